# Optimizing an MI355X kernel written in HIP

```python
import jax, jax.numpy as jnp
from jax import lax
import numpy as np

D_MODEL = 1024
BATCH = 2
SEQ = 16384
DEPTH = 2
DEC_BATCH = 4
DEC_SEQ = 8192
PAST_LEN = 128

N_META = 16
GRID_W = 64
Q_BLOCK = 128
ROPE_THETA = 10000.0
NORM_EPS = 1e-6

MLA_HEADS = 8
MLA_Q_LORA = 384
MLA_KV_LORA = 256
MLA_NOPE = 64
MLA_ROPE = 32
MLA_V = 64
MLA_QK = MLA_NOPE + MLA_ROPE
MLA_OUT = MLA_HEADS * MLA_V

GQA_HEADS = 8
GQA_KV_HEADS = 2
GQA_GROUP = GQA_HEADS // GQA_KV_HEADS
GQA_HEAD_DIM = 64
GQA_AXIS_DIM = GQA_HEAD_DIM // 2
GQA_OUT = GQA_HEADS * GQA_HEAD_DIM

MIX_WIDTH = MLA_OUT + GQA_OUT
D_FF = 4 * D_MODEL

IN_SIZES = (MLA_Q_LORA, MLA_KV_LORA, MLA_ROPE,
            GQA_HEADS * GQA_HEAD_DIM, GQA_KV_HEADS * GQA_HEAD_DIM, GQA_KV_HEADS * GQA_HEAD_DIM)
IN_COLS = sum(IN_SIZES)
IN_OFFSETS = tuple(int(v) for v in np.cumsum(IN_SIZES)[:-1])

kernel_name = "hybrid_mla_axial_gqa_encoder"


def rms_norm(x, g):
    xf = x.astype(jnp.float32)
    y = xf * lax.rsqrt(jnp.mean(xf * xf, axis=-1, keepdims=True) + NORM_EPS)
    return (y * g.astype(jnp.float32)).astype(x.dtype)


def inv_freq(dim):
    return 1.0 / (ROPE_THETA ** (jnp.arange(0, dim, 2, dtype=jnp.float32) / dim))


def cos_sin(ang):
    a = jnp.concatenate([ang, ang], axis=-1)
    return jnp.cos(a), jnp.sin(a)


def apply_rope(x, cos, sin):
    half = x.shape[-1] // 2
    x1, x2 = x[..., :half], x[..., half:]
    rot = jnp.concatenate([-x2, x1], axis=-1)
    c = cos[None, :, None, :].astype(x.dtype)
    s = sin[None, :, None, :].astype(x.dtype)
    return x * c + rot * s


def apply_axial_rope(x, row_cs, col_cs):
    xr = apply_rope(x[..., :GQA_AXIS_DIM], *row_cs)
    xc = apply_rope(x[..., GQA_AXIS_DIM:], *col_cs)
    return jnp.concatenate([xr, xc], axis=-1)


def block_attention(q, k, v, scale):
    B, L, Hk, G, D = q.shape
    n = L - N_META
    nb = n // Q_BLOCK

    def attend(qb):
        s = jnp.einsum('bqhgd,bkhd->bhgqk', qb, k).astype(jnp.float32) * scale
        p = jax.nn.softmax(s, axis=-1).astype(v.dtype)
        return jnp.einsum('bhgqk,bkhe->bqhge', p, v)

    o_meta = attend(q[:, :N_META])
    qr = q[:, N_META:].reshape(B, nb, Q_BLOCK, Hk, G, D)
    qr = jnp.moveaxis(qr, 1, 0)
    o_real = lax.map(attend, qr)
    o_real = jnp.moveaxis(o_real, 0, 1).reshape(B, n, Hk, G, v.shape[-1])
    return jnp.concatenate([o_meta, o_real], axis=1)


def encoder_layer(x, mla_cs, row_cs, col_cs, attn_norm_g, w_in, q_a_norm_g, w_q_b,
                  kv_a_norm_g, w_kv_b, gqa_q_norm_g, gqa_k_norm_g, mla_out_norm_g,
                  gqa_out_norm_g, w_out, mlp_norm_g, w_up, w_down):
    B, L, _ = x.shape
    h = rms_norm(x, attn_norm_g)
    proj = h @ w_in
    c_q, c_kv, k_rope, gq, gk, gv = jnp.split(proj, IN_OFFSETS, axis=-1)

    q = (rms_norm(c_q, q_a_norm_g) @ w_q_b).reshape(B, L, MLA_HEADS, MLA_QK)
    q_pe = apply_rope(q[..., MLA_NOPE:], *mla_cs)
    q_mla = jnp.concatenate([q[..., :MLA_NOPE], q_pe], axis=-1)[:, :, :, None, :]
    kv = (rms_norm(c_kv, kv_a_norm_g) @ w_kv_b).reshape(B, L, MLA_HEADS, MLA_NOPE + MLA_V)
    k_nope, v_mla = kv[..., :MLA_NOPE], kv[..., MLA_NOPE:]
    k_pe = apply_rope(k_rope[:, :, None, :], *mla_cs)
    k_mla = jnp.concatenate(
        [k_nope, jnp.broadcast_to(k_pe, (B, L, MLA_HEADS, MLA_ROPE))], axis=-1)
    o_mla = block_attention(q_mla, k_mla, v_mla, MLA_QK ** -0.5).reshape(B, L, MLA_OUT)

    gq = rms_norm(gq.reshape(B, L, GQA_HEADS, GQA_HEAD_DIM), gqa_q_norm_g)
    gk = rms_norm(gk.reshape(B, L, GQA_KV_HEADS, GQA_HEAD_DIM), gqa_k_norm_g)
    gv = gv.reshape(B, L, GQA_KV_HEADS, GQA_HEAD_DIM)
    gq = apply_axial_rope(gq, row_cs, col_cs).reshape(B, L, GQA_KV_HEADS, GQA_GROUP, GQA_HEAD_DIM)
    gk = apply_axial_rope(gk, row_cs, col_cs)
    o_gqa = block_attention(gq, gk, gv, GQA_HEAD_DIM ** -0.5).reshape(B, L, GQA_OUT)

    mixed = jnp.concatenate([rms_norm(o_mla, mla_out_norm_g),
                             rms_norm(o_gqa, gqa_out_norm_g)], axis=-1) @ w_out
    x = x + mixed

    u = rms_norm(x, mlp_norm_g) @ w_up
    return x + jnp.square(jax.nn.relu(u)) @ w_down


def run_trunk(x, meta_tokens, attn_norm_g, w_in, q_a_norm_g, w_q_b, kv_a_norm_g, w_kv_b,
              gqa_q_norm_g, gqa_k_norm_g, mla_out_norm_g, gqa_out_norm_g, w_out,
              mlp_norm_g, w_up, w_down, final_norm_g):
    B, n, _ = x.shape
    L = n + N_META
    meta = jnp.broadcast_to(meta_tokens.astype(x.dtype)[None], (B, N_META, D_MODEL))
    h = jnp.concatenate([meta, x], axis=1)

    pos = jnp.arange(L, dtype=jnp.float32)
    mla_cs = cos_sin(pos[:, None] * inv_freq(MLA_ROPE)[None, :])

    rows_n = n // GRID_W
    t_rows = jnp.repeat(jnp.arange(rows_n, dtype=jnp.float32), GRID_W)
    t_cols = jnp.tile(jnp.arange(GRID_W, dtype=jnp.float32), rows_n)
    zeros = jnp.zeros((N_META,), jnp.float32)
    f_ax = inv_freq(GQA_AXIS_DIM)
    row_cs = cos_sin(jnp.concatenate([zeros, t_rows])[:, None] * f_ax[None, :])
    col_cs = cos_sin(jnp.concatenate([zeros, t_cols])[:, None] * f_ax[None, :])

    for l in range(DEPTH):
        h = encoder_layer(h, mla_cs, row_cs, col_cs, attn_norm_g[l], w_in[l], q_a_norm_g[l],
                          w_q_b[l], kv_a_norm_g[l], w_kv_b[l], gqa_q_norm_g[l],
                          gqa_k_norm_g[l], mla_out_norm_g[l], gqa_out_norm_g[l], w_out[l],
                          mlp_norm_g[l], w_up[l], w_down[l])
    h = rms_norm(h, final_norm_g)
    return h[:, N_META:]


def setup_inputs(seed: int = 0) -> dict:
    key = jax.random.key(seed)
    ks = jax.random.split(key, 20)
    f32 = jnp.float32

    def w(k, shape, fan_in):
        return jax.random.normal(k, shape, f32) * (fan_in ** -0.5)

    def gain(k, shape):
        return 1.0 + 0.1 * jax.random.normal(k, shape, f32)

    return {
        "x_prompt": jax.random.normal(ks[0], (BATCH, SEQ, D_MODEL), f32),
        "x_sample": jax.random.normal(ks[1], (DEC_BATCH, DEC_SEQ, D_MODEL), f32),
        "meta_tokens": jax.random.normal(ks[2], (N_META, D_MODEL), f32),
        "attn_norm_g": gain(ks[3], (DEPTH, D_MODEL)),
        "w_in": w(ks[4], (DEPTH, D_MODEL, IN_COLS), D_MODEL),
        "q_a_norm_g": gain(ks[5], (DEPTH, MLA_Q_LORA)),
        "w_q_b": w(ks[6], (DEPTH, MLA_Q_LORA, MLA_HEADS * MLA_QK), MLA_Q_LORA),
        "kv_a_norm_g": gain(ks[7], (DEPTH, MLA_KV_LORA)),
        "w_kv_b": w(ks[8], (DEPTH, MLA_KV_LORA, MLA_HEADS * (MLA_NOPE + MLA_V)), MLA_KV_LORA),
        "gqa_q_norm_g": gain(ks[9], (DEPTH, GQA_HEAD_DIM)),
        "gqa_k_norm_g": gain(ks[10], (DEPTH, GQA_HEAD_DIM)),
        "mla_out_norm_g": gain(ks[11], (DEPTH, MLA_OUT)),
        "gqa_out_norm_g": gain(ks[12], (DEPTH, GQA_OUT)),
        "w_out": w(ks[13], (DEPTH, MIX_WIDTH, D_MODEL), MIX_WIDTH),
        "mlp_norm_g": gain(ks[14], (DEPTH, D_MODEL)),
        "w_up": w(ks[15], (DEPTH, D_MODEL, D_FF), D_MODEL),
        "w_down": w(ks[16], (DEPTH, D_FF, D_MODEL), D_FF),
        "final_norm_g": gain(ks[17], (D_MODEL,)),
    }


def reference(x_prompt, x_sample, meta_tokens, attn_norm_g, w_in, q_a_norm_g, w_q_b,
              kv_a_norm_g, w_kv_b, gqa_q_norm_g, gqa_k_norm_g, mla_out_norm_g,
              gqa_out_norm_g, w_out, mlp_norm_g, w_up, w_down, final_norm_g):
    y_prompt = run_trunk(x_prompt, meta_tokens, attn_norm_g, w_in, q_a_norm_g, w_q_b,
                         kv_a_norm_g, w_kv_b, gqa_q_norm_g, gqa_k_norm_g, mla_out_norm_g,
                         gqa_out_norm_g, w_out, mlp_norm_g, w_up, w_down, final_norm_g)
    y_sample = run_trunk(x_sample, meta_tokens, attn_norm_g, w_in, q_a_norm_g, w_q_b,
                         kv_a_norm_g, w_kv_b, gqa_q_norm_g, gqa_k_norm_g, mla_out_norm_g,
                         gqa_out_norm_g, w_out, mlp_norm_g, w_up, w_down, final_norm_g)
    return (y_prompt, y_sample)
```

```cpp
#include <hip/hip_runtime.h>
#include <hip/hip_cooperative_groups.h>
#include <stdint.h>
#include <cstdio>
namespace cg = cooperative_groups;

#ifndef MK_MULTI
#define MK_MULTI 0
#endif

typedef unsigned short u16;
typedef short bf16x8 __attribute__((ext_vector_type(8)));
typedef float f32x16 __attribute__((ext_vector_type(16)));
typedef unsigned u32x4 __attribute__((ext_vector_type(4)));
typedef unsigned u32x2 __attribute__((ext_vector_type(2)));
typedef float f32x2v __attribute__((ext_vector_type(2)));
typedef __bf16 bf16x2v __attribute__((ext_vector_type(2)));
#define DI __device__ __forceinline__
#define MFMA(a, b, c) __builtin_amdgcn_mfma_f32_32x32x16_bf16((a), (b), (c), 0, 0, 0)

constexpr int MPAD = 66304;
constexpr int NTM = 518;
constexpr float EPS = 1e-6f;
constexpr float LOG2E = 1.4426950408889634f;
constexpr float QSCALE_M = 0.10206207261596575f * LOG2E;
constexpr float QSCALE_G = 0.125f * LOG2E;

constexpr size_t SZ_WIN = 1536ull * 1024, SZ_WQB = 768ull * 384, SZ_WKVB = 1024ull * 256, SZ_WOUT = 1024ull * 1024,
                 SZ_WUP = 4096ull * 1024, SZ_WDN = 1024ull * 4096;
constexpr size_t WO_IN = 0, WO_QB = WO_IN + SZ_WIN, WO_KVB = WO_QB + SZ_WQB, WO_OUT = WO_KVB + SZ_WKVB, WO_UP = WO_OUT + SZ_WOUT,
                 WO_DN = WO_UP + SZ_WUP, W_LAYER = WO_DN + SZ_WDN;
constexpr size_t OFF_W = 0;
constexpr size_t OFF_TAB = OFF_W + 2 * W_LAYER * 2;
constexpr size_t OFF_XMETA = OFF_TAB + 16400ull * 16 * 8;
constexpr size_t OFF_SSQ = OFF_XMETA + 96ull * 1024 * 4;
constexpr size_t OFF_CNT = OFF_SSQ + 4ull * MPAD * 4;
constexpr size_t OFF_HN = OFF_CNT + 1024;
constexpr size_t OFF_CQ = OFF_HN + (size_t)MPAD * 1024 * 2;
constexpr size_t OFF_CKV = OFF_CQ + (size_t)MPAD * 384 * 2;
constexpr size_t OFF_KN = OFF_CKV + (size_t)MPAD * 256 * 2;
constexpr size_t OFF_KPE = OFF_KN + (size_t)MPAD * 512 * 2;
constexpr size_t OFF_VMT = OFF_KPE + (size_t)MPAD * 32 * 2;
constexpr size_t OFF_QG = OFF_VMT + (size_t)MPAD * 512 * 2;
constexpr size_t OFF_KG = OFF_QG + (size_t)MPAD * 512 * 2;
constexpr size_t OFF_VGT = OFF_KG + (size_t)MPAD * 128 * 2;
constexpr size_t OFF_END = OFF_VGT + (size_t)MPAD * 128 * 2;
constexpr size_t OFF_U = OFF_CQ;
static_assert(OFF_U + (size_t)MPAD * 2048 * 2 <= OFF_END, "U fits");
static_assert(OFF_END <= 536870912ull, "workspace");

struct Params {
  const float* xp; const float* xs; const float* meta;
  const float* attn_g; const float* w_in; const float* qa_g; const float* w_qb; const float* kva_g; const float* w_kvb;
  const float* gq_g; const float* gk_g; const float* mo_g; const float* go_g; const float* w_out; const float* mlp_g;
  const float* w_up; const float* w_dn; const float* fin_g;
  float* out; char* ws;
  int phase_lo, phase_hi;
};

DI unsigned pack2(float a, float b) { f32x2v f = {a, b}; bf16x2v v = __builtin_convertvector(f, bf16x2v); return __builtin_bit_cast(unsigned, v); }
DI u16 f2bf(float a) { return (u16)(pack2(a, 0.f) & 0xffffu); }
DI void store4(u16* dst, float a, float b, float c, float d) { u32x2 v = {pack2(a, b), pack2(c, d)}; *(u32x2*)dst = v; }
DI int crow(int i, int h) { return (i & 3) + 8 * (i >> 2) + 4 * h; }
DI int swap23(int r) { return (r & 0x13) | ((r & 4) << 1) | ((r & 8) >> 1); }
DI float xhalf(float v) { return __shfl_xor(v, 32); }

DI void decode_tile(int T, int& seq, int& i) {
  if (T < 258) { seq = (T >= 129) ? 1 : 0; i = T - seq * 129; }
  else { int u = T - 258; int q = u / 65; seq = 2 + q; i = u - q * 65; }
}
DI int seq_base(int seq) { return seq < 2 ? seq * 16512 : 33024 + (seq - 2) * 8320; }

DI const float* xrow_src(const Params& p, int g, bool from_input) {
  int T = g >> 7, r = g & 127, seq, i; decode_tile(T, seq, i);
  if (i == 0) {
    if (r < 112) return nullptr;
    return from_input ? p.meta + (size_t)(r - 112) * 1024 : (const float*)(p.ws + OFF_XMETA) + (size_t)(seq * 16 + r - 112) * 1024;
  }
  int j = (i - 1) * 128 + r;
  if (seq < 2) { size_t row = (size_t)seq * 16384 + j; return from_input ? p.xp + row * 1024 : p.out + row * 1024; }
  size_t row = (size_t)(seq - 2) * 8192 + j;
  return from_input ? p.xs + row * 1024 : p.out + (32768 + row) * 1024;
}
DI float* xrow_dst(const Params& p, int g) {
  int T = g >> 7, r = g & 127, seq, i; decode_tile(T, seq, i);
  if (i == 0) {
    if (r < 112) return nullptr;
    return (float*)(p.ws + OFF_XMETA) + (size_t)(seq * 16 + r - 112) * 1024;
  }
  int j = (i - 1) * 128 + r;
  if (seq < 2) { size_t row = (size_t)seq * 16384 + j; return p.out + row * 1024; }
  size_t row = (size_t)(seq - 2) * 8192 + j;
  return p.out + (32768 + row) * 1024;
}

DI int mapcol(int kind, int n) {
  if (kind == 1) { if (n < 640) return n; if (n < 1408) return n + 32; if (n < 1440) return 640 + (n - 1408); return -1; }
  if (kind == 2) { if (n < 512) return (n >> 6) * 96 + (n & 63); int m = n - 512; return (m >> 5) * 96 + 64 + (m & 31); }
  if (kind == 3) { if (n < 512) return (n >> 6) * 128 + (n & 63); int m = n - 512; return (m >> 6) * 128 + 64 + (m & 63); }
  return n;
}
DI void prep_weight(const float* __restrict__ src, int Nsrc, u16* __restrict__ dst, int Nout, int K, const float* gA, const float* gB,
                    int ksplit, int kind, int gtid, int gthreads) {
  const int total = Nout * (K >> 3);
  for (int u = gtid; u < total; u += gthreads) {
    const int n = u % Nout, kc = u / Nout;
    const int col = mapcol(kind, n);
    const int k = kc * 8;
    float v[8];
#pragma unroll
    for (int j = 0; j < 8; ++j) {
      float x = 0.f;
      if (col >= 0) {
        x = src[(size_t)(k + j) * Nsrc + col];
        if (gA) x *= (k + j < ksplit) ? gA[k + j] : gB[k + j - ksplit];
      }
      v[j] = x;
    }
    u32x4 o = {pack2(v[0], v[1]), pack2(v[2], v[3]), pack2(v[4], v[5]), pack2(v[6], v[7])};
    *(u32x4*)(dst + (size_t)n * K + k) = o;
  }
}

DI void phase_prep(const Params& p, int tid) {
  const int gtid = blockIdx.x * 256 + tid, gthreads = gridDim.x * 256;
  u16* W = (u16*)(p.ws + OFF_W);
  for (int l = 0; l < 2; ++l) {
    u16* Wl = W + (size_t)l * W_LAYER;
    prep_weight(p.w_in + (size_t)l * 1024 * 1440, 1440, Wl + WO_IN, 1536, 1024, nullptr, nullptr, 0, 1, gtid, gthreads);
    prep_weight(p.w_qb + (size_t)l * 384 * 768, 768, Wl + WO_QB, 768, 384, p.qa_g + l * 384, p.qa_g + l * 384, 384, 2, gtid, gthreads);
    prep_weight(p.w_kvb + (size_t)l * 256 * 1024, 1024, Wl + WO_KVB, 1024, 256, p.kva_g + l * 256, p.kva_g + l * 256, 256, 3, gtid, gthreads);
    prep_weight(p.w_out + (size_t)l * 1024 * 1024, 1024, Wl + WO_OUT, 1024, 1024, p.mo_g + l * 512, p.go_g + l * 512, 512, 0, gtid, gthreads);
    prep_weight(p.w_up + (size_t)l * 1024 * 4096, 4096, Wl + WO_UP, 4096, 1024, nullptr, nullptr, 0, 0, gtid, gthreads);
    prep_weight(p.w_dn + (size_t)l * 4096 * 1024, 1024, Wl + WO_DN, 1024, 4096, nullptr, nullptr, 0, 0, gtid, gthreads);
  }
  float2* tab = (float2*)(p.ws + OFF_TAB);
  for (int u = gtid; u < 16400 * 16; u += gthreads) {
    const int pos = u >> 4, f = u & 15;
    const float invf = 1.0f / powf(10000.0f, (float)(2 * f) / 32.0f);
    const float ang = (float)pos * invf;
    const double rev = (double)ang * 0.15915494309189535;
    const double fr = rev - rint(rev);
    const float x = (float)(2.0 * fr);
    tab[u] = make_float2(cospif(x), sinpif(x));
  }
  float* xm = (float*)(p.ws + OFF_XMETA);
  for (int u = gtid; u < 96 * 1024; u += gthreads) xm[u] = p.meta[u & 16383];
  int* cnt = (int*)(p.ws + OFF_CNT);
  if (gtid < 64) cnt[gtid] = 0;
}

DI void phase_norm(const Params& p, const float* __restrict__ gain, bool from_input, bool zero_ssq, int tid) {
  const int lane = tid & 63;
  const int gw = blockIdx.x * 4 + (tid >> 6), nw = gridDim.x * 4;
  u16* HN = (u16*)(p.ws + OFF_HN);
  float* ssq = (float*)(p.ws + OFF_SSQ);
  for (int g = gw; g < MPAD; g += nw) {
    const float* xr = xrow_src(p, g, from_input);
    u16* hr = HN + (size_t)g * 1024;
    if (!xr) {
      u32x4 z = {0u, 0u, 0u, 0u};
      *(u32x4*)(hr + lane * 16) = z;
      *(u32x4*)(hr + lane * 16 + 8) = z;
    } else {
      float4 v[4];
#pragma unroll
      for (int q = 0; q < 4; ++q) v[q] = ((const float4*)xr)[lane + 64 * q];
      float ss = 0.f;
#pragma unroll
      for (int q = 0; q < 4; ++q) ss += v[q].x * v[q].x + v[q].y * v[q].y + v[q].z * v[q].z + v[q].w * v[q].w;
#pragma unroll
      for (int o = 32; o >= 1; o >>= 1) ss += __shfl_xor(ss, o);
      const float rstd = rsqrtf(ss * (1.0f / 1024.0f) + EPS);
#pragma unroll
      for (int q = 0; q < 4; ++q) {
        const float4 gg = ((const float4*)gain)[lane + 64 * q];
        store4(hr + 4 * (lane + 64 * q), v[q].x * rstd * gg.x, v[q].y * rstd * gg.y, v[q].z * rstd * gg.z, v[q].w * rstd * gg.w);
      }
    }
    if (zero_ssq && lane < 4) ssq[(size_t)lane * MPAD + g] = 0.f;
  }
}

DI void phase_final(const Params& p, int tid) {
  const int lane = tid & 63;
  const int gw = blockIdx.x * 4 + (tid >> 6), nw = gridDim.x * 4;
  for (int g = gw; g < MPAD; g += nw) {
    if (((g >> 7) == 0) || ((g >> 7) == 129) || ((g >> 7) >= 258 && ((g >> 7) - 258) % 65 == 0)) continue;
    float* xr = xrow_dst(p, g);
    float4 v[4];
#pragma unroll
    for (int q = 0; q < 4; ++q) v[q] = ((const float4*)xr)[lane + 64 * q];
    float ss = 0.f;
#pragma unroll
    for (int q = 0; q < 4; ++q) ss += v[q].x * v[q].x + v[q].y * v[q].y + v[q].z * v[q].z + v[q].w * v[q].w;
#pragma unroll
    for (int o = 32; o >= 1; o >>= 1) ss += __shfl_xor(ss, o);
    const float rstd = rsqrtf(ss * (1.0f / 1024.0f) + EPS);
#pragma unroll
    for (int q = 0; q < 4; ++q) {
      const float4 gg = ((const float4*)p.fin_g)[lane + 64 * q];
      float4 o = make_float4(v[q].x * rstd * gg.x, v[q].y * rstd * gg.y, v[q].z * rstd * gg.z, v[q].w * rstd * gg.w);
      ((float4*)xr)[lane + 64 * q] = o;
    }
  }
}

constexpr int GP = 72;
struct APLin { const u16* A; int lda; DI const u16* ptr(int row, int k0) const { return A + (size_t)row * lda + k0; } };
struct APMix { const u16* QM; const u16* QG;
  DI const u16* ptr(int row, int k0) const { return k0 < 512 ? QM + (size_t)row * 768 + (k0 >> 6) * 96 : QG + (size_t)row * 512 + (k0 - 512); } };

template <bool MIDK, class AP, class EPI>
DI void gemm_tile(const AP& ap, const u16* __restrict__ W, int ldw, int K, int m0, int n0, const EPI& epi, char* smem, float r0, float r1, int tid) {
  u16* sA = (u16*)smem;
  u16* sB = sA + 128 * GP;
  const int lane = tid & 63, wave = tid >> 6, r = lane & 31, h = lane >> 5, wm = wave >> 1, wn = wave & 1;
  const int lrow = tid >> 3, lkc = (tid & 7) * 8;
  u32x4 ra[4], rb[4];
  f32x16 acc[2][2];
#pragma unroll
  for (int a = 0; a < 2; ++a)
#pragma unroll
    for (int b = 0; b < 2; ++b)
#pragma unroll
      for (int i = 0; i < 16; ++i) acc[a][b][i] = 0.f;
  const int nk = K >> 6;
#pragma unroll
  for (int q = 0; q < 4; ++q) {
    ra[q] = *(const u32x4*)(ap.ptr(m0 + lrow + 32 * q, 0) + lkc);
    rb[q] = *(const u32x4*)(W + (size_t)(n0 + lrow + 32 * q) * ldw + lkc);
  }
  for (int kt = 0; kt < nk; ++kt) {
    __syncthreads();
#pragma unroll
    for (int q = 0; q < 4; ++q) {
      *(u32x4*)(sA + (lrow + 32 * q) * GP + lkc) = ra[q];
      *(u32x4*)(sB + (lrow + 32 * q) * GP + lkc) = rb[q];
    }
    __syncthreads();
    if (kt + 1 < nk) {
      const int k0 = (kt + 1) << 6;
#pragma unroll
      for (int q = 0; q < 4; ++q) {
        ra[q] = *(const u32x4*)(ap.ptr(m0 + lrow + 32 * q, k0) + lkc);
        rb[q] = *(const u32x4*)(W + (size_t)(n0 + lrow + 32 * q) * ldw + k0 + lkc);
      }
    }
#pragma unroll
    for (int ks = 0; ks < 4; ++ks) {
      bf16x8 wf[2], xf[2];
#pragma unroll
      for (int a = 0; a < 2; ++a) {
        wf[a] = *(const bf16x8*)(sB + (wn * 64 + a * 32 + r) * GP + ks * 16 + h * 8);
        xf[a] = *(const bf16x8*)(sA + (wm * 64 + a * 32 + r) * GP + ks * 16 + h * 8);
      }
#pragma unroll
      for (int a = 0; a < 2; ++a)
#pragma unroll
        for (int b = 0; b < 2; ++b) acc[a][b] = MFMA(wf[a], xf[b], acc[a][b]);
    }
    if (MIDK && kt == 7) {
#pragma unroll
      for (int a = 0; a < 2; ++a)
#pragma unroll
        for (int i = 0; i < 16; ++i) { acc[a][0][i] *= r0; acc[a][1][i] *= r1; }
    }
  }
  epi(acc, n0 + wn * 64, m0 + wm * 64, r, h);
}

DI void rope16(float (&v)[16], const float2* __restrict__ tabrow, int h) {
#pragma unroll
  for (int i = 0; i < 8; ++i) {
    const int f = (i & 3) + 8 * (i >> 2) + 4 * h;
    const float2 cs = tabrow[f];
    const float x1 = v[i], x2 = v[i + 8];
    v[i] = x1 * cs.x - x2 * cs.y;
    v[i + 8] = x2 * cs.x + x1 * cs.y;
  }
}

struct EpiIn {
  u16 *CQ, *CKV, *QG, *KG, *VGT, *KPE; float *ssq_q, *ssq_kv; const float *gq_g, *gk_g; const float2* tab;
  DI void operator()(f32x16 (&acc)[2][2], int nb, int mb, int r, int h) const {
    int seq, it; decode_tile(mb >> 7, seq, it);
#pragma unroll
    for (int ti = 0; ti < 2; ++ti) {
      const int g = mb + ti * 32 + r, rr = g & 127;
      if (nb < 640) {
        u16* dst = nb < 384 ? CQ + (size_t)g * 384 + nb : CKV + (size_t)g * 256 + (nb - 384);
        float ss = 0.f;
#pragma unroll
        for (int fi = 0; fi < 2; ++fi)
#pragma unroll
          for (int g4 = 0; g4 < 4; ++g4) {
            const float a0 = acc[fi][ti][4 * g4], a1 = acc[fi][ti][4 * g4 + 1], a2 = acc[fi][ti][4 * g4 + 2], a3 = acc[fi][ti][4 * g4 + 3];
            ss += a0 * a0 + a1 * a1 + a2 * a2 + a3 * a3;
            store4(dst + fi * 32 + 8 * g4 + 4 * h, a0, a1, a2, a3);
          }
        ss += xhalf(ss);
        if (h == 0) unsafeAtomicAdd((nb < 384 ? ssq_q : ssq_kv) + g, ss);
      } else if (nb < 1280) {
        const bool isq = nb < 1152;
        const float* gg = isq ? gq_g : gk_g;
        float ss = 0.f;
#pragma unroll
        for (int fi = 0; fi < 2; ++fi)
#pragma unroll
          for (int i = 0; i < 16; ++i) ss += acc[fi][ti][i] * acc[fi][ti][i];
        ss += xhalf(ss);
        const float rstd = rsqrtf(ss * (1.0f / 64.0f) + EPS);
        const float osc = isq ? QSCALE_G : 1.0f;
        int prow = 0, pcol = 0;
        if (it > 0) { const int j = (it - 1) * 128 + rr; prow = j >> 6; pcol = j & 63; }
        u16* dst = isq ? QG + (size_t)g * 512 + (nb - 640) : KG + (size_t)g * 128 + (nb - 1152);
#pragma unroll
        for (int fi = 0; fi < 2; ++fi) {
          const int pos = fi == 0 ? prow : pcol;
          float v[16];
#pragma unroll
          for (int i = 0; i < 16; ++i) v[i] = acc[fi][ti][i] * rstd * gg[fi * 32 + crow(i, h)];
          rope16(v, tab + pos * 16, h);
#pragma unroll
          for (int g4 = 0; g4 < 4; ++g4)
            store4(dst + fi * 32 + 8 * g4 + 4 * h, v[4 * g4] * osc, v[4 * g4 + 1] * osc, v[4 * g4 + 2] * osc, v[4 * g4 + 3] * osc);
        }
      } else if (nb < 1408) {
#pragma unroll
        for (int fi = 0; fi < 2; ++fi)
#pragma unroll
          for (int i = 0; i < 16; ++i) VGT[(size_t)(nb - 1280 + fi * 32 + crow(i, h)) * MPAD + g] = f2bf(acc[fi][ti][i]);
      } else if (nb == 1408) {
        int pos = 128 * it + rr - 112; pos = pos < 0 ? 0 : pos;
        float v[16];
#pragma unroll
        for (int i = 0; i < 16; ++i) v[i] = acc[0][ti][i];
        rope16(v, tab + pos * 16, h);
#pragma unroll
        for (int g4 = 0; g4 < 4; ++g4) store4(KPE + (size_t)g * 32 + 8 * g4 + 4 * h, v[4 * g4], v[4 * g4 + 1], v[4 * g4 + 2], v[4 * g4 + 3]);
      }
    }
  }
};

struct EpiQB {
  u16* QM; const float* ssq_q; const float2* tab;
  DI void operator()(f32x16 (&acc)[2][2], int nb, int mb, int r, int h) const {
    int seq, it; decode_tile(mb >> 7, seq, it);
#pragma unroll
    for (int ti = 0; ti < 2; ++ti) {
      const int g = mb + ti * 32 + r, rr = g & 127;
      const float sc = rsqrtf(ssq_q[g] * (1.0f / 384.0f) + EPS) * QSCALE_M;
      if (nb < 512) {
        u16* dst = QM + (size_t)g * 768 + (nb >> 6) * 96;
#pragma unroll
        for (int fi = 0; fi < 2; ++fi)
#pragma unroll
          for (int g4 = 0; g4 < 4; ++g4)
            store4(dst + fi * 32 + 8 * g4 + 4 * h, acc[fi][ti][4 * g4] * sc, acc[fi][ti][4 * g4 + 1] * sc, acc[fi][ti][4 * g4 + 2] * sc, acc[fi][ti][4 * g4 + 3] * sc);
      } else {
        int pos = 128 * it + rr - 112; pos = pos < 0 ? 0 : pos;
#pragma unroll
        for (int fi = 0; fi < 2; ++fi) {
          const int head = ((nb - 512) >> 5) + fi;
          float v[16];
#pragma unroll
          for (int i = 0; i < 16; ++i) v[i] = acc[fi][ti][i] * sc;
          rope16(v, tab + pos * 16, h);
          u16* dst = QM + (size_t)g * 768 + head * 96 + 64;
#pragma unroll
          for (int g4 = 0; g4 < 4; ++g4) store4(dst + 8 * g4 + 4 * h, v[4 * g4], v[4 * g4 + 1], v[4 * g4 + 2], v[4 * g4 + 3]);
        }
      }
    }
  }
};

struct EpiKVB {
  u16 *KN, *VMT; const float* ssq_kv;
  DI void operator()(f32x16 (&acc)[2][2], int nb, int mb, int r, int h) const {
#pragma unroll
    for (int ti = 0; ti < 2; ++ti) {
      const int g = mb + ti * 32 + r;
      const float sc = rsqrtf(ssq_kv[g] * (1.0f / 256.0f) + EPS);
      if (nb < 512) {
        u16* dst = KN + (size_t)g * 512 + nb;
#pragma unroll
        for (int fi = 0; fi < 2; ++fi)
#pragma unroll
          for (int g4 = 0; g4 < 4; ++g4)
            store4(dst + fi * 32 + 8 * g4 + 4 * h, acc[fi][ti][4 * g4] * sc, acc[fi][ti][4 * g4 + 1] * sc, acc[fi][ti][4 * g4 + 2] * sc, acc[fi][ti][4 * g4 + 3] * sc);
      } else {
#pragma unroll
        for (int fi = 0; fi < 2; ++fi)
#pragma unroll
          for (int i = 0; i < 16; ++i) VMT[(size_t)(nb - 512 + fi * 32 + crow(i, h)) * MPAD + g] = f2bf(acc[fi][ti][i] * sc);
      }
    }
  }
};

struct EpiRes {
  const Params* p; bool from_input; float fin0, fin1;
  DI void operator()(f32x16 (&acc)[2][2], int nb, int mb, int r, int h) const {
#pragma unroll
    for (int ti = 0; ti < 2; ++ti) {
      const int g = mb + ti * 32 + r;
      const float sc = ti == 0 ? fin0 : fin1;
      const float* xs = xrow_src(*p, g, from_input);
      float* xd = xrow_dst(*p, g);
      if (xd) {
#pragma unroll
        for (int fi = 0; fi < 2; ++fi)
#pragma unroll
          for (int g4 = 0; g4 < 4; ++g4) {
            const int c = nb + fi * 32 + 8 * g4 + 4 * h;
            float4 x = *(const float4*)(xs + c);
            x.x += acc[fi][ti][4 * g4] * sc; x.y += acc[fi][ti][4 * g4 + 1] * sc; x.z += acc[fi][ti][4 * g4 + 2] * sc; x.w += acc[fi][ti][4 * g4 + 3] * sc;
            *(float4*)(xd + c) = x;
          }
      }
    }
  }
};

struct EpiUp {
  u16* U; int ncol0;
  DI void operator()(f32x16 (&acc)[2][2], int nb, int mb, int r, int h) const {
#pragma unroll
    for (int ti = 0; ti < 2; ++ti) {
      const int g = mb + ti * 32 + r;
      u16* dst = U + (size_t)g * 2048 + (nb - ncol0);
#pragma unroll
      for (int fi = 0; fi < 2; ++fi)
#pragma unroll
        for (int g4 = 0; g4 < 4; ++g4) {
          float a0 = fmaxf(acc[fi][ti][4 * g4], 0.f), a1 = fmaxf(acc[fi][ti][4 * g4 + 1], 0.f), a2 = fmaxf(acc[fi][ti][4 * g4 + 2], 0.f), a3 = fmaxf(acc[fi][ti][4 * g4 + 3], 0.f);
          store4(dst + fi * 32 + 8 * g4 + 4 * h, a0 * a0, a1 * a1, a2 * a2, a3 * a3);
        }
    }
  }
};

template <int DQK>
DI void attn_item(const u16* __restrict__ Qb, int qpitch, const u16* __restrict__ Kb, int kpitch, const u16* __restrict__ KPEb,
                  const u16* __restrict__ Vt, float* __restrict__ ssq, int rowq0, int rowk0, int nt, char* smem, int tid) {
  constexpr int KP = DQK + 8, NKS = DQK / 16, KCH = DQK / 8, NKL = 64 * KCH / 256;
  u16* sK = (u16*)smem;
  u16* sV = sK + 64 * KP;
  const int lane = tid & 63, wave = tid >> 6, r = lane & 31, h = lane >> 5;
  bf16x8 qf[NKS];
  const int myrow = rowq0 + wave * 32 + r;
  {
    const u16* qrow = Qb + (size_t)myrow * qpitch + h * 8;
#pragma unroll
    for (int ks = 0; ks < NKS; ++ks) qf[ks] = *(const bf16x8*)(qrow + ks * 16);
  }
  f32x16 o[2];
#pragma unroll
  for (int a = 0; a < 2; ++a)
#pragma unroll
    for (int i = 0; i < 16; ++i) o[a][i] = 0.f;
  float m = -1e30f, l = 0.f;
  u32x4 rk[NKL], rv[2];
  const int sr = swap23(r);
#pragma unroll
  for (int q = 0; q < NKL; ++q) {
    const int c = tid + 256 * q, row = c / KCH, cc = c % KCH;
    const u16* src = (DQK == 96 && cc >= 8) ? KPEb + (size_t)(rowk0 + row) * 32 + (cc - 8) * 8 : Kb + (size_t)(rowk0 + row) * kpitch + cc * 8;
    rk[q] = *(const u32x4*)src;
  }
#pragma unroll
  for (int q = 0; q < 2; ++q) {
    const int c = tid + 256 * q, dv = c >> 3, kc = c & 7;
    rv[q] = *(const u32x4*)(Vt + (size_t)dv * MPAD + rowk0 + kc * 8);
  }
  for (int t = 0; t < nt; ++t) {
    __syncthreads();
#pragma unroll
    for (int q = 0; q < NKL; ++q) {
      const int c = tid + 256 * q, row = c / KCH, cc = c % KCH;
      *(u32x4*)(sK + row * KP + cc * 8) = rk[q];
    }
#pragma unroll
    for (int q = 0; q < 2; ++q) {
      const int c = tid + 256 * q, dv = c >> 3, kc = c & 7;
      *(u32x4*)(sV + dv * GP + kc * 8) = rv[q];
    }
    __syncthreads();
    if (t + 1 < nt) {
      const int row0 = rowk0 + (t + 1) * 64;
#pragma unroll
      for (int q = 0; q < NKL; ++q) {
        const int c = tid + 256 * q, row = c / KCH, cc = c % KCH;
        const u16* src = (DQK == 96 && cc >= 8) ? KPEb + (size_t)(row0 + row) * 32 + (cc - 8) * 8 : Kb + (size_t)(row0 + row) * kpitch + cc * 8;
        rk[q] = *(const u32x4*)src;
      }
#pragma unroll
      for (int q = 0; q < 2; ++q) {
        const int c = tid + 256 * q, dv = c >> 3, kc = c & 7;
        rv[q] = *(const u32x4*)(Vt + (size_t)dv * MPAD + row0 + kc * 8);
      }
    }
    f32x16 s[2];
#pragma unroll
    for (int kb = 0; kb < 2; ++kb) {
#pragma unroll
      for (int i = 0; i < 16; ++i) s[kb][i] = 0.f;
#pragma unroll
      for (int ks = 0; ks < NKS; ++ks) {
        const bf16x8 a = *(const bf16x8*)(sK + (kb * 32 + sr) * KP + ks * 16 + h * 8);
        s[kb] = MFMA(a, qf[ks], s[kb]);
      }
    }
    if (t == 0) {
#pragma unroll
      for (int i = 0; i < 16; ++i) {
        s[0][i] = -1e30f;
        if (swap23(crow(i, h)) < 16) s[1][i] = -1e30f;
      }
    }
    float mx = s[0][0];
#pragma unroll
    for (int kb = 0; kb < 2; ++kb)
#pragma unroll
      for (int i = 0; i < 16; ++i) mx = fmaxf(mx, s[kb][i]);
    mx = fmaxf(mx, xhalf(mx));
    const float mn = fmaxf(m, mx);
    const float alpha = __builtin_amdgcn_exp2f(m - mn);
    m = mn;
    float psum = 0.f;
#pragma unroll
    for (int kb = 0; kb < 2; ++kb)
#pragma unroll
      for (int i = 0; i < 16; ++i) { const float pv = __builtin_amdgcn_exp2f(s[kb][i] - mn); s[kb][i] = pv; psum += pv; }
    l = l * alpha + psum;
#pragma unroll
    for (int a = 0; a < 2; ++a)
#pragma unroll
      for (int i = 0; i < 16; ++i) o[a][i] *= alpha;
#pragma unroll
    for (int kb = 0; kb < 2; ++kb)
#pragma unroll
      for (int s2 = 0; s2 < 2; ++s2) {
        u32x4 pk = {pack2(s[kb][8 * s2], s[kb][8 * s2 + 1]), pack2(s[kb][8 * s2 + 2], s[kb][8 * s2 + 3]),
                    pack2(s[kb][8 * s2 + 4], s[kb][8 * s2 + 5]), pack2(s[kb][8 * s2 + 6], s[kb][8 * s2 + 7])};
        const bf16x8 pf = __builtin_bit_cast(bf16x8, pk);
#pragma unroll
        for (int db = 0; db < 2; ++db) {
          const bf16x8 a = *(const bf16x8*)(sV + (db * 32 + r) * GP + kb * 32 + s2 * 16 + h * 8);
          o[db] = MFMA(a, pf, o[db]);
        }
      }
  }
  l += xhalf(l);
  const float inv = 1.0f / l;
  float ss = 0.f;
  u16* orow = (u16*)Qb + (size_t)myrow * qpitch;
#pragma unroll
  for (int db = 0; db < 2; ++db)
#pragma unroll
    for (int g4 = 0; g4 < 4; ++g4) {
      const float a0 = o[db][4 * g4] * inv, a1 = o[db][4 * g4 + 1] * inv, a2 = o[db][4 * g4 + 2] * inv, a3 = o[db][4 * g4 + 3] * inv;
      ss += a0 * a0 + a1 * a1 + a2 * a2 + a3 * a3;
      store4(orow + db * 32 + 8 * g4 + 4 * h, a0, a1, a2, a3);
    }
  ss += xhalf(ss);
  if (h == 0) unsafeAtomicAdd(ssq + myrow, ss);
}

constexpr int N_ITEMS = 8288;
DI void phase_attn(const Params& p, int layer, char* smem, int* s_item, int tid) {
  int* cnt = (int*)(p.ws + OFF_CNT) + layer;
  u16* QM = (u16*)(p.ws + OFF_HN);
  const u16* KN = (const u16*)(p.ws + OFF_KN);
  const u16* KPE = (const u16*)(p.ws + OFF_KPE);
  const u16* VMT = (const u16*)(p.ws + OFF_VMT);
  u16* QG = (u16*)(p.ws + OFF_QG);
  const u16* KG = (const u16*)(p.ws + OFF_KG);
  const u16* VGT = (const u16*)(p.ws + OFF_VGT);
  float* ssq = (float*)(p.ws + OFF_SSQ);
  for (;;) {
    if (tid == 0) *s_item = atomicAdd(cnt, 1);
    __syncthreads();
    const int it = *s_item;
    __syncthreads();
    if (it >= N_ITEMS) break;
    int grp, seq, head, qi, nt;
    if (it < 4128) { grp = it / 2064; const int u = it - grp * 2064; const int sh = u / 129; qi = u - sh * 129; seq = sh >> 3; head = sh & 7; nt = 257; }
    else { const int u0 = it - 4128; grp = u0 / 2080; const int u = u0 - grp * 2080; const int sh = u / 65; qi = u - sh * 65; seq = 2 + (sh >> 3); head = sh & 7; nt = 129; }
    const int P = seq_base(seq);
    if (grp == 0)
      attn_item<96>(QM + head * 96, 768, KN + head * 64, 512, KPE, VMT + (size_t)head * 64 * MPAD, ssq + 2 * (size_t)MPAD, P + qi * 128, P + 64, nt, smem, tid);
    else
      attn_item<64>(QG + head * 64, 512, KG + (head >> 2) * 64, 128, nullptr, VGT + (size_t)(head >> 2) * 64 * MPAD, ssq + 3 * (size_t)MPAD, P + qi * 128, P + 64, nt, smem, tid);
  }
}

__global__ void __launch_bounds__(256, 2) mega(Params pin) {
  __shared__ __attribute__((aligned(16))) char smem[2 * 128 * GP * 2];
  __shared__ int s_item;
  const int G = gridDim.x, b = blockIdx.x;
  const int vb = ((G & 7) == 0) ? ((b & 7) * (G >> 3) + (b >> 3)) : b;
  for (int ph = pin.phase_lo; ph < pin.phase_hi; ++ph) {
    if (ph > pin.phase_lo) cg::this_grid().sync();
    Params p = pin;
    asm volatile("" : "+s"(p.xp), "+s"(p.xs), "+s"(p.meta), "+s"(p.attn_g), "+s"(p.w_in), "+s"(p.qa_g), "+s"(p.w_qb), "+s"(p.kva_g), "+s"(p.w_kvb), "+s"(p.gq_g));
    asm volatile("" : "+s"(p.gk_g), "+s"(p.mo_g), "+s"(p.go_g), "+s"(p.w_out), "+s"(p.mlp_g), "+s"(p.w_up), "+s"(p.w_dn), "+s"(p.fin_g), "+s"(p.out), "+s"(p.ws));
    int tid = threadIdx.x;
    asm volatile("" : "+v"(tid));
    const int lane = tid & 63, wave = tid >> 6, r = lane & 31;
    float* ssq = (float*)(p.ws + OFF_SSQ);
    const float2* tab = (const float2*)(p.ws + OFF_TAB);
    if (ph == 0) { phase_prep(p, tid); continue; }
    if (ph == 21) { phase_final(p, tid); continue; }
    const int layer = (ph - 1) / 10, sub = (ph - 1) % 10;
    const u16* Wl = (const u16*)(p.ws + OFF_W) + (size_t)layer * W_LAYER;
    if (sub == 0) {
      phase_norm(p, p.attn_g + layer * 1024, layer == 0, true, tid);
    } else if (sub == 1) {
      EpiIn e; e.CQ = (u16*)(p.ws + OFF_CQ); e.CKV = (u16*)(p.ws + OFF_CKV); e.QG = (u16*)(p.ws + OFF_QG); e.KG = (u16*)(p.ws + OFF_KG);
      e.VGT = (u16*)(p.ws + OFF_VGT); e.KPE = (u16*)(p.ws + OFF_KPE); e.ssq_q = ssq; e.ssq_kv = ssq + MPAD;
      e.gq_g = p.gq_g + layer * 64; e.gk_g = p.gk_g + layer * 64; e.tab = tab;
      APLin ap{(const u16*)(p.ws + OFF_HN), 1024};
      for (int t = vb; t < NTM * 12; t += G) { const int mt = t / 12, nt = t - mt * 12; gemm_tile<false>(ap, Wl + WO_IN, 1024, 1024, mt * 128, nt * 128, e, smem, 1.f, 1.f, tid); }
    } else if (sub == 2) {
      EpiQB e2; e2.QM = (u16*)(p.ws + OFF_HN); e2.ssq_q = ssq; e2.tab = tab;
      EpiKVB e3; e3.KN = (u16*)(p.ws + OFF_KN); e3.VMT = (u16*)(p.ws + OFF_VMT); e3.ssq_kv = ssq + MPAD;
      APLin a2{(const u16*)(p.ws + OFF_CQ), 384};
      APLin a3{(const u16*)(p.ws + OFF_CKV), 256};
      for (int t = vb; t < NTM * 14; t += G) {
        if (t < NTM * 6) { const int mt = t / 6, nt = t - mt * 6; gemm_tile<false>(a2, Wl + WO_QB, 384, 384, mt * 128, nt * 128, e2, smem, 1.f, 1.f, tid); }
        else { const int u = t - NTM * 6; const int mt = u >> 3, nt = u & 7; gemm_tile<false>(a3, Wl + WO_KVB, 256, 256, mt * 128, nt * 128, e3, smem, 1.f, 1.f, tid); }
      }
    } else if (sub == 3) {
      phase_attn(p, layer, smem, &s_item, tid);
    } else if (sub == 4) {
      APMix ap{(const u16*)(p.ws + OFF_HN), (const u16*)(p.ws + OFF_QG)};
      for (int t = vb; t < NTM * 8; t += G) {
        const int mt = t >> 3, nt = t & 7;
        const int g0 = mt * 128 + (wave >> 1) * 64 + r;
        const float ra0 = rsqrtf(ssq[2 * (size_t)MPAD + g0] * (1.0f / 512.0f) + EPS), rg0 = rsqrtf(ssq[3 * (size_t)MPAD + g0] * (1.0f / 512.0f) + EPS);
        const float ra1 = rsqrtf(ssq[2 * (size_t)MPAD + g0 + 32] * (1.0f / 512.0f) + EPS), rg1 = rsqrtf(ssq[3 * (size_t)MPAD + g0 + 32] * (1.0f / 512.0f) + EPS);
        EpiRes e; e.p = &p; e.from_input = (layer == 0); e.fin0 = rg0; e.fin1 = rg1;
        gemm_tile<true>(ap, Wl + WO_OUT, 1024, 1024, mt * 128, nt * 128, e, smem, ra0 / rg0, ra1 / rg1, tid);
      }
    } else if (sub == 5) {
      phase_norm(p, p.mlp_g + layer * 1024, false, false, tid);
    } else if (sub == 6 || sub == 8) {
      const int half = (sub - 6) >> 1;
      EpiUp e; e.U = (u16*)(p.ws + OFF_U); e.ncol0 = half * 2048;
      APLin ap{(const u16*)(p.ws + OFF_HN), 1024};
      for (int t = vb; t < NTM * 16; t += G) { const int mt = t >> 4, nt = t & 15; gemm_tile<false>(ap, Wl + WO_UP, 1024, 1024, mt * 128, half * 2048 + nt * 128, e, smem, 1.f, 1.f, tid); }
    } else {
      const int half = (sub - 7) >> 1;
      EpiRes e; e.p = &p; e.from_input = false; e.fin0 = 1.f; e.fin1 = 1.f;
      APLin ap{(const u16*)(p.ws + OFF_U), 2048};
      for (int t = vb; t < NTM * 8; t += G) { const int mt = t >> 3, nt = t & 7; gemm_tile<false>(ap, Wl + WO_DN + half * 2048, 4096, 2048, mt * 128, nt * 128, e, smem, 1.f, 1.f, tid); }
    }
  }
}

extern "C" void kernel_launch(void* const* d_in, const int* in_sizes, int n_in, void* d_out, int out_size, void* d_ws, size_t ws_size,
                              hipStream_t stream) {
  static int grid_blocks = 0;
  if (!grid_blocks) {
    int dev = 0, cus = 0, per_cu = 0;
    hipGetDevice(&dev);
    hipDeviceGetAttribute(&cus, hipDeviceAttributeMultiprocessorCount, dev);
    hipOccupancyMaxActiveBlocksPerMultiprocessor(&per_cu, mega, 256, 0);
    if (per_cu > 2) per_cu = 2;
    if (per_cu < 1) per_cu = 1;
    grid_blocks = cus * per_cu;
  }
  Params p{};
  p.xp = (const float*)d_in[0]; p.xs = (const float*)d_in[1]; p.meta = (const float*)d_in[2];
  p.attn_g = (const float*)d_in[3]; p.w_in = (const float*)d_in[4]; p.qa_g = (const float*)d_in[5]; p.w_qb = (const float*)d_in[6];
  p.kva_g = (const float*)d_in[7]; p.w_kvb = (const float*)d_in[8]; p.gq_g = (const float*)d_in[9]; p.gk_g = (const float*)d_in[10];
  p.mo_g = (const float*)d_in[11]; p.go_g = (const float*)d_in[12]; p.w_out = (const float*)d_in[13]; p.mlp_g = (const float*)d_in[14];
  p.w_up = (const float*)d_in[15]; p.w_dn = (const float*)d_in[16]; p.fin_g = (const float*)d_in[17];
  p.out = (float*)d_out; p.ws = (char*)d_ws;
#if MK_MULTI
  for (int ph = 0; ph < 22; ++ph) {
    p.phase_lo = ph; p.phase_hi = ph + 1;
    hipLaunchKernelGGL(mega, dim3(grid_blocks), dim3(256), 0, stream, p);
  }
#else
  p.phase_lo = 0; p.phase_hi = 22;
  void* args[] = {&p};
  hipError_t e = hipLaunchCooperativeKernel((void*)mega, dim3(grid_blocks), dim3(256), args, 0, stream);
  if (e != hipSuccess) fprintf(stderr, "cooperative launch failed: %s (grid %d)\n", hipGetErrorString(e), grid_blocks);
#endif
}
```

```cpp
#include <hip/hip_runtime.h>
#include <hip/hip_cooperative_groups.h>
#include <stdint.h>
#include <cstdio>
namespace cg = cooperative_groups;

#ifndef PROBE_MASK
#define PROBE_MASK 0
#endif
#ifndef MK_MULTI
#define MK_MULTI 0
#endif

typedef unsigned short u16;
typedef short bf16x8 __attribute__((ext_vector_type(8)));
typedef float f32x16 __attribute__((ext_vector_type(16)));
typedef unsigned u32x4 __attribute__((ext_vector_type(4)));
typedef unsigned u32x2 __attribute__((ext_vector_type(2)));
typedef float f32x2v __attribute__((ext_vector_type(2)));
typedef __bf16 bf16x2v __attribute__((ext_vector_type(2)));
#define DI __device__ __forceinline__
#define WAVE_LDS_FENCE() asm volatile("s_waitcnt lgkmcnt(0)" ::: "memory")
#define MFMA(a, b, c) __builtin_amdgcn_mfma_f32_32x32x16_bf16((a), (b), (c), 0, 0, 0)

constexpr int MPAD = 66304;
constexpr int NTM = 518;
constexpr float EPS = 1e-6f;
constexpr float LOG2E = 1.4426950408889634f;
constexpr float QSCALE_M = 0.10206207261596575f * LOG2E;
constexpr float QSCALE_G = 0.125f * LOG2E;

constexpr size_t SZ_WIN = 1536ull * 1024, SZ_WQB = 768ull * 384, SZ_WKVB = 1024ull * 256, SZ_WOUT = 1024ull * 1024,
                 SZ_WUP = 4096ull * 1024, SZ_WDN = 1024ull * 4096;
constexpr size_t WO_IN = 0, WO_QB = WO_IN + SZ_WIN, WO_KVB = WO_QB + SZ_WQB, WO_OUT = WO_KVB + SZ_WKVB, WO_UP = WO_OUT + SZ_WOUT,
                 WO_DN = WO_UP + SZ_WUP, W_LAYER = WO_DN + SZ_WDN;
constexpr size_t OFF_W = 0;
constexpr size_t OFF_TAB = OFF_W + 2 * W_LAYER * 2;
constexpr size_t OFF_XMETA = OFF_TAB + 16400ull * 16 * 8;
constexpr size_t OFF_SSQ = OFF_XMETA + 96ull * 1024 * 4;
constexpr size_t OFF_CNT = OFF_SSQ + 4ull * MPAD * 4;
constexpr size_t OFF_HN = OFF_CNT + 1024;
constexpr size_t OFF_CQ = OFF_HN + (size_t)MPAD * 1024 * 2;
constexpr size_t OFF_CKV = OFF_CQ + (size_t)MPAD * 384 * 2;
constexpr size_t OFF_KN = OFF_CKV + (size_t)MPAD * 256 * 2;
constexpr size_t OFF_KPE = OFF_KN + (size_t)MPAD * 512 * 2;
constexpr size_t OFF_VMT = OFF_KPE + (size_t)MPAD * 32 * 2;
constexpr size_t OFF_QG = OFF_VMT + (size_t)MPAD * 512 * 2;
constexpr size_t OFF_KG = OFF_QG + (size_t)MPAD * 512 * 2;
constexpr size_t OFF_VGT = OFF_KG + (size_t)MPAD * 128 * 2;
constexpr size_t OFF_END = OFF_VGT + (size_t)MPAD * 128 * 2;
constexpr size_t OFF_U = OFF_CQ;
static_assert(OFF_U + (size_t)259 * 128 * 4096 * 2 <= OFF_END, "U fits");
static_assert(OFF_END <= 536870912ull, "workspace");

struct Params {
  const float* xp; const float* xs; const float* meta;
  const float* attn_g; const float* w_in; const float* qa_g; const float* w_qb; const float* kva_g; const float* w_kvb;
  const float* gq_g; const float* gk_g; const float* mo_g; const float* go_g; const float* w_out; const float* mlp_g;
  const float* w_up; const float* w_dn; const float* fin_g;
  float* out; char* ws;
  int phase_lo, phase_hi, probe, pad_;
};

DI unsigned pack2(float a, float b) { f32x2v f = {a, b}; bf16x2v v = __builtin_convertvector(f, bf16x2v); return __builtin_bit_cast(unsigned, v); }
DI u16 f2bf(float a) { return (u16)(pack2(a, 0.f) & 0xffffu); }
DI void store4(u16* dst, float a, float b, float c, float d) { u32x2 v = {pack2(a, b), pack2(c, d)}; *(u32x2*)dst = v; }
DI int crow(int i, int h) { return (i & 3) + 8 * (i >> 2) + 4 * h; }
DI int swap23(int r) { return (r & 0x13) | ((r & 4) << 1) | ((r & 8) >> 1); }
DI float xhalf(float v) { return __shfl_xor(v, 32); }

DI void decode_tile(int T, int& seq, int& i) {
  if (T < 258) { seq = (T >= 129) ? 1 : 0; i = T - seq * 129; }
  else { int u = T - 258; int q = u / 65; seq = 2 + q; i = u - q * 65; }
}
DI int seq_base(int seq) { return seq < 2 ? seq * 16512 : 33024 + (seq - 2) * 8320; }

DI const float* xrow_src(const Params& p, int g, bool from_input) {
  int T = g >> 7, r = g & 127, seq, i; decode_tile(T, seq, i);
  if (i == 0) {
    if (r < 112) return nullptr;
    return from_input ? p.meta + (size_t)(r - 112) * 1024 : (const float*)(p.ws + OFF_XMETA) + (size_t)(seq * 16 + r - 112) * 1024;
  }
  int j = (i - 1) * 128 + r;
  if (seq < 2) { size_t row = (size_t)seq * 16384 + j; return from_input ? p.xp + row * 1024 : p.out + row * 1024; }
  size_t row = (size_t)(seq - 2) * 8192 + j;
  return from_input ? p.xs + row * 1024 : p.out + (32768 + row) * 1024;
}
DI float* xrow_dst(const Params& p, int g) {
  int T = g >> 7, r = g & 127, seq, i; decode_tile(T, seq, i);
  if (i == 0) {
    if (r < 112) return nullptr;
    return (float*)(p.ws + OFF_XMETA) + (size_t)(seq * 16 + r - 112) * 1024;
  }
  int j = (i - 1) * 128 + r;
  if (seq < 2) { size_t row = (size_t)seq * 16384 + j; return p.out + row * 1024; }
  size_t row = (size_t)(seq - 2) * 8192 + j;
  return p.out + (32768 + row) * 1024;
}

DI int mapcol(int kind, int n) {
  if (kind == 1) { if (n < 640) return n; if (n < 1408) return n + 32; if (n < 1440) return 640 + (n - 1408); return -1; }
  if (kind == 2) { if (n < 512) return (n >> 6) * 96 + (n & 63); int m = n - 512; return (m >> 5) * 96 + 64 + (m & 31); }
  if (kind == 3) { if (n < 512) return (n >> 6) * 128 + (n & 63); int m = n - 512; return (m >> 6) * 128 + 64 + (m & 63); }
  return n;
}
DI void prep_weight(const float* __restrict__ src, int Nsrc, u16* __restrict__ dst, int Nout, int K, const float* gA, const float* gB,
                    int ksplit, int kind, int gtid, int gthreads) {
  const int total = Nout * (K >> 3);
  for (int u = gtid; u < total; u += gthreads) {
    const int n = u % Nout, kc = u / Nout;
    const int col = mapcol(kind, n);
    const int k = kc * 8;
    float v[8];
#pragma unroll
    for (int j = 0; j < 8; ++j) {
      float x = 0.f;
      if (col >= 0) {
        x = src[(size_t)(k + j) * Nsrc + col];
        if (gA) x *= (k + j < ksplit) ? gA[k + j] : gB[k + j - ksplit];
      }
      v[j] = x;
    }
    u32x4 o = {pack2(v[0], v[1]), pack2(v[2], v[3]), pack2(v[4], v[5]), pack2(v[6], v[7])};
    *(u32x4*)(dst + (size_t)n * K + k) = o;
  }
}

DI void phase_prep(const Params& p, int tid) {
  const int gtid = blockIdx.x * 256 + tid, gthreads = gridDim.x * 256;
  u16* W = (u16*)(p.ws + OFF_W);
  for (int l = 0; l < 2; ++l) {
    u16* Wl = W + (size_t)l * W_LAYER;
    prep_weight(p.w_in + (size_t)l * 1024 * 1440, 1440, Wl + WO_IN, 1536, 1024, nullptr, nullptr, 0, 1, gtid, gthreads);
    prep_weight(p.w_qb + (size_t)l * 384 * 768, 768, Wl + WO_QB, 768, 384, p.qa_g + l * 384, p.qa_g + l * 384, 384, 2, gtid, gthreads);
    prep_weight(p.w_kvb + (size_t)l * 256 * 1024, 1024, Wl + WO_KVB, 1024, 256, p.kva_g + l * 256, p.kva_g + l * 256, 256, 3, gtid, gthreads);
    prep_weight(p.w_out + (size_t)l * 1024 * 1024, 1024, Wl + WO_OUT, 1024, 1024, p.mo_g + l * 512, p.go_g + l * 512, 512, 0, gtid, gthreads);
    prep_weight(p.w_up + (size_t)l * 1024 * 4096, 4096, Wl + WO_UP, 4096, 1024, nullptr, nullptr, 0, 0, gtid, gthreads);
    prep_weight(p.w_dn + (size_t)l * 4096 * 1024, 1024, Wl + WO_DN, 1024, 4096, nullptr, nullptr, 0, 0, gtid, gthreads);
  }
  float2* tab = (float2*)(p.ws + OFF_TAB);
  for (int u = gtid; u < 16400 * 16; u += gthreads) {
    const int pos = u >> 4, f = u & 15;
    const float invf = 1.0f / powf(10000.0f, (float)(2 * f) / 32.0f);
    const float ang = (float)pos * invf;
    const double rev = (double)ang * 0.15915494309189535;
    const double fr = rev - rint(rev);
    const float x = (float)(2.0 * fr);
    tab[u] = make_float2(cospif(x), sinpif(x));
  }
  float* xm = (float*)(p.ws + OFF_XMETA);
  for (int u = gtid; u < 96 * 1024; u += gthreads) xm[u] = p.meta[u & 16383];
  int* cnt = (int*)(p.ws + OFF_CNT);
  if (gtid < 64) cnt[gtid] = 0;
}

DI void phase_norm(const Params& p, const float* __restrict__ gain, bool from_input, bool zero_ssq, int tid) {
  const int lane = tid & 63;
  const int gw = blockIdx.x * 4 + (tid >> 6), nw = gridDim.x * 4;
  u16* HN = (u16*)(p.ws + OFF_HN);
  float* ssq = (float*)(p.ws + OFF_SSQ);
  for (int g = gw; g < MPAD; g += nw) {
    const float* xr = xrow_src(p, g, from_input);
    u16* hr = HN + (size_t)g * 1024;
    if (!xr) {
      u32x4 z = {0u, 0u, 0u, 0u};
      *(u32x4*)(hr + lane * 16) = z;
      *(u32x4*)(hr + lane * 16 + 8) = z;
    } else {
      float4 v[4];
#pragma unroll
      for (int q = 0; q < 4; ++q) v[q] = ((const float4*)xr)[lane + 64 * q];
      float ss = 0.f;
#pragma unroll
      for (int q = 0; q < 4; ++q) ss += v[q].x * v[q].x + v[q].y * v[q].y + v[q].z * v[q].z + v[q].w * v[q].w;
#pragma unroll
      for (int o = 32; o >= 1; o >>= 1) ss += __shfl_xor(ss, o);
      const float rstd = rsqrtf(ss * (1.0f / 1024.0f) + EPS);
#pragma unroll
      for (int q = 0; q < 4; ++q) {
        const float4 gg = ((const float4*)gain)[lane + 64 * q];
        store4(hr + 4 * (lane + 64 * q), v[q].x * rstd * gg.x, v[q].y * rstd * gg.y, v[q].z * rstd * gg.z, v[q].w * rstd * gg.w);
      }
    }
    if (zero_ssq && lane < 4) ssq[(size_t)lane * MPAD + g] = 0.f;
  }
}

DI void phase_final(const Params& p, int tid) {
  const int lane = tid & 63;
  const int gw = blockIdx.x * 4 + (tid >> 6), nw = gridDim.x * 4;
  for (int g = gw; g < MPAD; g += nw) {
    if (((g >> 7) == 0) || ((g >> 7) == 129) || ((g >> 7) >= 258 && ((g >> 7) - 258) % 65 == 0)) continue;
    float* xr = xrow_dst(p, g);
    float4 v[4];
#pragma unroll
    for (int q = 0; q < 4; ++q) v[q] = ((const float4*)xr)[lane + 64 * q];
    float ss = 0.f;
#pragma unroll
    for (int q = 0; q < 4; ++q) ss += v[q].x * v[q].x + v[q].y * v[q].y + v[q].z * v[q].z + v[q].w * v[q].w;
#pragma unroll
    for (int o = 32; o >= 1; o >>= 1) ss += __shfl_xor(ss, o);
    const float rstd = rsqrtf(ss * (1.0f / 1024.0f) + EPS);
#pragma unroll
    for (int q = 0; q < 4; ++q) {
      const float4 gg = ((const float4*)p.fin_g)[lane + 64 * q];
      float4 o = make_float4(v[q].x * rstd * gg.x, v[q].y * rstd * gg.y, v[q].z * rstd * gg.z, v[q].w * rstd * gg.w);
      ((float4*)xr)[lane + 64 * q] = o;
    }
  }
}

constexpr int GP = 72;
struct APLin { const u16* A; int lda; DI const u16* ptr(int row, int k0) const { return A + (size_t)row * lda + k0; } };
struct APMix { const u16* QM; const u16* QG;
  DI const u16* ptr(int row, int k0) const { return k0 < 512 ? QM + (size_t)row * 768 + (k0 >> 6) * 96 : QG + (size_t)row * 512 + (k0 - 512); } };

template <bool MIDK, class AP, class EPI>
DI void gemm_tile(const AP& ap, const u16* __restrict__ W, int ldw, int K, int m0, int n0, const EPI& epi, char* smem, float r0, float r1, int tid, bool dry) {
  u16* sA = (u16*)smem;
  u16* sB = sA + 128 * GP;
  const int lane = tid & 63, wave = tid >> 6, r = lane & 31, h = lane >> 5, wm = wave >> 1, wn = wave & 1;
  const int lrow = tid >> 3, lkc = (tid & 7) * 8;
  u32x4 ra[4], rb[4];
  f32x16 acc[2][2];
#pragma unroll
  for (int a = 0; a < 2; ++a)
#pragma unroll
    for (int b = 0; b < 2; ++b)
#pragma unroll
      for (int i = 0; i < 16; ++i) acc[a][b][i] = 0.f;
  const int nk = K >> 6;
#pragma unroll
  for (int q = 0; q < 4; ++q) {
    ra[q] = *(const u32x4*)(ap.ptr(m0 + lrow + 32 * q, 0) + lkc);
    rb[q] = *(const u32x4*)(W + (size_t)(n0 + lrow + 32 * q) * ldw + lkc);
  }
  for (int kt = 0; kt < nk; ++kt) {
    __syncthreads();
#pragma unroll
    for (int q = 0; q < 4; ++q) {
      *(u32x4*)(sA + (lrow + 32 * q) * GP + lkc) = ra[q];
      *(u32x4*)(sB + (lrow + 32 * q) * GP + lkc) = rb[q];
    }
    __syncthreads();
    if (kt + 1 < nk) {
      const int k0 = (kt + 1) << 6;
#pragma unroll
      for (int q = 0; q < 4; ++q) {
        ra[q] = *(const u32x4*)(ap.ptr(m0 + lrow + 32 * q, k0) + lkc);
        rb[q] = *(const u32x4*)(W + (size_t)(n0 + lrow + 32 * q) * ldw + k0 + lkc);
      }
    }
#pragma unroll
    for (int ks = 0; ks < 4; ++ks) {
      bf16x8 wf[2], xf[2];
#pragma unroll
      for (int a = 0; a < 2; ++a) {
        wf[a] = *(const bf16x8*)(sB + (wn * 64 + a * 32 + r) * GP + ks * 16 + h * 8);
        xf[a] = *(const bf16x8*)(sA + (wm * 64 + a * 32 + r) * GP + ks * 16 + h * 8);
      }
#pragma unroll
      for (int a = 0; a < 2; ++a)
#pragma unroll
        for (int b = 0; b < 2; ++b) acc[a][b] = MFMA(wf[a], xf[b], acc[a][b]);
    }
    if (MIDK && kt == 7) {
#pragma unroll
      for (int a = 0; a < 2; ++a)
#pragma unroll
        for (int i = 0; i < 16; ++i) { acc[a][0][i] *= r0; acc[a][1][i] *= r1; }
    }
  }
  __syncthreads();
  if (!dry) epi(acc, n0 + wn * 64, m0 + wm * 64, lane, (u16*)smem + wave * 64 * GP);
}

struct ColId { DI int operator()(int ch) const { return ch * 8; } };
struct ColRope { DI int operator()(int ch) const { return (ch >> 2) * 96 + (ch & 3) * 8; } };

template <class COLF>
DI void stage_store(f32x16 (&acc)[2][2], u16* wl, int lane, u16* dst0, size_t pitch, const COLF& colf) {
  const int r = lane & 31, h = lane >> 5;
#pragma unroll
  for (int rb = 0; rb < 2; ++rb)
#pragma unroll
    for (int lb = 0; lb < 2; ++lb)
#pragma unroll
      for (int g4 = 0; g4 < 4; ++g4)
        store4(wl + (lb * 32 + r) * GP + rb * 32 + 8 * g4 + 4 * h, acc[rb][lb][4 * g4], acc[rb][lb][4 * g4 + 1], acc[rb][lb][4 * g4 + 2], acc[rb][lb][4 * g4 + 3]);
  WAVE_LDS_FENCE();
#pragma unroll
  for (int it = 0; it < 8; ++it) {
    const int row = it * 8 + (lane >> 3), ch = lane & 7;
    const u32x4 v = *(const u32x4*)(wl + row * GP + ch * 8);
    *(u32x4*)(dst0 + (size_t)row * pitch + colf(ch)) = v;
  }
  WAVE_LDS_FENCE();
}

DI void rope16(float (&v)[16], const float2* __restrict__ tabrow, int h) {
#pragma unroll
  for (int i = 0; i < 8; ++i) {
    const int f = (i & 3) + 8 * (i >> 2) + 4 * h;
    const float2 cs = tabrow[f];
    const float x1 = v[i], x2 = v[i + 8];
    v[i] = x1 * cs.x - x2 * cs.y;
    v[i + 8] = x2 * cs.x + x1 * cs.y;
  }
}

struct EpiIn {
  u16 *CQ, *CKV, *QG, *KG, *VGT, *KPE; float *ssq_q, *ssq_kv; const float *gq_g, *gk_g; const float2* tab;
  DI void operator()(f32x16 (&acc)[2][2], int nb, int mb, int lane, u16* wl) const {
    const int r = lane & 31, h = lane >> 5;
    int seq, it; decode_tile(mb >> 7, seq, it);
#pragma unroll
    for (int ti = 0; ti < 2; ++ti) {
      const int g = mb + ti * 32 + r, rr = g & 127;
      if (nb < 640) {
        float ss = 0.f;
#pragma unroll
        for (int fi = 0; fi < 2; ++fi)
#pragma unroll
          for (int i = 0; i < 16; ++i) ss += acc[fi][ti][i] * acc[fi][ti][i];
        ss += xhalf(ss);
        if (h == 0) unsafeAtomicAdd((nb < 384 ? ssq_q : ssq_kv) + g, ss);
      } else if (nb < 1280) {
        const bool isq = nb < 1152;
        const float* gg = isq ? gq_g : gk_g;
        float ss = 0.f;
#pragma unroll
        for (int fi = 0; fi < 2; ++fi)
#pragma unroll
          for (int i = 0; i < 16; ++i) ss += acc[fi][ti][i] * acc[fi][ti][i];
        ss += xhalf(ss);
        const float rstd = rsqrtf(ss * (1.0f / 64.0f) + EPS);
        const float osc = isq ? QSCALE_G : 1.0f;
        int prow = 0, pcol = 0;
        if (it > 0) { const int j = (it - 1) * 128 + rr; prow = j >> 6; pcol = j & 63; }
        u16* dst = isq ? QG + (size_t)g * 512 + (nb - 640) : KG + (size_t)g * 128 + (nb - 1152);
#pragma unroll
        for (int fi = 0; fi < 2; ++fi) {
          const int pos = fi == 0 ? prow : pcol;
          float v[16];
#pragma unroll
          for (int i = 0; i < 16; ++i) v[i] = acc[fi][ti][i] * rstd * gg[fi * 32 + crow(i, h)];
          rope16(v, tab + pos * 16, h);
#pragma unroll
          for (int g4 = 0; g4 < 4; ++g4)
            store4(dst + fi * 32 + 8 * g4 + 4 * h, v[4 * g4] * osc, v[4 * g4 + 1] * osc, v[4 * g4 + 2] * osc, v[4 * g4 + 3] * osc);
        }
      } else if (nb < 1408) {
#pragma unroll
        for (int fi = 0; fi < 2; ++fi)
#pragma unroll
          for (int i = 0; i < 16; ++i) VGT[(size_t)(nb - 1280 + fi * 32 + crow(i, h)) * MPAD + g] = f2bf(acc[fi][ti][i]);
      } else if (nb == 1408) {
        int pos = 128 * it + rr - 112; pos = pos < 0 ? 0 : pos;
        float v[16];
#pragma unroll
        for (int i = 0; i < 16; ++i) v[i] = acc[0][ti][i];
        rope16(v, tab + pos * 16, h);
#pragma unroll
        for (int g4 = 0; g4 < 4; ++g4) store4(KPE + (size_t)g * 32 + 8 * g4 + 4 * h, v[4 * g4], v[4 * g4 + 1], v[4 * g4 + 2], v[4 * g4 + 3]);
      }
    }
    if (nb < 384) stage_store(acc, wl, lane, CQ + (size_t)mb * 384 + nb, 384, ColId());
    else if (nb < 640) stage_store(acc, wl, lane, CKV + (size_t)mb * 256 + (nb - 384), 256, ColId());
  }
};

struct EpiQB {
  u16* QM; const float* ssq_q; const float2* tab;
  DI void operator()(f32x16 (&acc)[2][2], int nb, int mb, int lane, u16* wl) const {
    const int r = lane & 31, h = lane >> 5;
    int seq, it; decode_tile(mb >> 7, seq, it);
#pragma unroll
    for (int ti = 0; ti < 2; ++ti) {
      const int g = mb + ti * 32 + r, rr = g & 127;
      const float sc = rsqrtf(ssq_q[g] * (1.0f / 384.0f) + EPS) * QSCALE_M;
      if (nb < 512) {
#pragma unroll
        for (int fi = 0; fi < 2; ++fi)
#pragma unroll
          for (int i = 0; i < 16; ++i) acc[fi][ti][i] *= sc;
      } else {
        int pos = 128 * it + rr - 112; pos = pos < 0 ? 0 : pos;
#pragma unroll
        for (int fi = 0; fi < 2; ++fi) {
          float v[16];
#pragma unroll
          for (int i = 0; i < 16; ++i) v[i] = acc[fi][ti][i] * sc;
          rope16(v, tab + pos * 16, h);
#pragma unroll
          for (int i = 0; i < 16; ++i) acc[fi][ti][i] = v[i];
        }
      }
    }
    if (nb < 512) stage_store(acc, wl, lane, QM + (size_t)mb * 768 + (nb >> 6) * 96, 768, ColId());
    else stage_store(acc, wl, lane, QM + (size_t)mb * 768 + ((nb - 512) >> 5) * 96 + 64, 768, ColRope());
  }
};

struct EpiKVB {
  u16 *KN, *VMT; const float* ssq_kv;
  DI void operator()(f32x16 (&acc)[2][2], int nb, int mb, int lane, u16* wl) const {
    const int r = lane & 31, h = lane >> 5;
#pragma unroll
    for (int ti = 0; ti < 2; ++ti) {
      const int g = mb + ti * 32 + r;
      const float sc = rsqrtf(ssq_kv[g] * (1.0f / 256.0f) + EPS);
      if (nb < 512) {
#pragma unroll
        for (int fi = 0; fi < 2; ++fi)
#pragma unroll
          for (int i = 0; i < 16; ++i) acc[fi][ti][i] *= sc;
      } else {
#pragma unroll
        for (int fi = 0; fi < 2; ++fi)
#pragma unroll
          for (int i = 0; i < 16; ++i) VMT[(size_t)(nb - 512 + fi * 32 + crow(i, h)) * MPAD + g] = f2bf(acc[fi][ti][i] * sc);
      }
    }
    if (nb < 512) stage_store(acc, wl, lane, KN + (size_t)mb * 512 + nb, 512, ColId());
  }
};

DI void res_bases(const Params& p, int mt, bool from_input, const float*& sb, float*& db, int& minrow) {
  int seq, it; decode_tile(mt, seq, it);
  float* xm = (float*)(p.ws + OFF_XMETA);
  if (it == 0) {
    minrow = 112;
    db = xm + ((ptrdiff_t)seq * 16 - 112) * 1024;
    sb = from_input ? p.meta - 112 * 1024 : db;
  } else {
    minrow = 0;
    const size_t row = seq < 2 ? (size_t)seq * 16384 + (size_t)(it - 1) * 128 : 32768 + (size_t)(seq - 2) * 8192 + (size_t)(it - 1) * 128;
    db = p.out + row * 1024;
    sb = from_input ? (seq < 2 ? p.xp + row * 1024 : p.xs + (row - 32768) * 1024) : db;
  }
}

struct EpiRes {
  const float* sb; float* db; int minrow; float fin0, fin1;
  DI void operator()(f32x16 (&acc)[2][2], int nb, int mb, int lane, u16* wl) const {
    const int r = lane & 31, h = lane >> 5, mbl = mb & 127;
    float* wf = (float*)wl;
#pragma unroll
    for (int fi = 0; fi < 2; ++fi) {
#pragma unroll
      for (int ti = 0; ti < 2; ++ti) {
        const float sc = ti == 0 ? fin0 : fin1;
#pragma unroll
        for (int g4 = 0; g4 < 4; ++g4) {
          float4 o = make_float4(acc[fi][ti][4 * g4] * sc, acc[fi][ti][4 * g4 + 1] * sc, acc[fi][ti][4 * g4 + 2] * sc, acc[fi][ti][4 * g4 + 3] * sc);
          *(float4*)(wf + (ti * 32 + r) * 36 + 8 * g4 + 4 * h) = o;
        }
      }
      WAVE_LDS_FENCE();
#pragma unroll
      for (int it = 0; it < 8; ++it) {
        const int row = it * 8 + (lane >> 3), ch = lane & 7;
        const float4 a = *(const float4*)(wf + row * 36 + ch * 4);
        const int trow = mbl + row;
        if (trow >= minrow) {
          const size_t off = (size_t)trow * 1024 + nb + fi * 32 + ch * 4;
          float4 x = *(const float4*)(sb + off);
          x.x += a.x; x.y += a.y; x.z += a.z; x.w += a.w;
          *(float4*)(db + off) = x;
        }
      }
      WAVE_LDS_FENCE();
    }
  }
};

struct EpiUp {
  u16* U0;
  DI void operator()(f32x16 (&acc)[2][2], int nb, int mb, int lane, u16* wl) const {
#pragma unroll
    for (int ti = 0; ti < 2; ++ti)
#pragma unroll
      for (int fi = 0; fi < 2; ++fi)
#pragma unroll
        for (int i = 0; i < 16; ++i) { const float a = fmaxf(acc[fi][ti][i], 0.f); acc[fi][ti][i] = a * a; }
    stage_store(acc, wl, lane, U0 + (size_t)mb * 4096 + nb, 4096, ColId());
  }
};

constexpr float ATT_THR = 8.0f;

template <int DQK>
struct AttnCtx {
  static constexpr int KP = DQK + 8, NKS = DQK / 16, KCH = DQK / 8, NKL = 64 * KCH / 256, KBUF = 64 * KP, VBUF = 64 * GP;
  const u16 *Kb, *KPEb, *Vt; int kpitch, rowk0, nt, tid, r, h, sr;
  u16 *sK, *sV;
  bf16x8 qf[NKS];
  f32x16 o[2];
  float mref, l;
  u32x4 rk[NKL], rv[2];

  int koff[NKL], voff[2];
  DI void init_offs() {
#pragma unroll
    for (int q = 0; q < NKL; ++q) {
      const int c = tid + 256 * q, row = c / KCH, cc = c % KCH;
      koff[q] = (DQK == 96 && cc >= 8) ? row * 32 + (cc - 8) * 8 : row * kpitch + cc * 8;
    }
#pragma unroll
    for (int q = 0; q < 2; ++q) { const int c = tid + 256 * q, dv = c >> 3, kc = c & 7; voff[q] = dv * MPAD + kc * 8; }
  }
  DI void gload_k(int t) {
    const int row0 = rowk0 + t * 64;
    const u16* kt = Kb + (size_t)row0 * kpitch;
    const u16* pt = KPEb + (size_t)row0 * 32;
#pragma unroll
    for (int q = 0; q < NKL; ++q) {
      const int c = tid + 256 * q, cc = c % KCH;
      rk[q] = *(const u32x4*)(((DQK == 96 && cc >= 8) ? pt : kt) + koff[q]);
    }
  }
  DI void gload_v(int t) {
    const u16* vt = Vt + (rowk0 + t * 64);
#pragma unroll
    for (int q = 0; q < 2; ++q) rv[q] = *(const u32x4*)(vt + voff[q]);
  }
  DI void sstore_k(int buf) {
#pragma unroll
    for (int q = 0; q < NKL; ++q) {
      const int c = tid + 256 * q, row = c / KCH, cc = c % KCH;
      *(u32x4*)(sK + buf * KBUF + row * KP + cc * 8) = rk[q];
    }
  }
  DI void sstore_v(int buf) {
#pragma unroll
    for (int q = 0; q < 2; ++q) {
      const int c = tid + 256 * q, dv = c >> 3, kc = c & 7;
      *(u32x4*)(sV + buf * VBUF + dv * GP + kc * 8) = rv[q];
    }
  }
  DI void qk(int buf, f32x16 (&s)[2]) {
    const u16* kb = sK + buf * KBUF + sr * KP + h * 8;
#pragma unroll
    for (int kb2 = 0; kb2 < 2; ++kb2) {
#pragma unroll
      for (int i = 0; i < 16; ++i) s[kb2][i] = 0.f;
#pragma unroll
      for (int ks = 0; ks < NKS; ++ks) {
        const bf16x8 a = *(const bf16x8*)(kb + kb2 * 32 * KP + ks * 16);
        s[kb2] = MFMA(a, qf[ks], s[kb2]);
      }
    }
  }
  template <int PAR>
  DI void step(int t, f32x16 (&cur)[2], f32x16 (&nxt)[2]) {
    if (t + 1 < nt) { sstore_k(PAR ^ 1); gload_v(t + 1); }
    __syncthreads();
    if (t + 1 < nt) qk(PAR ^ 1, nxt);
    float mx = fmaxf(cur[0][0], cur[1][0]);
#pragma unroll
    for (int i = 1; i < 16; ++i) mx = fmaxf(fmaxf(cur[0][i], cur[1][i]), mx);
    if (__builtin_amdgcn_ballot_w64(mx > mref + ATT_THR) != 0ull) {
      mx = fmaxf(mx, xhalf(mx));
      const float mn = fmaxf(mref, mx);
      const float alpha = __builtin_amdgcn_exp2f(mref - mn);
      mref = mn;
      l *= alpha;
#pragma unroll
      for (int a = 0; a < 2; ++a)
#pragma unroll
        for (int i = 0; i < 16; ++i) o[a][i] *= alpha;
    }
    float psum = 0.f;
#pragma unroll
    for (int kb2 = 0; kb2 < 2; ++kb2)
#pragma unroll
      for (int i = 0; i < 16; ++i) { const float pv = __builtin_amdgcn_exp2f(cur[kb2][i] - mref); cur[kb2][i] = pv; psum += pv; }
    l += psum;
    if (t + 2 < nt) gload_k(t + 2);
    const u16* vb = sV + PAR * VBUF + r * GP + h * 8;
#pragma unroll
    for (int kb2 = 0; kb2 < 2; ++kb2)
#pragma unroll
      for (int s2 = 0; s2 < 2; ++s2) {
        u32x4 pk = {pack2(cur[kb2][8 * s2], cur[kb2][8 * s2 + 1]), pack2(cur[kb2][8 * s2 + 2], cur[kb2][8 * s2 + 3]),
                    pack2(cur[kb2][8 * s2 + 4], cur[kb2][8 * s2 + 5]), pack2(cur[kb2][8 * s2 + 6], cur[kb2][8 * s2 + 7])};
        const bf16x8 pf = __builtin_bit_cast(bf16x8, pk);
#pragma unroll
        for (int db = 0; db < 2; ++db) {
          const bf16x8 a = *(const bf16x8*)(vb + db * 32 * GP + kb2 * 32 + s2 * 16);
          o[db] = MFMA(a, pf, o[db]);
        }
      }
    if (t + 1 < nt) sstore_v(PAR ^ 1);
  }
};

template <int DQK>
DI void attn_item(const u16* __restrict__ Qb, int qpitch, const u16* __restrict__ Kb, int kpitch, const u16* __restrict__ KPEb,
                  const u16* __restrict__ Vt, float* __restrict__ ssq, int rowq0, int rowk0, int nt, char* smem, int tid, bool dry) {
  typedef AttnCtx<DQK> C;
  C c;
  const int lane = tid & 63, wave = tid >> 6, r = lane & 31, h = lane >> 5;
  c.Kb = Kb; c.KPEb = KPEb; c.Vt = Vt; c.kpitch = kpitch; c.rowk0 = rowk0; c.nt = nt; c.tid = tid; c.r = r; c.h = h; c.sr = swap23(r);
  c.sK = (u16*)smem; c.sV = c.sK + 2 * C::KBUF;
  c.init_offs();
  const int myrow = rowq0 + wave * 32 + r;
  {
    const u16* qrow = Qb + (size_t)myrow * qpitch + h * 8;
#pragma unroll
    for (int ks = 0; ks < C::NKS; ++ks) c.qf[ks] = *(const bf16x8*)(qrow + ks * 16);
  }
#pragma unroll
  for (int a = 0; a < 2; ++a)
#pragma unroll
    for (int i = 0; i < 16; ++i) c.o[a][i] = 0.f;
  c.mref = -1e30f; c.l = 0.f;
  f32x16 sa[2], sb[2];
  c.gload_k(0); c.gload_v(0);
  __syncthreads();
  c.sstore_k(0); c.sstore_v(0);
  if (nt > 1) c.gload_k(1);
  __syncthreads();
  c.qk(0, sa);
#pragma unroll
  for (int i = 0; i < 16; ++i) {
    sa[0][i] = -1e30f;
    if (swap23(crow(i, h)) < 16) sa[1][i] = -1e30f;
  }
  int t = 0;
  for (; t + 1 < nt; t += 2) {
    c.template step<0>(t, sa, sb);
    c.template step<1>(t + 1, sb, sa);
  }
  if (t < nt) c.template step<0>(t, sa, sb);
  if (dry) return;
  float l = c.l;
  l += xhalf(l);
  const float inv = 1.0f / l;
  float ss = 0.f;
  u16* orow = (u16*)Qb + (size_t)myrow * qpitch;
#pragma unroll
  for (int db = 0; db < 2; ++db)
#pragma unroll
    for (int g4 = 0; g4 < 4; ++g4) {
      const float a0 = c.o[db][4 * g4] * inv, a1 = c.o[db][4 * g4 + 1] * inv, a2 = c.o[db][4 * g4 + 2] * inv, a3 = c.o[db][4 * g4 + 3] * inv;
      ss += a0 * a0 + a1 * a1 + a2 * a2 + a3 * a3;
      store4(orow + db * 32 + 8 * g4 + 4 * h, a0, a1, a2, a3);
    }
  ss += xhalf(ss);
  if (h == 0) unsafeAtomicAdd(ssq + myrow, ss);
}

constexpr int N_ITEMS = 8288;
DI void phase_attn(const Params& p, int layer, char* smem, int* s_item, int tid, bool dry) {
  int* cnt = (int*)(p.ws + OFF_CNT) + layer + (dry ? 2 : 0);
  u16* QM = (u16*)(p.ws + OFF_HN);
  const u16* KN = (const u16*)(p.ws + OFF_KN);
  const u16* KPE = (const u16*)(p.ws + OFF_KPE);
  const u16* VMT = (const u16*)(p.ws + OFF_VMT);
  u16* QG = (u16*)(p.ws + OFF_QG);
  const u16* KG = (const u16*)(p.ws + OFF_KG);
  const u16* VGT = (const u16*)(p.ws + OFF_VGT);
  float* ssq = (float*)(p.ws + OFF_SSQ);
  for (;;) {
    if (tid == 0) *s_item = atomicAdd(cnt, 1);
    __syncthreads();
    const int it = *s_item;
    __syncthreads();
    if (it >= N_ITEMS) break;
    int grp, seq, head, qi, nt;
    if (it < 4128) { grp = it / 2064; const int u = it - grp * 2064; const int sh = u / 129; qi = u - sh * 129; seq = sh >> 3; head = sh & 7; nt = 257; }
    else { const int u0 = it - 4128; grp = u0 / 2080; const int u = u0 - grp * 2080; const int sh = u / 65; qi = u - sh * 65; seq = 2 + (sh >> 3); head = sh & 7; nt = 129; }
    const int P = seq_base(seq);
    if (grp == 0)
      attn_item<96>(QM + head * 96, 768, KN + head * 64, 512, KPE, VMT + (size_t)head * 64 * MPAD, ssq + 2 * (size_t)MPAD, P + qi * 128, P + 64, nt, smem, tid, dry);
    else
      attn_item<64>(QG + head * 64, 512, KG + (head >> 2) * 64, 128, nullptr, VGT + (size_t)(head >> 2) * 64 * MPAD, ssq + 3 * (size_t)MPAD, P + qi * 128, P + 64, nt, smem, tid, dry);
  }
}

__global__ void __launch_bounds__(256, 2) mega(Params pin) {
  __shared__ __attribute__((aligned(16))) char smem[2 * 64 * 104 * 2 + 2 * 64 * GP * 2];
  __shared__ int s_item;
  const int G = gridDim.x, b = blockIdx.x;
  const int vb = ((G & 7) == 0) ? ((b & 7) * (G >> 3) + (b >> 3)) : b;
  for (int st = pin.phase_lo; st < pin.phase_hi; ++st) {
    int ph; bool dry = false;
    if (st == 0) ph = 0;
    else if (st == 41) ph = 21;
    else {
      const int u = st - 1, lay = u / 20, v = u - lay * 20, sb = v >> 1;
      dry = (v & 1) == 0;
      if (dry && !((pin.probe >> sb) & 1)) continue;
      ph = 1 + lay * 10 + sb;
    }
    if (st > pin.phase_lo) cg::this_grid().sync();
    Params p = pin;
    asm volatile("" : "+s"(p.xp), "+s"(p.xs), "+s"(p.meta), "+s"(p.attn_g), "+s"(p.w_in), "+s"(p.qa_g), "+s"(p.w_qb), "+s"(p.kva_g), "+s"(p.w_kvb), "+s"(p.gq_g));
    asm volatile("" : "+s"(p.gk_g), "+s"(p.mo_g), "+s"(p.go_g), "+s"(p.w_out), "+s"(p.mlp_g), "+s"(p.w_up), "+s"(p.w_dn), "+s"(p.fin_g), "+s"(p.out), "+s"(p.ws));
    int tid = threadIdx.x;
    asm volatile("" : "+v"(tid));
    const int lane = tid & 63, wave = tid >> 6, r = lane & 31;
    float* ssq = (float*)(p.ws + OFF_SSQ);
    const float2* tab = (const float2*)(p.ws + OFF_TAB);
    if (ph == 0) { phase_prep(p, tid); continue; }
    if (ph == 21) { phase_final(p, tid); continue; }
    const int layer = (ph - 1) / 10, sub = (ph - 1) % 10;
    const u16* Wl = (const u16*)(p.ws + OFF_W) + (size_t)layer * W_LAYER;
    if (sub == 0) {
      phase_norm(p, p.attn_g + layer * 1024, layer == 0, true, tid);
    } else if (sub == 1) {
      EpiIn e; e.CQ = (u16*)(p.ws + OFF_CQ); e.CKV = (u16*)(p.ws + OFF_CKV); e.QG = (u16*)(p.ws + OFF_QG); e.KG = (u16*)(p.ws + OFF_KG);
      e.VGT = (u16*)(p.ws + OFF_VGT); e.KPE = (u16*)(p.ws + OFF_KPE); e.ssq_q = ssq; e.ssq_kv = ssq + MPAD;
      e.gq_g = p.gq_g + layer * 64; e.gk_g = p.gk_g + layer * 64; e.tab = tab;
      APLin ap{(const u16*)(p.ws + OFF_HN), 1024};
      for (int t = vb; t < NTM * 12; t += G) { const int mt = t / 12, nt = t - mt * 12; gemm_tile<false>(ap, Wl + WO_IN, 1024, 1024, mt * 128, nt * 128, e, smem, 1.f, 1.f, tid, dry); }
    } else if (sub == 2) {
      EpiQB e2; e2.QM = (u16*)(p.ws + OFF_HN); e2.ssq_q = ssq; e2.tab = tab;
      EpiKVB e3; e3.KN = (u16*)(p.ws + OFF_KN); e3.VMT = (u16*)(p.ws + OFF_VMT); e3.ssq_kv = ssq + MPAD;
      APLin a2{(const u16*)(p.ws + OFF_CQ), 384};
      APLin a3{(const u16*)(p.ws + OFF_CKV), 256};
      for (int t = vb; t < NTM * 14; t += G) {
        if (t < NTM * 6) { const int mt = t / 6, nt = t - mt * 6; gemm_tile<false>(a2, Wl + WO_QB, 384, 384, mt * 128, nt * 128, e2, smem, 1.f, 1.f, tid, dry); }
        else { const int u = t - NTM * 6; const int mt = u >> 3, nt = u & 7; gemm_tile<false>(a3, Wl + WO_KVB, 256, 256, mt * 128, nt * 128, e3, smem, 1.f, 1.f, tid, dry); }
      }
    } else if (sub == 3) {
      phase_attn(p, layer, smem, &s_item, tid, dry);
    } else if (sub == 4) {
      APMix ap{(const u16*)(p.ws + OFF_HN), (const u16*)(p.ws + OFF_QG)};
      for (int t = vb; t < NTM * 8; t += G) {
        const int mt = t >> 3, nt = t & 7;
        const int g0 = mt * 128 + (wave >> 1) * 64 + r;
        const float ra0 = rsqrtf(ssq[2 * (size_t)MPAD + g0] * (1.0f / 512.0f) + EPS), rg0 = rsqrtf(ssq[3 * (size_t)MPAD + g0] * (1.0f / 512.0f) + EPS);
        const float ra1 = rsqrtf(ssq[2 * (size_t)MPAD + g0 + 32] * (1.0f / 512.0f) + EPS), rg1 = rsqrtf(ssq[3 * (size_t)MPAD + g0 + 32] * (1.0f / 512.0f) + EPS);
        EpiRes e; res_bases(p, mt, layer == 0, e.sb, e.db, e.minrow); e.fin0 = rg0; e.fin1 = rg1;
        gemm_tile<true>(ap, Wl + WO_OUT, 1024, 1024, mt * 128, nt * 128, e, smem, ra0 / rg0, ra1 / rg1, tid, dry);
      }
    } else if (sub == 5) {
      phase_norm(p, p.mlp_g + layer * 1024, false, false, tid);
    } else if (sub == 6 || sub == 8) {
      const int mh = (sub - 6) >> 1;
      EpiUp e; e.U0 = (u16*)(p.ws + OFF_U) - (size_t)mh * 259 * 128 * 4096;
      APLin ap{(const u16*)(p.ws + OFF_HN), 1024};
      for (int t = vb; t < 259 * 32; t += G) { const int mt = mh * 259 + (t >> 5), nt = t & 31; gemm_tile<false>(ap, Wl + WO_UP, 1024, 1024, mt * 128, nt * 128, e, smem, 1.f, 1.f, tid, dry); }
    } else {
      const int mh = (sub - 7) >> 1;
      APLin ap{(const u16*)(p.ws + OFF_U) - (size_t)mh * 259 * 128 * 4096, 4096};
      for (int t = vb; t < 259 * 8; t += G) {
        const int mt = mh * 259 + (t >> 3), nt = t & 7;
        EpiRes e; res_bases(p, mt, false, e.sb, e.db, e.minrow); e.fin0 = 1.f; e.fin1 = 1.f;
        gemm_tile<false>(ap, Wl + WO_DN, 4096, 4096, mt * 128, nt * 128, e, smem, 1.f, 1.f, tid, dry);
      }
    }
  }
}

extern "C" void kernel_launch(void* const* d_in, const int* in_sizes, int n_in, void* d_out, int out_size, void* d_ws, size_t ws_size,
                              hipStream_t stream) {
  static int grid_blocks = 0;
  if (!grid_blocks) {
    int dev = 0, cus = 0, per_cu = 0;
    hipGetDevice(&dev);
    hipDeviceGetAttribute(&cus, hipDeviceAttributeMultiprocessorCount, dev);
    hipOccupancyMaxActiveBlocksPerMultiprocessor(&per_cu, mega, 256, 0);
    if (per_cu > 2) per_cu = 2;
    if (per_cu < 1) per_cu = 1;
    grid_blocks = cus * per_cu;
  }
  Params p{};
  p.xp = (const float*)d_in[0]; p.xs = (const float*)d_in[1]; p.meta = (const float*)d_in[2];
  p.attn_g = (const float*)d_in[3]; p.w_in = (const float*)d_in[4]; p.qa_g = (const float*)d_in[5]; p.w_qb = (const float*)d_in[6];
  p.kva_g = (const float*)d_in[7]; p.w_kvb = (const float*)d_in[8]; p.gq_g = (const float*)d_in[9]; p.gk_g = (const float*)d_in[10];
  p.mo_g = (const float*)d_in[11]; p.go_g = (const float*)d_in[12]; p.w_out = (const float*)d_in[13]; p.mlp_g = (const float*)d_in[14];
  p.w_up = (const float*)d_in[15]; p.w_dn = (const float*)d_in[16]; p.fin_g = (const float*)d_in[17];
  p.out = (float*)d_out; p.ws = (char*)d_ws;
#if MK_MULTI
  for (int ph = 0; ph < 42; ++ph) {
    p.phase_lo = ph; p.phase_hi = ph + 1; p.probe = PROBE_MASK;
    if (ph > 0 && ph < 41 && ((ph - 1) & 1) == 0 && !((PROBE_MASK >> (((ph - 1) % 20) >> 1)) & 1)) continue;
    hipLaunchKernelGGL(mega, dim3(grid_blocks), dim3(256), 0, stream, p);
  }
#else
  p.phase_lo = 0; p.phase_hi = 42; p.probe = PROBE_MASK;
  void* args[] = {&p};
  hipError_t e = hipLaunchCooperativeKernel((void*)mega, dim3(grid_blocks), dim3(256), args, 0, stream);
  if (e != hipSuccess) fprintf(stderr, "cooperative launch failed: %s (grid %d)\n", hipGetErrorString(e), grid_blocks);
#endif
}
```

```cpp
#include <hip/hip_runtime.h>
#include <hip/hip_cooperative_groups.h>
#include <stdint.h>
#include <cstdio>
namespace cg = cooperative_groups;

#ifndef PROBE_MASK
#define PROBE_MASK 0
#endif
#ifndef MK_MULTI
#define MK_MULTI 0
#endif

typedef unsigned short u16;
typedef short bf16x8 __attribute__((ext_vector_type(8)));
typedef float f32x16 __attribute__((ext_vector_type(16)));
typedef unsigned u32x4 __attribute__((ext_vector_type(4)));
typedef unsigned u32x2 __attribute__((ext_vector_type(2)));
typedef float f32x2v __attribute__((ext_vector_type(2)));
typedef __bf16 bf16x2v __attribute__((ext_vector_type(2)));
#define DI __device__ __forceinline__
#define WAVE_LDS_FENCE() asm volatile("s_waitcnt lgkmcnt(0)" ::: "memory")
#define MFMA(a, b, c) __builtin_amdgcn_mfma_f32_32x32x16_bf16((a), (b), (c), 0, 0, 0)

constexpr int MPAD = 66304;
constexpr int NTM = 518;
constexpr float EPS = 1e-6f;
constexpr float LOG2E = 1.4426950408889634f;
constexpr float QSCALE_M = 0.10206207261596575f * LOG2E;
constexpr float QSCALE_G = 0.125f * LOG2E;

constexpr size_t SZ_WIN = 1536ull * 1024, SZ_WQB = 768ull * 384, SZ_WKVB = 1024ull * 256, SZ_WOUT = 1024ull * 1024,
                 SZ_WUP = 4096ull * 1024, SZ_WDN = 1024ull * 4096;
constexpr size_t WO_IN = 0, WO_QB = WO_IN + SZ_WIN, WO_KVB = WO_QB + SZ_WQB, WO_OUT = WO_KVB + SZ_WKVB, WO_UP = WO_OUT + SZ_WOUT,
                 WO_DN = WO_UP + SZ_WUP, W_LAYER = WO_DN + SZ_WDN;
constexpr size_t OFF_W = 0;
constexpr size_t OFF_TAB = OFF_W + 2 * W_LAYER * 2;
constexpr size_t OFF_XMETA = OFF_TAB + 16400ull * 16 * 8;
constexpr size_t OFF_SSQ = OFF_XMETA + 96ull * 1024 * 4;
constexpr size_t OFF_CNT = OFF_SSQ + 4ull * MPAD * 4;
constexpr size_t OFF_HN = OFF_CNT + 1024;
constexpr size_t OFF_CQ = OFF_HN + (size_t)MPAD * 1024 * 2;
constexpr size_t OFF_CKV = OFF_CQ + (size_t)MPAD * 384 * 2;
constexpr size_t OFF_KN = OFF_CKV + (size_t)MPAD * 256 * 2;
constexpr size_t OFF_KPE = OFF_KN + (size_t)MPAD * 512 * 2;
constexpr size_t OFF_VMT = OFF_KPE + (size_t)MPAD * 32 * 2;
constexpr size_t OFF_QG = OFF_VMT + (size_t)MPAD * 512 * 2;
constexpr size_t OFF_KG = OFF_QG + (size_t)MPAD * 512 * 2;
constexpr size_t OFF_VGT = OFF_KG + (size_t)MPAD * 128 * 2;
constexpr size_t OFF_END = OFF_VGT + (size_t)MPAD * 128 * 2;
constexpr size_t OFF_U = OFF_CQ;
static_assert(OFF_U + (size_t)259 * 128 * 4096 * 2 <= OFF_END, "U fits");
static_assert(OFF_END <= 536870912ull, "workspace");

struct Params {
  const float* xp; const float* xs; const float* meta;
  const float* attn_g; const float* w_in; const float* qa_g; const float* w_qb; const float* kva_g; const float* w_kvb;
  const float* gq_g; const float* gk_g; const float* mo_g; const float* go_g; const float* w_out; const float* mlp_g;
  const float* w_up; const float* w_dn; const float* fin_g;
  float* out; char* ws;
  int phase_lo, phase_hi, probe, pad_;
};

DI unsigned pack2(float a, float b) { f32x2v f = {a, b}; bf16x2v v = __builtin_convertvector(f, bf16x2v); return __builtin_bit_cast(unsigned, v); }
DI u16 f2bf(float a) { return (u16)(pack2(a, 0.f) & 0xffffu); }
DI void store4(u16* dst, float a, float b, float c, float d) { u32x2 v = {pack2(a, b), pack2(c, d)}; *(u32x2*)dst = v; }
DI int crow(int i, int h) { return (i & 3) + 8 * (i >> 2) + 4 * h; }
DI int swap23(int r) { return (r & 0x13) | ((r & 4) << 1) | ((r & 8) >> 1); }
DI float xhalf(float v) { return __shfl_xor(v, 32); }

DI void decode_tile(int T, int& seq, int& i) {
  if (T < 258) { seq = (T >= 129) ? 1 : 0; i = T - seq * 129; }
  else { int u = T - 258; int q = u / 65; seq = 2 + q; i = u - q * 65; }
}
DI int seq_base(int seq) { return seq < 2 ? seq * 16512 : 33024 + (seq - 2) * 8320; }

DI const float* xrow_src(const Params& p, int g, bool from_input) {
  int T = g >> 7, r = g & 127, seq, i; decode_tile(T, seq, i);
  if (i == 0) {
    if (r < 112) return nullptr;
    return from_input ? p.meta + (size_t)(r - 112) * 1024 : (const float*)(p.ws + OFF_XMETA) + (size_t)(seq * 16 + r - 112) * 1024;
  }
  int j = (i - 1) * 128 + r;
  if (seq < 2) { size_t row = (size_t)seq * 16384 + j; return from_input ? p.xp + row * 1024 : p.out + row * 1024; }
  size_t row = (size_t)(seq - 2) * 8192 + j;
  return from_input ? p.xs + row * 1024 : p.out + (32768 + row) * 1024;
}
DI float* xrow_dst(const Params& p, int g) {
  int T = g >> 7, r = g & 127, seq, i; decode_tile(T, seq, i);
  if (i == 0) {
    if (r < 112) return nullptr;
    return (float*)(p.ws + OFF_XMETA) + (size_t)(seq * 16 + r - 112) * 1024;
  }
  int j = (i - 1) * 128 + r;
  if (seq < 2) { size_t row = (size_t)seq * 16384 + j; return p.out + row * 1024; }
  size_t row = (size_t)(seq - 2) * 8192 + j;
  return p.out + (32768 + row) * 1024;
}

DI int mapcol(int kind, int n) {
  if (kind == 1) { if (n < 640) return n; if (n < 1408) return n + 32; if (n < 1440) return 640 + (n - 1408); return -1; }
  if (kind == 2) { if (n < 512) return (n >> 6) * 96 + (n & 63); int m = n - 512; return (m >> 5) * 96 + 64 + (m & 31); }
  if (kind == 3) { if (n < 512) return (n >> 6) * 128 + (n & 63); int m = n - 512; return (m >> 6) * 128 + 64 + (m & 63); }
  return n;
}
DI void prep_weight(const float* __restrict__ src, int Nsrc, u16* __restrict__ dst, int Nout, int K, const float* gA, const float* gB,
                    int ksplit, int kind, int gtid, int gthreads) {
  const int total = Nout * (K >> 3);
  for (int u = gtid; u < total; u += gthreads) {
    const int n = u % Nout, kc = u / Nout;
    const int col = mapcol(kind, n);
    const int k = kc * 8;
    float v[8];
#pragma unroll
    for (int j = 0; j < 8; ++j) {
      float x = 0.f;
      if (col >= 0) {
        x = src[(size_t)(k + j) * Nsrc + col];
        if (gA) x *= (k + j < ksplit) ? gA[k + j] : gB[k + j - ksplit];
      }
      v[j] = x;
    }
    u32x4 o = {pack2(v[0], v[1]), pack2(v[2], v[3]), pack2(v[4], v[5]), pack2(v[6], v[7])};
    *(u32x4*)(dst + (size_t)n * K + k) = o;
  }
}

DI void phase_prep(const Params& p, int tid) {
  const int gtid = blockIdx.x * 256 + tid, gthreads = gridDim.x * 256;
  u16* W = (u16*)(p.ws + OFF_W);
  for (int l = 0; l < 2; ++l) {
    u16* Wl = W + (size_t)l * W_LAYER;
    prep_weight(p.w_in + (size_t)l * 1024 * 1440, 1440, Wl + WO_IN, 1536, 1024, nullptr, nullptr, 0, 1, gtid, gthreads);
    prep_weight(p.w_qb + (size_t)l * 384 * 768, 768, Wl + WO_QB, 768, 384, p.qa_g + l * 384, p.qa_g + l * 384, 384, 2, gtid, gthreads);
    prep_weight(p.w_kvb + (size_t)l * 256 * 1024, 1024, Wl + WO_KVB, 1024, 256, p.kva_g + l * 256, p.kva_g + l * 256, 256, 3, gtid, gthreads);
    prep_weight(p.w_out + (size_t)l * 1024 * 1024, 1024, Wl + WO_OUT, 1024, 1024, p.mo_g + l * 512, p.go_g + l * 512, 512, 0, gtid, gthreads);
    prep_weight(p.w_up + (size_t)l * 1024 * 4096, 4096, Wl + WO_UP, 4096, 1024, nullptr, nullptr, 0, 0, gtid, gthreads);
    prep_weight(p.w_dn + (size_t)l * 4096 * 1024, 1024, Wl + WO_DN, 1024, 4096, nullptr, nullptr, 0, 0, gtid, gthreads);
  }
  float2* tab = (float2*)(p.ws + OFF_TAB);
  for (int u = gtid; u < 16400 * 16; u += gthreads) {
    const int pos = u >> 4, f = u & 15;
    const float invf = 1.0f / powf(10000.0f, (float)(2 * f) / 32.0f);
    const float ang = (float)pos * invf;
    const double rev = (double)ang * 0.15915494309189535;
    const double fr = rev - rint(rev);
    const float x = (float)(2.0 * fr);
    tab[u] = make_float2(cospif(x), sinpif(x));
  }
  float* xm = (float*)(p.ws + OFF_XMETA);
  for (int u = gtid; u < 96 * 1024; u += gthreads) xm[u] = p.meta[u & 16383];
  int* cnt = (int*)(p.ws + OFF_CNT);
  if (gtid < 64) cnt[gtid] = 0;
}

DI void phase_norm(const Params& p, const float* __restrict__ gain, bool from_input, bool zero_ssq, int tid) {
  const int lane = tid & 63;
  const int gw = blockIdx.x * 4 + (tid >> 6), nw = gridDim.x * 4;
  u16* HN = (u16*)(p.ws + OFF_HN);
  float* ssq = (float*)(p.ws + OFF_SSQ);
  for (int g = gw; g < MPAD; g += nw) {
    const float* xr = xrow_src(p, g, from_input);
    u16* hr = HN + (size_t)g * 1024;
    if (!xr) {
      u32x4 z = {0u, 0u, 0u, 0u};
      *(u32x4*)(hr + lane * 16) = z;
      *(u32x4*)(hr + lane * 16 + 8) = z;
    } else {
      float4 v[4];
#pragma unroll
      for (int q = 0; q < 4; ++q) v[q] = ((const float4*)xr)[lane + 64 * q];
      float ss = 0.f;
#pragma unroll
      for (int q = 0; q < 4; ++q) ss += v[q].x * v[q].x + v[q].y * v[q].y + v[q].z * v[q].z + v[q].w * v[q].w;
#pragma unroll
      for (int o = 32; o >= 1; o >>= 1) ss += __shfl_xor(ss, o);
      const float rstd = rsqrtf(ss * (1.0f / 1024.0f) + EPS);
#pragma unroll
      for (int q = 0; q < 4; ++q) {
        const float4 gg = ((const float4*)gain)[lane + 64 * q];
        store4(hr + 4 * (lane + 64 * q), v[q].x * rstd * gg.x, v[q].y * rstd * gg.y, v[q].z * rstd * gg.z, v[q].w * rstd * gg.w);
      }
    }
    if (zero_ssq && lane < 4) ssq[(size_t)lane * MPAD + g] = 0.f;
  }
}

DI void phase_final(const Params& p, int tid) {
  const int lane = tid & 63;
  const int gw = blockIdx.x * 4 + (tid >> 6), nw = gridDim.x * 4;
  for (int g = gw; g < MPAD; g += nw) {
    if (((g >> 7) == 0) || ((g >> 7) == 129) || ((g >> 7) >= 258 && ((g >> 7) - 258) % 65 == 0)) continue;
    float* xr = xrow_dst(p, g);
    float4 v[4];
#pragma unroll
    for (int q = 0; q < 4; ++q) v[q] = ((const float4*)xr)[lane + 64 * q];
    float ss = 0.f;
#pragma unroll
    for (int q = 0; q < 4; ++q) ss += v[q].x * v[q].x + v[q].y * v[q].y + v[q].z * v[q].z + v[q].w * v[q].w;
#pragma unroll
    for (int o = 32; o >= 1; o >>= 1) ss += __shfl_xor(ss, o);
    const float rstd = rsqrtf(ss * (1.0f / 1024.0f) + EPS);
#pragma unroll
    for (int q = 0; q < 4; ++q) {
      const float4 gg = ((const float4*)p.fin_g)[lane + 64 * q];
      float4 o = make_float4(v[q].x * rstd * gg.x, v[q].y * rstd * gg.y, v[q].z * rstd * gg.z, v[q].w * rstd * gg.w);
      ((float4*)xr)[lane + 64 * q] = o;
    }
  }
}

constexpr int GP = 72;
struct APLin { const u16* A; int lda; DI const u16* ptr(int row, int k0) const { return A + (size_t)row * lda + k0; } };
struct APMix { const u16* QM; const u16* QG;
  DI const u16* ptr(int row, int k0) const { return k0 < 512 ? QM + (size_t)row * 768 + (k0 >> 6) * 96 : QG + (size_t)row * 512 + (k0 - 512); } };

template <bool MIDK, class AP, class EPI>
DI void gemm_tile(const AP& ap, const u16* __restrict__ W, int ldw, int K, int m0, int n0, const EPI& epi, char* smem, float r0, float r1, int tid, bool dry) {
  constexpr int SBUF = 2 * 128 * GP;
  u16* sA = (u16*)smem;
  u16* sB = sA + 128 * GP;
  const int lane = tid & 63, wave = tid >> 6, r = lane & 31, h = lane >> 5, wm = wave >> 1, wn = wave & 1;
  const int lrow = tid >> 3, lkc = (tid & 7) * 8;
  u32x4 ra[4], rb[4];
  f32x16 acc[2][2];
#pragma unroll
  for (int a = 0; a < 2; ++a)
#pragma unroll
    for (int b = 0; b < 2; ++b)
#pragma unroll
      for (int i = 0; i < 16; ++i) acc[a][b][i] = 0.f;
  const int nk = K >> 6;
#pragma unroll
  for (int q = 0; q < 4; ++q) {
    ra[q] = *(const u32x4*)(ap.ptr(m0 + lrow + 32 * q, 0) + lkc);
    rb[q] = *(const u32x4*)(W + (size_t)(n0 + lrow + 32 * q) * ldw + lkc);
  }
  __syncthreads();
#pragma unroll
  for (int q = 0; q < 4; ++q) {
    *(u32x4*)(sA + (lrow + 32 * q) * GP + lkc) = ra[q];
    *(u32x4*)(sB + (lrow + 32 * q) * GP + lkc) = rb[q];
  }
  if (nk > 1) {
#pragma unroll
    for (int q = 0; q < 4; ++q) {
      ra[q] = *(const u32x4*)(ap.ptr(m0 + lrow + 32 * q, 64) + lkc);
      rb[q] = *(const u32x4*)(W + (size_t)(n0 + lrow + 32 * q) * ldw + 64 + lkc);
    }
  }
  __syncthreads();
  for (int kt = 0; kt < nk; ++kt) {
    const int cb = (kt & 1) * SBUF, nb_ = SBUF - cb;
    if (kt + 1 < nk) {
#pragma unroll
      for (int q = 0; q < 4; ++q) {
        *(u32x4*)(sA + nb_ + (lrow + 32 * q) * GP + lkc) = ra[q];
        *(u32x4*)(sB + nb_ + (lrow + 32 * q) * GP + lkc) = rb[q];
      }
      if (kt + 2 < nk) {
        const int k0 = (kt + 2) << 6;
#pragma unroll
        for (int q = 0; q < 4; ++q) {
          ra[q] = *(const u32x4*)(ap.ptr(m0 + lrow + 32 * q, k0) + lkc);
          rb[q] = *(const u32x4*)(W + (size_t)(n0 + lrow + 32 * q) * ldw + k0 + lkc);
        }
      }
    }
#pragma unroll
    for (int ks = 0; ks < 4; ++ks) {
      bf16x8 wf[2], xf[2];
#pragma unroll
      for (int a = 0; a < 2; ++a) {
        wf[a] = *(const bf16x8*)(sB + cb + (wn * 64 + a * 32 + r) * GP + ks * 16 + h * 8);
        xf[a] = *(const bf16x8*)(sA + cb + (wm * 64 + a * 32 + r) * GP + ks * 16 + h * 8);
      }
#pragma unroll
      for (int a = 0; a < 2; ++a)
#pragma unroll
        for (int b = 0; b < 2; ++b) acc[a][b] = MFMA(wf[a], xf[b], acc[a][b]);
    }
    if (MIDK && kt == 7) {
#pragma unroll
      for (int a = 0; a < 2; ++a)
#pragma unroll
        for (int i = 0; i < 16; ++i) { acc[a][0][i] *= r0; acc[a][1][i] *= r1; }
    }
    __syncthreads();
  }
  if (!dry) epi(acc, n0 + wn * 64, m0 + wm * 64, lane, (u16*)smem + wave * 64 * GP);
}

struct ColId { DI int operator()(int ch) const { return ch * 8; } };
struct ColRope { DI int operator()(int ch) const { return (ch >> 2) * 96 + (ch & 3) * 8; } };

template <class COLF>
DI void stage_store(f32x16 (&acc)[2][2], u16* wl, int lane, u16* dst0, size_t pitch, const COLF& colf) {
  const int r = lane & 31, h = lane >> 5;
#pragma unroll
  for (int rb = 0; rb < 2; ++rb)
#pragma unroll
    for (int lb = 0; lb < 2; ++lb)
#pragma unroll
      for (int g4 = 0; g4 < 4; ++g4)
        store4(wl + (lb * 32 + r) * GP + rb * 32 + 8 * g4 + 4 * h, acc[rb][lb][4 * g4], acc[rb][lb][4 * g4 + 1], acc[rb][lb][4 * g4 + 2], acc[rb][lb][4 * g4 + 3]);
  WAVE_LDS_FENCE();
#pragma unroll
  for (int it = 0; it < 8; ++it) {
    const int row = it * 8 + (lane >> 3), ch = lane & 7;
    const u32x4 v = *(const u32x4*)(wl + row * GP + ch * 8);
    *(u32x4*)(dst0 + (size_t)row * pitch + colf(ch)) = v;
  }
  WAVE_LDS_FENCE();
}

DI void rope16(float (&v)[16], const float2* __restrict__ tabrow, int h) {
#pragma unroll
  for (int i = 0; i < 8; ++i) {
    const int f = (i & 3) + 8 * (i >> 2) + 4 * h;
    const float2 cs = tabrow[f];
    const float x1 = v[i], x2 = v[i + 8];
    v[i] = x1 * cs.x - x2 * cs.y;
    v[i + 8] = x2 * cs.x + x1 * cs.y;
  }
}

struct EpiIn {
  u16 *CQ, *CKV, *QG, *KG, *VGT, *KPE; float *ssq_q, *ssq_kv; const float *gq_g, *gk_g; const float2* tab;
  DI void operator()(f32x16 (&acc)[2][2], int nb, int mb, int lane, u16* wl) const {
    const int r = lane & 31, h = lane >> 5;
    int seq, it; decode_tile(mb >> 7, seq, it);
#pragma unroll
    for (int ti = 0; ti < 2; ++ti) {
      const int g = mb + ti * 32 + r, rr = g & 127;
      if (nb < 640) {
        float ss = 0.f;
#pragma unroll
        for (int fi = 0; fi < 2; ++fi)
#pragma unroll
          for (int i = 0; i < 16; ++i) ss += acc[fi][ti][i] * acc[fi][ti][i];
        ss += xhalf(ss);
        if (h == 0) unsafeAtomicAdd((nb < 384 ? ssq_q : ssq_kv) + g, ss);
      } else if (nb < 1280) {
        const bool isq = nb < 1152;
        const float* gg = isq ? gq_g : gk_g;
        float ss = 0.f;
#pragma unroll
        for (int fi = 0; fi < 2; ++fi)
#pragma unroll
          for (int i = 0; i < 16; ++i) ss += acc[fi][ti][i] * acc[fi][ti][i];
        ss += xhalf(ss);
        const float rstd = rsqrtf(ss * (1.0f / 64.0f) + EPS);
        const float osc = isq ? QSCALE_G : 1.0f;
        int prow = 0, pcol = 0;
        if (it > 0) { const int j = (it - 1) * 128 + rr; prow = j >> 6; pcol = j & 63; }
        u16* dst = isq ? QG + (size_t)g * 512 + (nb - 640) : KG + (size_t)g * 128 + (nb - 1152);
#pragma unroll
        for (int fi = 0; fi < 2; ++fi) {
          const int pos = fi == 0 ? prow : pcol;
          float v[16];
#pragma unroll
          for (int i = 0; i < 16; ++i) v[i] = acc[fi][ti][i] * rstd * gg[fi * 32 + crow(i, h)];
          rope16(v, tab + pos * 16, h);
#pragma unroll
          for (int g4 = 0; g4 < 4; ++g4)
            store4(dst + fi * 32 + 8 * g4 + 4 * h, v[4 * g4] * osc, v[4 * g4 + 1] * osc, v[4 * g4 + 2] * osc, v[4 * g4 + 3] * osc);
        }
      } else if (nb < 1408) {
#pragma unroll
        for (int fi = 0; fi < 2; ++fi)
#pragma unroll
          for (int i = 0; i < 16; ++i) VGT[(size_t)(nb - 1280 + fi * 32 + crow(i, h)) * MPAD + g] = f2bf(acc[fi][ti][i]);
      } else if (nb == 1408) {
        int pos = 128 * it + rr - 112; pos = pos < 0 ? 0 : pos;
        float v[16];
#pragma unroll
        for (int i = 0; i < 16; ++i) v[i] = acc[0][ti][i];
        rope16(v, tab + pos * 16, h);
#pragma unroll
        for (int g4 = 0; g4 < 4; ++g4) store4(KPE + (size_t)g * 32 + 8 * g4 + 4 * h, v[4 * g4], v[4 * g4 + 1], v[4 * g4 + 2], v[4 * g4 + 3]);
      }
    }
    if (nb < 384) stage_store(acc, wl, lane, CQ + (size_t)mb * 384 + nb, 384, ColId());
    else if (nb < 640) stage_store(acc, wl, lane, CKV + (size_t)mb * 256 + (nb - 384), 256, ColId());
  }
};

struct EpiQB {
  u16* QM; const float* ssq_q; const float2* tab;
  DI void operator()(f32x16 (&acc)[2][2], int nb, int mb, int lane, u16* wl) const {
    const int r = lane & 31, h = lane >> 5;
    int seq, it; decode_tile(mb >> 7, seq, it);
#pragma unroll
    for (int ti = 0; ti < 2; ++ti) {
      const int g = mb + ti * 32 + r, rr = g & 127;
      const float sc = rsqrtf(ssq_q[g] * (1.0f / 384.0f) + EPS) * QSCALE_M;
      if (nb < 512) {
#pragma unroll
        for (int fi = 0; fi < 2; ++fi)
#pragma unroll
          for (int i = 0; i < 16; ++i) acc[fi][ti][i] *= sc;
      } else {
        int pos = 128 * it + rr - 112; pos = pos < 0 ? 0 : pos;
#pragma unroll
        for (int fi = 0; fi < 2; ++fi) {
          float v[16];
#pragma unroll
          for (int i = 0; i < 16; ++i) v[i] = acc[fi][ti][i] * sc;
          rope16(v, tab + pos * 16, h);
#pragma unroll
          for (int i = 0; i < 16; ++i) acc[fi][ti][i] = v[i];
        }
      }
    }
    if (nb < 512) stage_store(acc, wl, lane, QM + (size_t)mb * 768 + (nb >> 6) * 96, 768, ColId());
    else stage_store(acc, wl, lane, QM + (size_t)mb * 768 + ((nb - 512) >> 5) * 96 + 64, 768, ColRope());
  }
};

struct EpiKVB {
  u16 *KN, *VMT; const float* ssq_kv;
  DI void operator()(f32x16 (&acc)[2][2], int nb, int mb, int lane, u16* wl) const {
    const int r = lane & 31, h = lane >> 5;
#pragma unroll
    for (int ti = 0; ti < 2; ++ti) {
      const int g = mb + ti * 32 + r;
      const float sc = rsqrtf(ssq_kv[g] * (1.0f / 256.0f) + EPS);
      if (nb < 512) {
#pragma unroll
        for (int fi = 0; fi < 2; ++fi)
#pragma unroll
          for (int i = 0; i < 16; ++i) acc[fi][ti][i] *= sc;
      } else {
#pragma unroll
        for (int fi = 0; fi < 2; ++fi)
#pragma unroll
          for (int i = 0; i < 16; ++i) VMT[(size_t)(nb - 512 + fi * 32 + crow(i, h)) * MPAD + g] = f2bf(acc[fi][ti][i] * sc);
      }
    }
    if (nb < 512) stage_store(acc, wl, lane, KN + (size_t)mb * 512 + nb, 512, ColId());
  }
};

DI void res_bases(const Params& p, int mt, bool from_input, const float*& sb, float*& db, int& minrow) {
  int seq, it; decode_tile(mt, seq, it);
  float* xm = (float*)(p.ws + OFF_XMETA);
  if (it == 0) {
    minrow = 112;
    db = xm + ((ptrdiff_t)seq * 16 - 112) * 1024;
    sb = from_input ? p.meta - 112 * 1024 : db;
  } else {
    minrow = 0;
    const size_t row = seq < 2 ? (size_t)seq * 16384 + (size_t)(it - 1) * 128 : 32768 + (size_t)(seq - 2) * 8192 + (size_t)(it - 1) * 128;
    db = p.out + row * 1024;
    sb = from_input ? (seq < 2 ? p.xp + row * 1024 : p.xs + (row - 32768) * 1024) : db;
  }
}

struct EpiRes {
  const float* sb; float* db; int minrow; float fin0, fin1;
  DI void operator()(f32x16 (&acc)[2][2], int nb, int mb, int lane, u16* wl) const {
    const int r = lane & 31, h = lane >> 5, mbl = mb & 127;
    float* wf = (float*)wl;
#pragma unroll
    for (int fi = 0; fi < 2; ++fi) {
#pragma unroll
      for (int ti = 0; ti < 2; ++ti) {
        const float sc = ti == 0 ? fin0 : fin1;
#pragma unroll
        for (int g4 = 0; g4 < 4; ++g4) {
          float4 o = make_float4(acc[fi][ti][4 * g4] * sc, acc[fi][ti][4 * g4 + 1] * sc, acc[fi][ti][4 * g4 + 2] * sc, acc[fi][ti][4 * g4 + 3] * sc);
          *(float4*)(wf + (ti * 32 + r) * 36 + 8 * g4 + 4 * h) = o;
        }
      }
      WAVE_LDS_FENCE();
#pragma unroll
      for (int it = 0; it < 8; ++it) {
        const int row = it * 8 + (lane >> 3), ch = lane & 7;
        const float4 a = *(const float4*)(wf + row * 36 + ch * 4);
        const int trow = mbl + row;
        if (trow >= minrow) {
          const size_t off = (size_t)trow * 1024 + nb + fi * 32 + ch * 4;
          float4 x = *(const float4*)(sb + off);
          x.x += a.x; x.y += a.y; x.z += a.z; x.w += a.w;
          *(float4*)(db + off) = x;
        }
      }
      WAVE_LDS_FENCE();
    }
  }
};

struct EpiUp {
  u16* U0;
  DI void operator()(f32x16 (&acc)[2][2], int nb, int mb, int lane, u16* wl) const {
#pragma unroll
    for (int ti = 0; ti < 2; ++ti)
#pragma unroll
      for (int fi = 0; fi < 2; ++fi)
#pragma unroll
        for (int i = 0; i < 16; ++i) { const float a = fmaxf(acc[fi][ti][i], 0.f); acc[fi][ti][i] = a * a; }
    stage_store(acc, wl, lane, U0 + (size_t)mb * 4096 + nb, 4096, ColId());
  }
};

constexpr float ATT_THR = 8.0f;

template <int DQK>
struct AttnCtx {
  static constexpr int KP = DQK + 8, NKS = DQK / 16, KCH = DQK / 8, NKL = 64 * KCH / 256, KBUF = 64 * KP, VBUF = 64 * GP;
  const u16 *Kb, *KPEb, *Vt; int kpitch, rowk0, nt, tid, r, h, sr;
  u16 *sK, *sV;
  bf16x8 qf[NKS], kone, qm;
  f32x16 o[2];
  float mref, l;
  u32x4 rk[NKL], rv[2];

  int koff[NKL], voff[2];
  DI void init_offs() {
#pragma unroll
    for (int q = 0; q < NKL; ++q) {
      const int c = tid + 256 * q, row = c / KCH, cc = c % KCH;
      koff[q] = (DQK == 96 && cc >= 8) ? row * 32 + (cc - 8) * 8 : row * kpitch + cc * 8;
    }
#pragma unroll
    for (int q = 0; q < 2; ++q) { const int c = tid + 256 * q, dv = c >> 3, kc = c & 7; voff[q] = dv * MPAD + kc * 8; }
  }
  DI void gload_k(int t) {
    const int row0 = rowk0 + t * 64;
    const u16* kt = Kb + (size_t)row0 * kpitch;
    const u16* pt = KPEb + (size_t)row0 * 32;
#pragma unroll
    for (int q = 0; q < NKL; ++q) {
      const int c = tid + 256 * q, cc = c % KCH;
      rk[q] = *(const u32x4*)(((DQK == 96 && cc >= 8) ? pt : kt) + koff[q]);
    }
  }
  DI void gload_v(int t) {
    const u16* vt = Vt + (rowk0 + t * 64);
#pragma unroll
    for (int q = 0; q < 2; ++q) rv[q] = *(const u32x4*)(vt + voff[q]);
  }
  DI void sstore_k(int buf) {
#pragma unroll
    for (int q = 0; q < NKL; ++q) {
      const int c = tid + 256 * q, row = c / KCH, cc = c % KCH;
      *(u32x4*)(sK + buf * KBUF + row * KP + cc * 8) = rk[q];
    }
  }
  DI void sstore_v(int buf) {
#pragma unroll
    for (int q = 0; q < 2; ++q) {
      const int c = tid + 256 * q, dv = c >> 3, kc = c & 7;
      *(u32x4*)(sV + buf * VBUF + dv * GP + kc * 8) = rv[q];
    }
  }
  DI void qk(int buf, f32x16 (&s)[2]) {
    const u16* kb = sK + buf * KBUF + sr * KP + h * 8;
#pragma unroll
    for (int kb2 = 0; kb2 < 2; ++kb2)
#pragma unroll
      for (int i = 0; i < 16; ++i) s[kb2][i] = 0.f;
#pragma unroll
    for (int ks = 0; ks < NKS; ++ks)
#pragma unroll
      for (int kb2 = 0; kb2 < 2; ++kb2) {
        const bf16x8 a = *(const bf16x8*)(kb + kb2 * 32 * KP + ks * 16);
        s[kb2] = MFMA(a, qf[ks], s[kb2]);
      }
    s[0] = MFMA(kone, qm, s[0]);
    s[1] = MFMA(kone, qm, s[1]);
  }
  template <int PAR>
  DI void step(int t, f32x16 (&cur)[2], f32x16 (&nxt)[2]) {
    if (t + 1 < nt) { sstore_k(PAR ^ 1); gload_v(t + 1); }
    __syncthreads();
    if (t + 1 < nt) qk(PAR ^ 1, nxt);
    float mx = fmaxf(cur[0][0], cur[1][0]);
#pragma unroll
    for (int i = 1; i < 16; ++i) mx = fmaxf(fmaxf(cur[0][i], cur[1][i]), mx);
    if (__builtin_amdgcn_ballot_w64(mx > ATT_THR) != 0ull) {
      asm volatile("" ::: "memory");
      mx = fmaxf(mx, xhalf(mx));
      const float want = mref + fmaxf(mx, 0.f);
      const float mn = __uint_as_float(pack2(want, 0.f) << 16);
      const float d = mn - mref;
      const float alpha = __builtin_amdgcn_exp2f(-d);
      mref = mn;
      l *= alpha;
#pragma unroll
      for (int a = 0; a < 2; ++a)
#pragma unroll
        for (int i = 0; i < 16; ++i) { o[a][i] *= alpha; cur[a][i] -= d; nxt[a][i] -= d; }
      u32x4 q4 = {h == 0 ? (pack2(-mn, 0.f) & 0xffffu) : 0u, 0u, 0u, 0u};
      qm = __builtin_bit_cast(bf16x8, q4);
    }
    float psum = 0.f;
#pragma unroll
    for (int kb2 = 0; kb2 < 2; ++kb2)
#pragma unroll
      for (int i = 0; i < 16; ++i) { const float pv = __builtin_amdgcn_exp2f(cur[kb2][i]); cur[kb2][i] = pv; psum += pv; }
    l += psum;
    if (t + 2 < nt) gload_k(t + 2);
    const u16* vb = sV + PAR * VBUF + r * GP + h * 8;
#pragma unroll
    for (int kb2 = 0; kb2 < 2; ++kb2)
#pragma unroll
      for (int s2 = 0; s2 < 2; ++s2) {
        u32x4 pk = {pack2(cur[kb2][8 * s2], cur[kb2][8 * s2 + 1]), pack2(cur[kb2][8 * s2 + 2], cur[kb2][8 * s2 + 3]),
                    pack2(cur[kb2][8 * s2 + 4], cur[kb2][8 * s2 + 5]), pack2(cur[kb2][8 * s2 + 6], cur[kb2][8 * s2 + 7])};
        const bf16x8 pf = __builtin_bit_cast(bf16x8, pk);
#pragma unroll
        for (int db = 0; db < 2; ++db) {
          const bf16x8 a = *(const bf16x8*)(vb + db * 32 * GP + kb2 * 32 + s2 * 16);
          o[db] = MFMA(a, pf, o[db]);
        }
      }
    if (t + 1 < nt) sstore_v(PAR ^ 1);
  }
};

template <int DQK>
DI void attn_item(const u16* __restrict__ Qb, int qpitch, const u16* __restrict__ Kb, int kpitch, const u16* __restrict__ KPEb,
                  const u16* __restrict__ Vt, float* __restrict__ ssq, int rowq0, int rowk0, int nt, char* smem, int tid, bool dry) {
  typedef AttnCtx<DQK> C;
  C c;
  const int lane = tid & 63, wave = tid >> 6, r = lane & 31, h = lane >> 5;
  c.Kb = Kb; c.KPEb = KPEb; c.Vt = Vt; c.kpitch = kpitch; c.rowk0 = rowk0; c.nt = nt; c.tid = tid; c.r = r; c.h = h; c.sr = swap23(r);
  c.sK = (u16*)smem; c.sV = c.sK + 2 * C::KBUF;
  c.init_offs();
  const int myrow = rowq0 + wave * 32 + r;
  {
    const u16* qrow = Qb + (size_t)myrow * qpitch + h * 8;
#pragma unroll
    for (int ks = 0; ks < C::NKS; ++ks) c.qf[ks] = *(const bf16x8*)(qrow + ks * 16);
  }
#pragma unroll
  for (int a = 0; a < 2; ++a)
#pragma unroll
    for (int i = 0; i < 16; ++i) c.o[a][i] = 0.f;
  c.mref = 0.f; c.l = 0.f;
  {
    u32x4 k1 = {h == 0 ? 0x3F80u : 0u, 0u, 0u, 0u}, z4 = {0u, 0u, 0u, 0u};
    c.kone = __builtin_bit_cast(bf16x8, k1); c.qm = __builtin_bit_cast(bf16x8, z4);
  }
  f32x16 sa[2], sb[2];
  c.gload_k(0); c.gload_v(0);
  __syncthreads();
  c.sstore_k(0); c.sstore_v(0);
  if (nt > 1) c.gload_k(1);
  __syncthreads();
  c.qk(0, sa);
#pragma unroll
  for (int i = 0; i < 16; ++i) {
    sa[0][i] = -1e30f;
    if (swap23(crow(i, h)) < 16) sa[1][i] = -1e30f;
  }
  int t = 0;
  for (; t + 1 < nt; t += 2) {
    c.template step<0>(t, sa, sb);
    c.template step<1>(t + 1, sb, sa);
  }
  if (t < nt) c.template step<0>(t, sa, sb);
  if (dry) return;
  float l = c.l;
  l += xhalf(l);
  const float inv = 1.0f / l;
  float ss = 0.f;
  u16* orow = (u16*)Qb + (size_t)myrow * qpitch;
#pragma unroll
  for (int db = 0; db < 2; ++db)
#pragma unroll
    for (int g4 = 0; g4 < 4; ++g4) {
      const float a0 = c.o[db][4 * g4] * inv, a1 = c.o[db][4 * g4 + 1] * inv, a2 = c.o[db][4 * g4 + 2] * inv, a3 = c.o[db][4 * g4 + 3] * inv;
      ss += a0 * a0 + a1 * a1 + a2 * a2 + a3 * a3;
      store4(orow + db * 32 + 8 * g4 + 4 * h, a0, a1, a2, a3);
    }
  ss += xhalf(ss);
  if (h == 0) unsafeAtomicAdd(ssq + myrow, ss);
}

constexpr int N_ITEMS = 8288;
DI void phase_attn(const Params& p, int layer, char* smem, int* s_item, int tid, bool dry) {
  int* cnt = (int*)(p.ws + OFF_CNT) + layer + (dry ? 2 : 0);
  u16* QM = (u16*)(p.ws + OFF_HN);
  const u16* KN = (const u16*)(p.ws + OFF_KN);
  const u16* KPE = (const u16*)(p.ws + OFF_KPE);
  const u16* VMT = (const u16*)(p.ws + OFF_VMT);
  u16* QG = (u16*)(p.ws + OFF_QG);
  const u16* KG = (const u16*)(p.ws + OFF_KG);
  const u16* VGT = (const u16*)(p.ws + OFF_VGT);
  float* ssq = (float*)(p.ws + OFF_SSQ);
  for (;;) {
    if (tid == 0) *s_item = atomicAdd(cnt, 1);
    __syncthreads();
    const int it = *s_item;
    __syncthreads();
    if (it >= N_ITEMS) break;
    int grp, seq, head, qi, nt;
    if (it < 4128) { grp = it / 2064; const int u = it - grp * 2064; const int sh = u / 129; qi = u - sh * 129; seq = sh >> 3; head = sh & 7; nt = 257; }
    else { const int u0 = it - 4128; grp = u0 / 2080; const int u = u0 - grp * 2080; const int sh = u / 65; qi = u - sh * 65; seq = 2 + (sh >> 3); head = sh & 7; nt = 129; }
    const int P = seq_base(seq);
    if (grp == 0)
      attn_item<96>(QM + head * 96, 768, KN + head * 64, 512, KPE, VMT + (size_t)head * 64 * MPAD, ssq + 2 * (size_t)MPAD, P + qi * 128, P + 64, nt, smem, tid, dry);
    else
      attn_item<64>(QG + head * 64, 512, KG + (head >> 2) * 64, 128, nullptr, VGT + (size_t)(head >> 2) * 64 * MPAD, ssq + 3 * (size_t)MPAD, P + qi * 128, P + 64, nt, smem, tid, dry);
  }
}

__global__ void __launch_bounds__(256, 2) mega(Params pin) {
  __shared__ __attribute__((aligned(16))) char smem[2 * 2 * 128 * GP * 2];
  __shared__ int s_item;
  const int G = gridDim.x, b = blockIdx.x;
  const int vb = ((G & 7) == 0) ? ((b & 7) * (G >> 3) + (b >> 3)) : b;
  for (int st = pin.phase_lo; st < pin.phase_hi; ++st) {
    int ph; bool dry = false;
    if (st == 0) ph = 0;
    else if (st == 41) ph = 21;
    else {
      const int u = st - 1, lay = u / 20, v = u - lay * 20, sb = v >> 1;
      dry = (v & 1) == 0;
      if (dry && !((pin.probe >> sb) & 1)) continue;
      ph = 1 + lay * 10 + sb;
    }
    if (st > pin.phase_lo) cg::this_grid().sync();
    Params p = pin;
    asm volatile("" : "+s"(p.xp), "+s"(p.xs), "+s"(p.meta), "+s"(p.attn_g), "+s"(p.w_in), "+s"(p.qa_g), "+s"(p.w_qb), "+s"(p.kva_g), "+s"(p.w_kvb), "+s"(p.gq_g));
    asm volatile("" : "+s"(p.gk_g), "+s"(p.mo_g), "+s"(p.go_g), "+s"(p.w_out), "+s"(p.mlp_g), "+s"(p.w_up), "+s"(p.w_dn), "+s"(p.fin_g), "+s"(p.out), "+s"(p.ws));
    int tid = threadIdx.x;
    asm volatile("" : "+v"(tid));
    const int lane = tid & 63, wave = tid >> 6, r = lane & 31;
    float* ssq = (float*)(p.ws + OFF_SSQ);
    const float2* tab = (const float2*)(p.ws + OFF_TAB);
    if (ph == 0) { phase_prep(p, tid); continue; }
    if (ph == 21) { phase_final(p, tid); continue; }
    const int layer = (ph - 1) / 10, sub = (ph - 1) % 10;
    const u16* Wl = (const u16*)(p.ws + OFF_W) + (size_t)layer * W_LAYER;
    if (sub == 0) {
      phase_norm(p, p.attn_g + layer * 1024, layer == 0, true, tid);
    } else if (sub == 1) {
      EpiIn e; e.CQ = (u16*)(p.ws + OFF_CQ); e.CKV = (u16*)(p.ws + OFF_CKV); e.QG = (u16*)(p.ws + OFF_QG); e.KG = (u16*)(p.ws + OFF_KG);
      e.VGT = (u16*)(p.ws + OFF_VGT); e.KPE = (u16*)(p.ws + OFF_KPE); e.ssq_q = ssq; e.ssq_kv = ssq + MPAD;
      e.gq_g = p.gq_g + layer * 64; e.gk_g = p.gk_g + layer * 64; e.tab = tab;
      APLin ap{(const u16*)(p.ws + OFF_HN), 1024};
      for (int t = vb; t < NTM * 12; t += G) { const int mt = t / 12, nt = t - mt * 12; gemm_tile<false>(ap, Wl + WO_IN, 1024, 1024, mt * 128, nt * 128, e, smem, 1.f, 1.f, tid, dry); }
    } else if (sub == 2) {
      EpiQB e2; e2.QM = (u16*)(p.ws + OFF_HN); e2.ssq_q = ssq; e2.tab = tab;
      EpiKVB e3; e3.KN = (u16*)(p.ws + OFF_KN); e3.VMT = (u16*)(p.ws + OFF_VMT); e3.ssq_kv = ssq + MPAD;
      APLin a2{(const u16*)(p.ws + OFF_CQ), 384};
      APLin a3{(const u16*)(p.ws + OFF_CKV), 256};
      for (int t = vb; t < NTM * 14; t += G) {
        if (t < NTM * 6) { const int mt = t / 6, nt = t - mt * 6; gemm_tile<false>(a2, Wl + WO_QB, 384, 384, mt * 128, nt * 128, e2, smem, 1.f, 1.f, tid, dry); }
        else { const int u = t - NTM * 6; const int mt = u >> 3, nt = u & 7; gemm_tile<false>(a3, Wl + WO_KVB, 256, 256, mt * 128, nt * 128, e3, smem, 1.f, 1.f, tid, dry); }
      }
    } else if (sub == 3) {
      phase_attn(p, layer, smem, &s_item, tid, dry);
    } else if (sub == 4) {
      APMix ap{(const u16*)(p.ws + OFF_HN), (const u16*)(p.ws + OFF_QG)};
      for (int t = vb; t < NTM * 8; t += G) {
        const int mt = t >> 3, nt = t & 7;
        const int g0 = mt * 128 + (wave >> 1) * 64 + r;
        const float ra0 = rsqrtf(ssq[2 * (size_t)MPAD + g0] * (1.0f / 512.0f) + EPS), rg0 = rsqrtf(ssq[3 * (size_t)MPAD + g0] * (1.0f / 512.0f) + EPS);
        const float ra1 = rsqrtf(ssq[2 * (size_t)MPAD + g0 + 32] * (1.0f / 512.0f) + EPS), rg1 = rsqrtf(ssq[3 * (size_t)MPAD + g0 + 32] * (1.0f / 512.0f) + EPS);
        EpiRes e; res_bases(p, mt, layer == 0, e.sb, e.db, e.minrow); e.fin0 = rg0; e.fin1 = rg1;
        gemm_tile<true>(ap, Wl + WO_OUT, 1024, 1024, mt * 128, nt * 128, e, smem, ra0 / rg0, ra1 / rg1, tid, dry);
      }
    } else if (sub == 5) {
      phase_norm(p, p.mlp_g + layer * 1024, false, false, tid);
    } else if (sub == 6 || sub == 8) {
      const int mh = (sub - 6) >> 1;
      EpiUp e; e.U0 = (u16*)(p.ws + OFF_U) - (size_t)mh * 259 * 128 * 4096;
      APLin ap{(const u16*)(p.ws + OFF_HN), 1024};
      for (int t = vb; t < 259 * 32; t += G) {
        int ml, nt;
        if (t < 256 * 32) { const int blk = t >> 6, w = t & 63; ml = (blk >> 2) * 8 + (w >> 3); nt = (blk & 3) * 8 + (w & 7); }
        else { ml = t >> 5; nt = t & 31; }
        gemm_tile<false>(ap, Wl + WO_UP, 1024, 1024, (mh * 259 + ml) * 128, nt * 128, e, smem, 1.f, 1.f, tid, dry);
      }
    } else {
      const int mh = (sub - 7) >> 1;
      APLin ap{(const u16*)(p.ws + OFF_U) - (size_t)mh * 259 * 128 * 4096, 4096};
      for (int t = vb; t < 259 * 8; t += G) {
        const int mt = mh * 259 + (t >> 3), nt = t & 7;
        EpiRes e; res_bases(p, mt, false, e.sb, e.db, e.minrow); e.fin0 = 1.f; e.fin1 = 1.f;
        gemm_tile<false>(ap, Wl + WO_DN, 4096, 4096, mt * 128, nt * 128, e, smem, 1.f, 1.f, tid, dry);
      }
    }
  }
}

extern "C" void kernel_launch(void* const* d_in, const int* in_sizes, int n_in, void* d_out, int out_size, void* d_ws, size_t ws_size,
                              hipStream_t stream) {
  static int grid_blocks = 0;
  if (!grid_blocks) {
    int dev = 0, cus = 0, per_cu = 0;
    hipGetDevice(&dev);
    hipDeviceGetAttribute(&cus, hipDeviceAttributeMultiprocessorCount, dev);
    hipOccupancyMaxActiveBlocksPerMultiprocessor(&per_cu, mega, 256, 0);
    if (per_cu > 2) per_cu = 2;
    if (per_cu < 1) per_cu = 1;
    grid_blocks = cus * per_cu;
  }
  Params p{};
  p.xp = (const float*)d_in[0]; p.xs = (const float*)d_in[1]; p.meta = (const float*)d_in[2];
  p.attn_g = (const float*)d_in[3]; p.w_in = (const float*)d_in[4]; p.qa_g = (const float*)d_in[5]; p.w_qb = (const float*)d_in[6];
  p.kva_g = (const float*)d_in[7]; p.w_kvb = (const float*)d_in[8]; p.gq_g = (const float*)d_in[9]; p.gk_g = (const float*)d_in[10];
  p.mo_g = (const float*)d_in[11]; p.go_g = (const float*)d_in[12]; p.w_out = (const float*)d_in[13]; p.mlp_g = (const float*)d_in[14];
  p.w_up = (const float*)d_in[15]; p.w_dn = (const float*)d_in[16]; p.fin_g = (const float*)d_in[17];
  p.out = (float*)d_out; p.ws = (char*)d_ws;
#if MK_MULTI
  for (int ph = 0; ph < 42; ++ph) {
    p.phase_lo = ph; p.phase_hi = ph + 1; p.probe = PROBE_MASK;
    if (ph > 0 && ph < 41 && ((ph - 1) & 1) == 0 && !((PROBE_MASK >> (((ph - 1) % 20) >> 1)) & 1)) continue;
    hipLaunchKernelGGL(mega, dim3(grid_blocks), dim3(256), 0, stream, p);
  }
#else
  p.phase_lo = 0; p.phase_hi = 42; p.probe = PROBE_MASK;
  void* args[] = {&p};
  hipError_t e = hipLaunchCooperativeKernel((void*)mega, dim3(grid_blocks), dim3(256), args, 0, stream);
  if (e != hipSuccess) fprintf(stderr, "cooperative launch failed: %s (grid %d)\n", hipGetErrorString(e), grid_blocks);
#endif
}
```

```cpp
#include <hip/hip_runtime.h>
#include <hip/hip_cooperative_groups.h>
#include <stdint.h>
#include <cstdio>
namespace cg = cooperative_groups;

#ifndef PROBE_MASK
#define PROBE_MASK 0
#endif
#ifndef MK_MULTI
#define MK_MULTI 0
#endif

typedef unsigned short u16;
typedef short bf16x8 __attribute__((ext_vector_type(8)));
typedef float f32x16 __attribute__((ext_vector_type(16)));
typedef unsigned u32x4 __attribute__((ext_vector_type(4)));
typedef unsigned u32x2 __attribute__((ext_vector_type(2)));
typedef float f32x2v __attribute__((ext_vector_type(2)));
typedef __bf16 bf16x2v __attribute__((ext_vector_type(2)));
#define DI __device__ __forceinline__
#define WAVE_LDS_FENCE() asm volatile("s_waitcnt lgkmcnt(0)" ::: "memory")
#define MFMA(a, b, c) __builtin_amdgcn_mfma_f32_32x32x16_bf16((a), (b), (c), 0, 0, 0)

constexpr int MPAD = 66304;
constexpr int NTM = 518;
constexpr float EPS = 1e-6f;
constexpr float LOG2E = 1.4426950408889634f;
constexpr float QSCALE_M = 0.10206207261596575f * LOG2E;
constexpr float QSCALE_G = 0.125f * LOG2E;

constexpr size_t SZ_WIN = 1536ull * 1024, SZ_WQB = 768ull * 384, SZ_WKVB = 1024ull * 256, SZ_WOUT = 1024ull * 1024,
                 SZ_WUP = 4096ull * 1024, SZ_WDN = 1024ull * 4096;
constexpr size_t WO_IN = 0, WO_QB = WO_IN + SZ_WIN, WO_KVB = WO_QB + SZ_WQB, WO_OUT = WO_KVB + SZ_WKVB, WO_UP = WO_OUT + SZ_WOUT,
                 WO_DN = WO_UP + SZ_WUP, W_LAYER = WO_DN + SZ_WDN;
constexpr size_t OFF_W = 0;
constexpr size_t OFF_TAB = OFF_W + 2 * W_LAYER * 2;
constexpr size_t OFF_XMETA = OFF_TAB + 16400ull * 16 * 8;
constexpr size_t OFF_SSQ = OFF_XMETA + 96ull * 1024 * 4;
constexpr size_t OFF_CNT = OFF_SSQ + 4ull * MPAD * 4;
constexpr size_t OFF_HN = OFF_CNT + 1024;
constexpr size_t OFF_CQ = OFF_HN + (size_t)MPAD * 1024 * 2;
constexpr size_t OFF_CKV = OFF_CQ + (size_t)MPAD * 384 * 2;
constexpr size_t OFF_KN = OFF_CKV + (size_t)MPAD * 256 * 2;
constexpr size_t OFF_KPE = OFF_KN + (size_t)MPAD * 512 * 2;
constexpr size_t OFF_VMT = OFF_KPE + (size_t)MPAD * 32 * 2;
constexpr size_t OFF_QG = OFF_VMT + (size_t)MPAD * 512 * 2;
constexpr size_t OFF_KG = OFF_QG + (size_t)MPAD * 512 * 2;
constexpr size_t OFF_VGT = OFF_KG + (size_t)MPAD * 128 * 2;
constexpr size_t OFF_END = OFF_VGT + (size_t)MPAD * 128 * 2;
constexpr size_t OFF_U = OFF_CQ;
static_assert(OFF_U + (size_t)259 * 128 * 4096 * 2 <= OFF_END, "U fits");
static_assert(OFF_END <= 536870912ull, "workspace");

struct Params {
  const float* xp; const float* xs; const float* meta;
  const float* attn_g; const float* w_in; const float* qa_g; const float* w_qb; const float* kva_g; const float* w_kvb;
  const float* gq_g; const float* gk_g; const float* mo_g; const float* go_g; const float* w_out; const float* mlp_g;
  const float* w_up; const float* w_dn; const float* fin_g;
  float* out; char* ws;
  int phase_lo, phase_hi, probe, pad_;
};

DI unsigned pack2(float a, float b) { f32x2v f = {a, b}; bf16x2v v = __builtin_convertvector(f, bf16x2v); return __builtin_bit_cast(unsigned, v); }
DI u16 f2bf(float a) { return (u16)(pack2(a, 0.f) & 0xffffu); }
DI void store4(u16* dst, float a, float b, float c, float d) { u32x2 v = {pack2(a, b), pack2(c, d)}; *(u32x2*)dst = v; }
DI int crow(int i, int h) { return (i & 3) + 8 * (i >> 2) + 4 * h; }
DI int swap23(int r) { return (r & 0x13) | ((r & 4) << 1) | ((r & 8) >> 1); }
DI float xhalf(float v) { return __shfl_xor(v, 32); }

DI void decode_tile(int T, int& seq, int& i) {
  if (T < 258) { seq = (T >= 129) ? 1 : 0; i = T - seq * 129; }
  else { int u = T - 258; int q = u / 65; seq = 2 + q; i = u - q * 65; }
}
DI int seq_base(int seq) { return seq < 2 ? seq * 16512 : 33024 + (seq - 2) * 8320; }

DI const float* xrow_src(const Params& p, int g, bool from_input) {
  int T = g >> 7, r = g & 127, seq, i; decode_tile(T, seq, i);
  if (i == 0) {
    if (r < 112) return nullptr;
    return from_input ? p.meta + (size_t)(r - 112) * 1024 : (const float*)(p.ws + OFF_XMETA) + (size_t)(seq * 16 + r - 112) * 1024;
  }
  int j = (i - 1) * 128 + r;
  if (seq < 2) { size_t row = (size_t)seq * 16384 + j; return from_input ? p.xp + row * 1024 : p.out + row * 1024; }
  size_t row = (size_t)(seq - 2) * 8192 + j;
  return from_input ? p.xs + row * 1024 : p.out + (32768 + row) * 1024;
}
DI float* xrow_dst(const Params& p, int g) {
  int T = g >> 7, r = g & 127, seq, i; decode_tile(T, seq, i);
  if (i == 0) {
    if (r < 112) return nullptr;
    return (float*)(p.ws + OFF_XMETA) + (size_t)(seq * 16 + r - 112) * 1024;
  }
  int j = (i - 1) * 128 + r;
  if (seq < 2) { size_t row = (size_t)seq * 16384 + j; return p.out + row * 1024; }
  size_t row = (size_t)(seq - 2) * 8192 + j;
  return p.out + (32768 + row) * 1024;
}

DI int mapcol(int kind, int n) {
  if (kind == 1) { if (n < 640) return n; if (n < 1408) return n + 32; if (n < 1440) return 640 + (n - 1408); return -1; }
  if (kind == 2) { if (n < 512) return (n >> 6) * 96 + (n & 63); int m = n - 512; return (m >> 5) * 96 + 64 + (m & 31); }
  if (kind == 3) { if (n < 512) return (n >> 6) * 128 + (n & 63); int m = n - 512; return (m >> 6) * 128 + 64 + (m & 63); }
  return n;
}
DI void prep_weight(const float* __restrict__ src, int Nsrc, u16* __restrict__ dst, int Nout, int K, const float* gA, const float* gB,
                    int ksplit, int kind, int gtid, int gthreads) {
  const int total = Nout * (K >> 3);
  for (int u = gtid; u < total; u += gthreads) {
    const int n = u % Nout, kc = u / Nout;
    const int col = mapcol(kind, n);
    const int k = kc * 8;
    float v[8];
#pragma unroll
    for (int j = 0; j < 8; ++j) {
      float x = 0.f;
      if (col >= 0) {
        x = src[(size_t)(k + j) * Nsrc + col];
        if (gA) x *= (k + j < ksplit) ? gA[k + j] : gB[k + j - ksplit];
      }
      v[j] = x;
    }
    u32x4 o = {pack2(v[0], v[1]), pack2(v[2], v[3]), pack2(v[4], v[5]), pack2(v[6], v[7])};
    *(u32x4*)(dst + (size_t)n * K + k) = o;
  }
}

DI void phase_prep(const Params& p, int tid) {
  const int gtid = blockIdx.x * 256 + tid, gthreads = gridDim.x * 256;
  u16* W = (u16*)(p.ws + OFF_W);
  for (int l = 0; l < 2; ++l) {
    u16* Wl = W + (size_t)l * W_LAYER;
    prep_weight(p.w_in + (size_t)l * 1024 * 1440, 1440, Wl + WO_IN, 1536, 1024, nullptr, nullptr, 0, 1, gtid, gthreads);
    prep_weight(p.w_qb + (size_t)l * 384 * 768, 768, Wl + WO_QB, 768, 384, p.qa_g + l * 384, p.qa_g + l * 384, 384, 2, gtid, gthreads);
    prep_weight(p.w_kvb + (size_t)l * 256 * 1024, 1024, Wl + WO_KVB, 1024, 256, p.kva_g + l * 256, p.kva_g + l * 256, 256, 3, gtid, gthreads);
    prep_weight(p.w_out + (size_t)l * 1024 * 1024, 1024, Wl + WO_OUT, 1024, 1024, p.mo_g + l * 512, p.go_g + l * 512, 512, 0, gtid, gthreads);
    prep_weight(p.w_up + (size_t)l * 1024 * 4096, 4096, Wl + WO_UP, 4096, 1024, nullptr, nullptr, 0, 0, gtid, gthreads);
    prep_weight(p.w_dn + (size_t)l * 4096 * 1024, 1024, Wl + WO_DN, 1024, 4096, nullptr, nullptr, 0, 0, gtid, gthreads);
  }
  float2* tab = (float2*)(p.ws + OFF_TAB);
  for (int u = gtid; u < 16400 * 16; u += gthreads) {
    const int pos = u >> 4, f = u & 15;
    const float invf = 1.0f / powf(10000.0f, (float)(2 * f) / 32.0f);
    const float ang = (float)pos * invf;
    const double rev = (double)ang * 0.15915494309189535;
    const double fr = rev - rint(rev);
    const float x = (float)(2.0 * fr);
    tab[u] = make_float2(cospif(x), sinpif(x));
  }
  float* xm = (float*)(p.ws + OFF_XMETA);
  for (int u = gtid; u < 96 * 1024; u += gthreads) xm[u] = p.meta[u & 16383];
  int* cnt = (int*)(p.ws + OFF_CNT);
  if (gtid < 64) cnt[gtid] = 0;
}

DI void phase_norm(const Params& p, const float* __restrict__ gain, bool from_input, bool zero_ssq, int tid) {
  const int lane = tid & 63;
  const int gw = blockIdx.x * 4 + (tid >> 6), nw = gridDim.x * 4;
  u16* HN = (u16*)(p.ws + OFF_HN);
  float* ssq = (float*)(p.ws + OFF_SSQ);
  for (int g = gw; g < MPAD; g += nw) {
    const float* xr = xrow_src(p, g, from_input);
    u16* hr = HN + (size_t)g * 1024;
    if (!xr) {
      u32x4 z = {0u, 0u, 0u, 0u};
      *(u32x4*)(hr + lane * 16) = z;
      *(u32x4*)(hr + lane * 16 + 8) = z;
    } else {
      float4 v[4];
#pragma unroll
      for (int q = 0; q < 4; ++q) v[q] = ((const float4*)xr)[lane + 64 * q];
      float ss = 0.f;
#pragma unroll
      for (int q = 0; q < 4; ++q) ss += v[q].x * v[q].x + v[q].y * v[q].y + v[q].z * v[q].z + v[q].w * v[q].w;
#pragma unroll
      for (int o = 32; o >= 1; o >>= 1) ss += __shfl_xor(ss, o);
      const float rstd = rsqrtf(ss * (1.0f / 1024.0f) + EPS);
#pragma unroll
      for (int q = 0; q < 4; ++q) {
        const float4 gg = ((const float4*)gain)[lane + 64 * q];
        store4(hr + 4 * (lane + 64 * q), v[q].x * rstd * gg.x, v[q].y * rstd * gg.y, v[q].z * rstd * gg.z, v[q].w * rstd * gg.w);
      }
    }
    if (zero_ssq && lane < 4) ssq[(size_t)lane * MPAD + g] = 0.f;
  }
}

DI void phase_final(const Params& p, int tid) {
  const int lane = tid & 63;
  const int gw = blockIdx.x * 4 + (tid >> 6), nw = gridDim.x * 4;
  for (int g = gw; g < MPAD; g += nw) {
    if (((g >> 7) == 0) || ((g >> 7) == 129) || ((g >> 7) >= 258 && ((g >> 7) - 258) % 65 == 0)) continue;
    float* xr = xrow_dst(p, g);
    float4 v[4];
#pragma unroll
    for (int q = 0; q < 4; ++q) v[q] = ((const float4*)xr)[lane + 64 * q];
    float ss = 0.f;
#pragma unroll
    for (int q = 0; q < 4; ++q) ss += v[q].x * v[q].x + v[q].y * v[q].y + v[q].z * v[q].z + v[q].w * v[q].w;
#pragma unroll
    for (int o = 32; o >= 1; o >>= 1) ss += __shfl_xor(ss, o);
    const float rstd = rsqrtf(ss * (1.0f / 1024.0f) + EPS);
#pragma unroll
    for (int q = 0; q < 4; ++q) {
      const float4 gg = ((const float4*)p.fin_g)[lane + 64 * q];
      float4 o = make_float4(v[q].x * rstd * gg.x, v[q].y * rstd * gg.y, v[q].z * rstd * gg.z, v[q].w * rstd * gg.w);
      ((float4*)xr)[lane + 64 * q] = o;
    }
  }
}

constexpr int GP = 72;
struct APLin { const u16* A; int lda; DI const u16* ptr(int row, int k0) const { return A + (size_t)row * lda + k0; } };
struct APMix { const u16* QM; const u16* QG;
  DI const u16* ptr(int row, int k0) const { return k0 < 512 ? QM + (size_t)row * 768 + (k0 >> 6) * 96 : QG + (size_t)row * 512 + (k0 - 512); } };

template <bool MIDK, class AP, class EPI>
DI void gemm_tile(const AP& ap, const u16* __restrict__ W, int ldw, int K, int m0, int n0, const EPI& epi, char* smem, float r0, float r1, int tid, bool dry) {
  constexpr int SBUF = 2 * 128 * GP;
  u16* sA = (u16*)smem;
  u16* sB = sA + 128 * GP;
  const int lane = tid & 63, wave = tid >> 6, r = lane & 31, h = lane >> 5, wm = wave >> 1, wn = wave & 1;
  const int lrow = tid >> 3, lkc = (tid & 7) * 8;
  u32x4 ra[4], rb[4];
  f32x16 acc[2][2];
#pragma unroll
  for (int a = 0; a < 2; ++a)
#pragma unroll
    for (int b = 0; b < 2; ++b)
#pragma unroll
      for (int i = 0; i < 16; ++i) acc[a][b][i] = 0.f;
  const int nk = K >> 6;
#pragma unroll
  for (int q = 0; q < 4; ++q) {
    ra[q] = *(const u32x4*)(ap.ptr(m0 + lrow + 32 * q, 0) + lkc);
    rb[q] = *(const u32x4*)(W + (size_t)(n0 + lrow + 32 * q) * ldw + lkc);
  }
  __syncthreads();
#pragma unroll
  for (int q = 0; q < 4; ++q) {
    *(u32x4*)(sA + (lrow + 32 * q) * GP + lkc) = ra[q];
    *(u32x4*)(sB + (lrow + 32 * q) * GP + lkc) = rb[q];
  }
  if (nk > 1) {
#pragma unroll
    for (int q = 0; q < 4; ++q) {
      ra[q] = *(const u32x4*)(ap.ptr(m0 + lrow + 32 * q, 64) + lkc);
      rb[q] = *(const u32x4*)(W + (size_t)(n0 + lrow + 32 * q) * ldw + 64 + lkc);
    }
  }
  __syncthreads();
  for (int kt = 0; kt < nk; ++kt) {
    const int cb = (kt & 1) * SBUF, nb_ = SBUF - cb;
    if (kt + 1 < nk) {
#pragma unroll
      for (int q = 0; q < 4; ++q) {
        *(u32x4*)(sA + nb_ + (lrow + 32 * q) * GP + lkc) = ra[q];
        *(u32x4*)(sB + nb_ + (lrow + 32 * q) * GP + lkc) = rb[q];
      }
      if (kt + 2 < nk) {
        const int k0 = (kt + 2) << 6;
#pragma unroll
        for (int q = 0; q < 4; ++q) {
          ra[q] = *(const u32x4*)(ap.ptr(m0 + lrow + 32 * q, k0) + lkc);
          rb[q] = *(const u32x4*)(W + (size_t)(n0 + lrow + 32 * q) * ldw + k0 + lkc);
        }
      }
    }
#pragma unroll
    for (int ks = 0; ks < 4; ++ks) {
      bf16x8 wf[2], xf[2];
#pragma unroll
      for (int a = 0; a < 2; ++a) {
        wf[a] = *(const bf16x8*)(sB + cb + (wn * 64 + a * 32 + r) * GP + ks * 16 + h * 8);
        xf[a] = *(const bf16x8*)(sA + cb + (wm * 64 + a * 32 + r) * GP + ks * 16 + h * 8);
      }
#pragma unroll
      for (int a = 0; a < 2; ++a)
#pragma unroll
        for (int b = 0; b < 2; ++b) acc[a][b] = MFMA(wf[a], xf[b], acc[a][b]);
    }
    if (MIDK && kt == 7) {
#pragma unroll
      for (int a = 0; a < 2; ++a)
#pragma unroll
        for (int i = 0; i < 16; ++i) { acc[a][0][i] *= r0; acc[a][1][i] *= r1; }
    }
    __syncthreads();
  }
  if (!dry) epi(acc, n0 + wn * 64, m0 + wm * 64, lane, (u16*)smem + wave * 64 * GP);
}

struct ColId { DI int operator()(int ch) const { return ch * 8; } };
struct ColRope { DI int operator()(int ch) const { return (ch >> 2) * 96 + (ch & 3) * 8; } };

template <class COLF>
DI void stage_store(f32x16 (&acc)[2][2], u16* wl, int lane, u16* dst0, size_t pitch, const COLF& colf) {
  const int r = lane & 31, h = lane >> 5;
#pragma unroll
  for (int rb = 0; rb < 2; ++rb)
#pragma unroll
    for (int lb = 0; lb < 2; ++lb)
#pragma unroll
      for (int g4 = 0; g4 < 4; ++g4)
        store4(wl + (lb * 32 + r) * GP + rb * 32 + 8 * g4 + 4 * h, acc[rb][lb][4 * g4], acc[rb][lb][4 * g4 + 1], acc[rb][lb][4 * g4 + 2], acc[rb][lb][4 * g4 + 3]);
  WAVE_LDS_FENCE();
#pragma unroll
  for (int it = 0; it < 8; ++it) {
    const int row = it * 8 + (lane >> 3), ch = lane & 7;
    const u32x4 v = *(const u32x4*)(wl + row * GP + ch * 8);
    *(u32x4*)(dst0 + (size_t)row * pitch + colf(ch)) = v;
  }
  WAVE_LDS_FENCE();
}

DI void rope16(float (&v)[16], const float2* __restrict__ tabrow, int h) {
#pragma unroll
  for (int i = 0; i < 8; ++i) {
    const int f = (i & 3) + 8 * (i >> 2) + 4 * h;
    const float2 cs = tabrow[f];
    const float x1 = v[i], x2 = v[i + 8];
    v[i] = x1 * cs.x - x2 * cs.y;
    v[i + 8] = x2 * cs.x + x1 * cs.y;
  }
}

struct EpiIn {
  u16 *CQ, *CKV, *QG, *KG, *VGT, *KPE; float *ssq_q, *ssq_kv; const float *gq_g, *gk_g; const float2* tab;
  DI void operator()(f32x16 (&acc)[2][2], int nb, int mb, int lane, u16* wl) const {
    const int r = lane & 31, h = lane >> 5;
    int seq, it; decode_tile(mb >> 7, seq, it);
#pragma unroll
    for (int ti = 0; ti < 2; ++ti) {
      const int g = mb + ti * 32 + r, rr = g & 127;
      if (nb < 640) {
        float ss = 0.f;
#pragma unroll
        for (int fi = 0; fi < 2; ++fi)
#pragma unroll
          for (int i = 0; i < 16; ++i) ss += acc[fi][ti][i] * acc[fi][ti][i];
        ss += xhalf(ss);
        if (h == 0) unsafeAtomicAdd((nb < 384 ? ssq_q : ssq_kv) + g, ss);
      } else if (nb < 1280) {
        const bool isq = nb < 1152;
        const float* gg = isq ? gq_g : gk_g;
        float ss = 0.f;
#pragma unroll
        for (int fi = 0; fi < 2; ++fi)
#pragma unroll
          for (int i = 0; i < 16; ++i) ss += acc[fi][ti][i] * acc[fi][ti][i];
        ss += xhalf(ss);
        const float rstd = rsqrtf(ss * (1.0f / 64.0f) + EPS);
        const float osc = isq ? QSCALE_G : 1.0f;
        int prow = 0, pcol = 0;
        if (it > 0) { const int j = (it - 1) * 128 + rr; prow = j >> 6; pcol = j & 63; }
        u16* dst = isq ? QG + (size_t)g * 512 + (nb - 640) : KG + (size_t)g * 128 + (nb - 1152);
#pragma unroll
        for (int fi = 0; fi < 2; ++fi) {
          const int pos = fi == 0 ? prow : pcol;
          float v[16];
#pragma unroll
          for (int i = 0; i < 16; ++i) v[i] = acc[fi][ti][i] * rstd * gg[fi * 32 + crow(i, h)];
          rope16(v, tab + pos * 16, h);
#pragma unroll
          for (int g4 = 0; g4 < 4; ++g4)
            store4(dst + fi * 32 + 8 * g4 + 4 * h, v[4 * g4] * osc, v[4 * g4 + 1] * osc, v[4 * g4 + 2] * osc, v[4 * g4 + 3] * osc);
        }
      } else if (nb < 1408) {
#pragma unroll
        for (int fi = 0; fi < 2; ++fi)
#pragma unroll
          for (int i = 0; i < 16; ++i) VGT[(size_t)(nb - 1280 + fi * 32 + crow(i, h)) * MPAD + g] = f2bf(acc[fi][ti][i]);
      } else if (nb == 1408) {
        int pos = 128 * it + rr - 112; pos = pos < 0 ? 0 : pos;
        float v[16];
#pragma unroll
        for (int i = 0; i < 16; ++i) v[i] = acc[0][ti][i];
        rope16(v, tab + pos * 16, h);
#pragma unroll
        for (int g4 = 0; g4 < 4; ++g4) store4(KPE + (size_t)g * 32 + 8 * g4 + 4 * h, v[4 * g4], v[4 * g4 + 1], v[4 * g4 + 2], v[4 * g4 + 3]);
      }
    }
    if (nb < 384) stage_store(acc, wl, lane, CQ + (size_t)mb * 384 + nb, 384, ColId());
    else if (nb < 640) stage_store(acc, wl, lane, CKV + (size_t)mb * 256 + (nb - 384), 256, ColId());
  }
};

struct EpiQB {
  u16* QM; const float* ssq_q; const float2* tab;
  DI void operator()(f32x16 (&acc)[2][2], int nb, int mb, int lane, u16* wl) const {
    const int r = lane & 31, h = lane >> 5;
    int seq, it; decode_tile(mb >> 7, seq, it);
#pragma unroll
    for (int ti = 0; ti < 2; ++ti) {
      const int g = mb + ti * 32 + r, rr = g & 127;
      const float sc = rsqrtf(ssq_q[g] * (1.0f / 384.0f) + EPS) * QSCALE_M;
      if (nb < 512) {
#pragma unroll
        for (int fi = 0; fi < 2; ++fi)
#pragma unroll
          for (int i = 0; i < 16; ++i) acc[fi][ti][i] *= sc;
      } else {
        int pos = 128 * it + rr - 112; pos = pos < 0 ? 0 : pos;
#pragma unroll
        for (int fi = 0; fi < 2; ++fi) {
          float v[16];
#pragma unroll
          for (int i = 0; i < 16; ++i) v[i] = acc[fi][ti][i] * sc;
          rope16(v, tab + pos * 16, h);
#pragma unroll
          for (int i = 0; i < 16; ++i) acc[fi][ti][i] = v[i];
        }
      }
    }
    if (nb < 512) stage_store(acc, wl, lane, QM + (size_t)mb * 768 + (nb >> 6) * 96, 768, ColId());
    else stage_store(acc, wl, lane, QM + (size_t)mb * 768 + ((nb - 512) >> 5) * 96 + 64, 768, ColRope());
  }
};

struct EpiKVB {
  u16 *KN, *VMT; const float* ssq_kv;
  DI void operator()(f32x16 (&acc)[2][2], int nb, int mb, int lane, u16* wl) const {
    const int r = lane & 31, h = lane >> 5;
#pragma unroll
    for (int ti = 0; ti < 2; ++ti) {
      const int g = mb + ti * 32 + r;
      const float sc = rsqrtf(ssq_kv[g] * (1.0f / 256.0f) + EPS);
      if (nb < 512) {
#pragma unroll
        for (int fi = 0; fi < 2; ++fi)
#pragma unroll
          for (int i = 0; i < 16; ++i) acc[fi][ti][i] *= sc;
      } else {
#pragma unroll
        for (int fi = 0; fi < 2; ++fi)
#pragma unroll
          for (int i = 0; i < 16; ++i) VMT[(size_t)(nb - 512 + fi * 32 + crow(i, h)) * MPAD + g] = f2bf(acc[fi][ti][i] * sc);
      }
    }
    if (nb < 512) stage_store(acc, wl, lane, KN + (size_t)mb * 512 + nb, 512, ColId());
  }
};

DI void res_bases(const Params& p, int mt, bool from_input, const float*& sb, float*& db, int& minrow) {
  int seq, it; decode_tile(mt, seq, it);
  float* xm = (float*)(p.ws + OFF_XMETA);
  if (it == 0) {
    minrow = 112;
    db = xm + ((ptrdiff_t)seq * 16 - 112) * 1024;
    sb = from_input ? p.meta - 112 * 1024 : db;
  } else {
    minrow = 0;
    const size_t row = seq < 2 ? (size_t)seq * 16384 + (size_t)(it - 1) * 128 : 32768 + (size_t)(seq - 2) * 8192 + (size_t)(it - 1) * 128;
    db = p.out + row * 1024;
    sb = from_input ? (seq < 2 ? p.xp + row * 1024 : p.xs + (row - 32768) * 1024) : db;
  }
}

struct EpiRes {
  const float* sb; float* db; int minrow; float fin0, fin1;
  DI void operator()(f32x16 (&acc)[2][2], int nb, int mb, int lane, u16* wl) const {
    const int r = lane & 31, h = lane >> 5, mbl = mb & 127;
    float* wf = (float*)wl;
#pragma unroll
    for (int fi = 0; fi < 2; ++fi) {
#pragma unroll
      for (int ti = 0; ti < 2; ++ti) {
        const float sc = ti == 0 ? fin0 : fin1;
#pragma unroll
        for (int g4 = 0; g4 < 4; ++g4) {
          float4 o = make_float4(acc[fi][ti][4 * g4] * sc, acc[fi][ti][4 * g4 + 1] * sc, acc[fi][ti][4 * g4 + 2] * sc, acc[fi][ti][4 * g4 + 3] * sc);
          *(float4*)(wf + (ti * 32 + r) * 36 + 8 * g4 + 4 * h) = o;
        }
      }
      WAVE_LDS_FENCE();
#pragma unroll
      for (int it = 0; it < 8; ++it) {
        const int row = it * 8 + (lane >> 3), ch = lane & 7;
        const float4 a = *(const float4*)(wf + row * 36 + ch * 4);
        const int trow = mbl + row;
        if (trow >= minrow) {
          const size_t off = (size_t)trow * 1024 + nb + fi * 32 + ch * 4;
          float4 x = *(const float4*)(sb + off);
          x.x += a.x; x.y += a.y; x.z += a.z; x.w += a.w;
          *(float4*)(db + off) = x;
        }
      }
      WAVE_LDS_FENCE();
    }
  }
};

struct EpiUp {
  u16* U0;
  DI void operator()(f32x16 (&acc)[2][2], int nb, int mb, int lane, u16* wl) const {
#pragma unroll
    for (int ti = 0; ti < 2; ++ti)
#pragma unroll
      for (int fi = 0; fi < 2; ++fi)
#pragma unroll
        for (int i = 0; i < 16; ++i) { const float a = fmaxf(acc[fi][ti][i], 0.f); acc[fi][ti][i] = a * a; }
    stage_store(acc, wl, lane, U0 + (size_t)mb * 4096 + nb, 4096, ColId());
  }
};

constexpr float ATT_THR = 8.0f;

template <int DQK>
struct AttnCtx {
  static constexpr int KP = DQK + 8, NKS = DQK / 16, KCH = DQK / 8, NKL = 64 * KCH / 256, KBUF = 64 * KP, VBUF = 64 * GP;
  const u16 *Kb, *KPEb, *Vt; int kpitch, rowk0, nt, tid, r, h, sr;
  u16 *sK, *sV;
  bf16x8 qf[NKS], kone, qm;
  f32x16 o[2];
  float mref, l;
  u32x4 rk[NKL], rv[2];

  int koff[NKL], voff[2];
  DI void init_offs() {
#pragma unroll
    for (int q = 0; q < NKL; ++q) {
      const int c = tid + 256 * q, row = c / KCH, cc = c % KCH;
      koff[q] = (DQK == 96 && cc >= 8) ? row * 32 + (cc - 8) * 8 : row * kpitch + cc * 8;
    }
#pragma unroll
    for (int q = 0; q < 2; ++q) { const int c = tid + 256 * q, dv = c >> 3, kc = c & 7; voff[q] = dv * MPAD + kc * 8; }
  }
  DI void gload_k(int t) {
    const int row0 = rowk0 + t * 64;
    const u16* kt = Kb + (size_t)row0 * kpitch;
    const u16* pt = KPEb + (size_t)row0 * 32;
#pragma unroll
    for (int q = 0; q < NKL; ++q) {
      const int c = tid + 256 * q, cc = c % KCH;
      rk[q] = *(const u32x4*)(((DQK == 96 && cc >= 8) ? pt : kt) + koff[q]);
    }
  }
  DI void gload_v(int t) {
    const u16* vt = Vt + (rowk0 + t * 64);
#pragma unroll
    for (int q = 0; q < 2; ++q) rv[q] = *(const u32x4*)(vt + voff[q]);
  }
  DI void sstore_k(int buf) {
#pragma unroll
    for (int q = 0; q < NKL; ++q) {
      const int c = tid + 256 * q, row = c / KCH, cc = c % KCH;
      *(u32x4*)(sK + buf * KBUF + row * KP + cc * 8) = rk[q];
    }
  }
  DI void sstore_v(int buf) {
#pragma unroll
    for (int q = 0; q < 2; ++q) {
      const int c = tid + 256 * q, dv = c >> 3, kc = c & 7;
      *(u32x4*)(sV + buf * VBUF + dv * GP + kc * 8) = rv[q];
    }
  }
  DI void qk(int buf, f32x16 (&s)[2]) {
    const u16* kb = sK + buf * KBUF + sr * KP + h * 8;
#pragma unroll
    for (int kb2 = 0; kb2 < 2; ++kb2)
#pragma unroll
      for (int i = 0; i < 16; ++i) s[kb2][i] = 0.f;
#pragma unroll
    for (int ks = 0; ks < NKS; ++ks)
#pragma unroll
      for (int kb2 = 0; kb2 < 2; ++kb2) {
        const bf16x8 a = *(const bf16x8*)(kb + kb2 * 32 * KP + ks * 16);
        s[kb2] = MFMA(a, qf[ks], s[kb2]);
      }
    s[0] = MFMA(kone, qm, s[0]);
    s[1] = MFMA(kone, qm, s[1]);
  }
  template <int PAR>
  DI void step(int t, f32x16 (&cur)[2], f32x16 (&nxt)[2]) {
    if (t + 1 < nt) sstore_k(PAR ^ 1);
    if (t > 0) sstore_v(PAR);
    __syncthreads();
    if (t + 1 < nt) qk(PAR ^ 1, nxt);
    float mx = fmaxf(cur[0][0], cur[1][0]);
#pragma unroll
    for (int i = 1; i < 16; ++i) mx = fmaxf(fmaxf(cur[0][i], cur[1][i]), mx);
    if (__builtin_amdgcn_ballot_w64(mx > ATT_THR) != 0ull) {
      asm volatile("" ::: "memory");
      mx = fmaxf(mx, xhalf(mx));
      const float want = mref + fmaxf(mx, 0.f);
      const float mn = __uint_as_float(pack2(want, 0.f) << 16);
      const float d = mn - mref;
      const float alpha = __builtin_amdgcn_exp2f(-d);
      mref = mn;
      l *= alpha;
#pragma unroll
      for (int a = 0; a < 2; ++a)
#pragma unroll
        for (int i = 0; i < 16; ++i) { o[a][i] *= alpha; cur[a][i] -= d; nxt[a][i] -= d; }
      u32x4 q4 = {h == 0 ? (pack2(-mn, 0.f) & 0xffffu) : 0u, 0u, 0u, 0u};
      qm = __builtin_bit_cast(bf16x8, q4);
    }
    float psum = 0.f;
#pragma unroll
    for (int kb2 = 0; kb2 < 2; ++kb2)
#pragma unroll
      for (int i = 0; i < 16; ++i) { const float pv = __builtin_amdgcn_exp2f(cur[kb2][i]); cur[kb2][i] = pv; psum += pv; }
    l += psum;
    if (t + 2 < nt) gload_k(t + 2);
    if (t + 1 < nt) gload_v(t + 1);
    const u16* vb = sV + PAR * VBUF + r * GP + h * 8;
#pragma unroll
    for (int kb2 = 0; kb2 < 2; ++kb2)
#pragma unroll
      for (int s2 = 0; s2 < 2; ++s2) {
        u32x4 pk = {pack2(cur[kb2][8 * s2], cur[kb2][8 * s2 + 1]), pack2(cur[kb2][8 * s2 + 2], cur[kb2][8 * s2 + 3]),
                    pack2(cur[kb2][8 * s2 + 4], cur[kb2][8 * s2 + 5]), pack2(cur[kb2][8 * s2 + 6], cur[kb2][8 * s2 + 7])};
        const bf16x8 pf = __builtin_bit_cast(bf16x8, pk);
#pragma unroll
        for (int db = 0; db < 2; ++db) {
          const bf16x8 a = *(const bf16x8*)(vb + db * 32 * GP + kb2 * 32 + s2 * 16);
          o[db] = MFMA(a, pf, o[db]);
        }
      }
  }
};

template <int DQK>
DI void attn_item(const u16* __restrict__ Qb, int qpitch, const u16* __restrict__ Kb, int kpitch, const u16* __restrict__ KPEb,
                  const u16* __restrict__ Vt, float* __restrict__ ssq, int rowq0, int rowk0, int nt, char* smem, int tid, bool dry) {
  typedef AttnCtx<DQK> C;
  C c;
  const int lane = tid & 63, wave = tid >> 6, r = lane & 31, h = lane >> 5;
  c.Kb = Kb; c.KPEb = KPEb; c.Vt = Vt; c.kpitch = kpitch; c.rowk0 = rowk0; c.nt = nt; c.tid = tid; c.r = r; c.h = h; c.sr = swap23(r);
  c.sK = (u16*)smem; c.sV = c.sK + 2 * C::KBUF;
  c.init_offs();
  const int myrow = rowq0 + wave * 32 + r;
  {
    const u16* qrow = Qb + (size_t)myrow * qpitch + h * 8;
#pragma unroll
    for (int ks = 0; ks < C::NKS; ++ks) c.qf[ks] = *(const bf16x8*)(qrow + ks * 16);
  }
#pragma unroll
  for (int a = 0; a < 2; ++a)
#pragma unroll
    for (int i = 0; i < 16; ++i) c.o[a][i] = 0.f;
  c.mref = 0.f; c.l = 0.f;
  {
    u32x4 k1 = {h == 0 ? 0x3F80u : 0u, 0u, 0u, 0u}, z4 = {0u, 0u, 0u, 0u};
    c.kone = __builtin_bit_cast(bf16x8, k1); c.qm = __builtin_bit_cast(bf16x8, z4);
  }
  f32x16 sa[2], sb[2];
  c.gload_k(0); c.gload_v(0);
  __syncthreads();
  c.sstore_k(0); c.sstore_v(0);
  if (nt > 1) c.gload_k(1);
  __syncthreads();
  c.qk(0, sa);
#pragma unroll
  for (int i = 0; i < 16; ++i) {
    sa[0][i] = -1e30f;
    if (swap23(crow(i, h)) < 16) sa[1][i] = -1e30f;
  }
  int t = 0;
  for (; t + 1 < nt; t += 2) {
    c.template step<0>(t, sa, sb);
    c.template step<1>(t + 1, sb, sa);
  }
  if (t < nt) c.template step<0>(t, sa, sb);
  if (dry) return;
  float l = c.l;
  l += xhalf(l);
  const float inv = 1.0f / l;
  float ss = 0.f;
  u16* orow = (u16*)Qb + (size_t)myrow * qpitch;
#pragma unroll
  for (int db = 0; db < 2; ++db)
#pragma unroll
    for (int g4 = 0; g4 < 4; ++g4) {
      const float a0 = c.o[db][4 * g4] * inv, a1 = c.o[db][4 * g4 + 1] * inv, a2 = c.o[db][4 * g4 + 2] * inv, a3 = c.o[db][4 * g4 + 3] * inv;
      ss += a0 * a0 + a1 * a1 + a2 * a2 + a3 * a3;
      store4(orow + db * 32 + 8 * g4 + 4 * h, a0, a1, a2, a3);
    }
  ss += xhalf(ss);
  if (h == 0) unsafeAtomicAdd(ssq + myrow, ss);
}

constexpr int N_ITEMS = 8288;
DI void phase_attn(const Params& p, int layer, char* smem, int* s_item, int tid, bool dry) {
  int* cnt = (int*)(p.ws + OFF_CNT) + layer + (dry ? 2 : 0);
  u16* QM = (u16*)(p.ws + OFF_HN);
  const u16* KN = (const u16*)(p.ws + OFF_KN);
  const u16* KPE = (const u16*)(p.ws + OFF_KPE);
  const u16* VMT = (const u16*)(p.ws + OFF_VMT);
  u16* QG = (u16*)(p.ws + OFF_QG);
  const u16* KG = (const u16*)(p.ws + OFF_KG);
  const u16* VGT = (const u16*)(p.ws + OFF_VGT);
  float* ssq = (float*)(p.ws + OFF_SSQ);
  for (;;) {
    if (tid == 0) *s_item = atomicAdd(cnt, 1);
    __syncthreads();
    const int it = *s_item;
    __syncthreads();
    if (it >= N_ITEMS) break;
    int grp, seq, head, qi, nt;
    if (it < 4128) { grp = it / 2064; const int u = it - grp * 2064; const int sh = u / 129; qi = u - sh * 129; seq = sh >> 3; head = sh & 7; nt = 257; }
    else { const int u0 = it - 4128; grp = u0 / 2080; const int u = u0 - grp * 2080; const int sh = u / 65; qi = u - sh * 65; seq = 2 + (sh >> 3); head = sh & 7; nt = 129; }
    const int P = seq_base(seq);
    if (grp == 0)
      attn_item<96>(QM + head * 96, 768, KN + head * 64, 512, KPE, VMT + (size_t)head * 64 * MPAD, ssq + 2 * (size_t)MPAD, P + qi * 128, P + 64, nt, smem, tid, dry);
    else
      attn_item<64>(QG + head * 64, 512, KG + (head >> 2) * 64, 128, nullptr, VGT + (size_t)(head >> 2) * 64 * MPAD, ssq + 3 * (size_t)MPAD, P + qi * 128, P + 64, nt, smem, tid, dry);
  }
}

__global__ void __launch_bounds__(256, 2) mega(Params pin) {
  __shared__ __attribute__((aligned(16))) char smem[2 * 2 * 128 * GP * 2];
  __shared__ int s_item;
  const int G = gridDim.x, b = blockIdx.x;
  const int vb = ((G & 7) == 0) ? ((b & 7) * (G >> 3) + (b >> 3)) : b;
  for (int st = pin.phase_lo; st < pin.phase_hi; ++st) {
    int ph; bool dry = false;
    if (st == 0) ph = 0;
    else if (st == 41) ph = 21;
    else {
      const int u = st - 1, lay = u / 20, v = u - lay * 20, sb = v >> 1;
      dry = (v & 1) == 0;
      if (dry && !((pin.probe >> sb) & 1)) continue;
      ph = 1 + lay * 10 + sb;
    }
    if (st > pin.phase_lo) cg::this_grid().sync();
    Params p = pin;
    asm volatile("" : "+s"(p.xp), "+s"(p.xs), "+s"(p.meta), "+s"(p.attn_g), "+s"(p.w_in), "+s"(p.qa_g), "+s"(p.w_qb), "+s"(p.kva_g), "+s"(p.w_kvb), "+s"(p.gq_g));
    asm volatile("" : "+s"(p.gk_g), "+s"(p.mo_g), "+s"(p.go_g), "+s"(p.w_out), "+s"(p.mlp_g), "+s"(p.w_up), "+s"(p.w_dn), "+s"(p.fin_g), "+s"(p.out), "+s"(p.ws));
    int tid = threadIdx.x;
    asm volatile("" : "+v"(tid));
    const int lane = tid & 63, wave = tid >> 6, r = lane & 31;
    float* ssq = (float*)(p.ws + OFF_SSQ);
    const float2* tab = (const float2*)(p.ws + OFF_TAB);
    if (ph == 0) { phase_prep(p, tid); continue; }
    if (ph == 21) { phase_final(p, tid); continue; }
    const int layer = (ph - 1) / 10, sub = (ph - 1) % 10;
    const u16* Wl = (const u16*)(p.ws + OFF_W) + (size_t)layer * W_LAYER;
    if (sub == 0) {
      phase_norm(p, p.attn_g + layer * 1024, layer == 0, true, tid);
    } else if (sub == 1) {
      EpiIn e; e.CQ = (u16*)(p.ws + OFF_CQ); e.CKV = (u16*)(p.ws + OFF_CKV); e.QG = (u16*)(p.ws + OFF_QG); e.KG = (u16*)(p.ws + OFF_KG);
      e.VGT = (u16*)(p.ws + OFF_VGT); e.KPE = (u16*)(p.ws + OFF_KPE); e.ssq_q = ssq; e.ssq_kv = ssq + MPAD;
      e.gq_g = p.gq_g + layer * 64; e.gk_g = p.gk_g + layer * 64; e.tab = tab;
      APLin ap{(const u16*)(p.ws + OFF_HN), 1024};
      for (int t = vb; t < NTM * 12; t += G) { const int mt = t / 12, nt = t - mt * 12; gemm_tile<false>(ap, Wl + WO_IN, 1024, 1024, mt * 128, nt * 128, e, smem, 1.f, 1.f, tid, dry); }
    } else if (sub == 2) {
      EpiQB e2; e2.QM = (u16*)(p.ws + OFF_HN); e2.ssq_q = ssq; e2.tab = tab;
      EpiKVB e3; e3.KN = (u16*)(p.ws + OFF_KN); e3.VMT = (u16*)(p.ws + OFF_VMT); e3.ssq_kv = ssq + MPAD;
      APLin a2{(const u16*)(p.ws + OFF_CQ), 384};
      APLin a3{(const u16*)(p.ws + OFF_CKV), 256};
      for (int t = vb; t < NTM * 14; t += G) {
        if (t < NTM * 6) { const int mt = t / 6, nt = t - mt * 6; gemm_tile<false>(a2, Wl + WO_QB, 384, 384, mt * 128, nt * 128, e2, smem, 1.f, 1.f, tid, dry); }
        else { const int u = t - NTM * 6; const int mt = u >> 3, nt = u & 7; gemm_tile<false>(a3, Wl + WO_KVB, 256, 256, mt * 128, nt * 128, e3, smem, 1.f, 1.f, tid, dry); }
      }
    } else if (sub == 3) {
      phase_attn(p, layer, smem, &s_item, tid, dry);
    } else if (sub == 4) {
      APMix ap{(const u16*)(p.ws + OFF_HN), (const u16*)(p.ws + OFF_QG)};
      for (int t = vb; t < NTM * 8; t += G) {
        const int mt = t >> 3, nt = t & 7;
        const int g0 = mt * 128 + (wave >> 1) * 64 + r;
        const float ra0 = rsqrtf(ssq[2 * (size_t)MPAD + g0] * (1.0f / 512.0f) + EPS), rg0 = rsqrtf(ssq[3 * (size_t)MPAD + g0] * (1.0f / 512.0f) + EPS);
        const float ra1 = rsqrtf(ssq[2 * (size_t)MPAD + g0 + 32] * (1.0f / 512.0f) + EPS), rg1 = rsqrtf(ssq[3 * (size_t)MPAD + g0 + 32] * (1.0f / 512.0f) + EPS);
        EpiRes e; res_bases(p, mt, layer == 0, e.sb, e.db, e.minrow); e.fin0 = rg0; e.fin1 = rg1;
        gemm_tile<true>(ap, Wl + WO_OUT, 1024, 1024, mt * 128, nt * 128, e, smem, ra0 / rg0, ra1 / rg1, tid, dry);
      }
    } else if (sub == 5) {
      phase_norm(p, p.mlp_g + layer * 1024, false, false, tid);
    } else if (sub == 6 || sub == 8) {
      const int mh = (sub - 6) >> 1;
      EpiUp e; e.U0 = (u16*)(p.ws + OFF_U) - (size_t)mh * 259 * 128 * 4096;
      APLin ap{(const u16*)(p.ws + OFF_HN), 1024};
      for (int t = vb; t < 259 * 32; t += G) {
        int ml, nt;
        if (t < 256 * 32) { const int blk = t >> 6, w = t & 63; ml = (blk >> 2) * 8 + (w >> 3); nt = (blk & 3) * 8 + (w & 7); }
        else { ml = t >> 5; nt = t & 31; }
        gemm_tile<false>(ap, Wl + WO_UP, 1024, 1024, (mh * 259 + ml) * 128, nt * 128, e, smem, 1.f, 1.f, tid, dry);
      }
    } else {
      const int mh = (sub - 7) >> 1;
      APLin ap{(const u16*)(p.ws + OFF_U) - (size_t)mh * 259 * 128 * 4096, 4096};
      for (int t = vb; t < 259 * 8; t += G) {
        const int mt = mh * 259 + (t >> 3), nt = t & 7;
        EpiRes e; res_bases(p, mt, false, e.sb, e.db, e.minrow); e.fin0 = 1.f; e.fin1 = 1.f;
        gemm_tile<false>(ap, Wl + WO_DN, 4096, 4096, mt * 128, nt * 128, e, smem, 1.f, 1.f, tid, dry);
      }
    }
  }
}

extern "C" void kernel_launch(void* const* d_in, const int* in_sizes, int n_in, void* d_out, int out_size, void* d_ws, size_t ws_size,
                              hipStream_t stream) {
  static int grid_blocks = 0;
  if (!grid_blocks) {
    int dev = 0, cus = 0, per_cu = 0;
    hipGetDevice(&dev);
    hipDeviceGetAttribute(&cus, hipDeviceAttributeMultiprocessorCount, dev);
    hipOccupancyMaxActiveBlocksPerMultiprocessor(&per_cu, mega, 256, 0);
    if (per_cu > 2) per_cu = 2;
    if (per_cu < 1) per_cu = 1;
    grid_blocks = cus * per_cu;
  }
  Params p{};
  p.xp = (const float*)d_in[0]; p.xs = (const float*)d_in[1]; p.meta = (const float*)d_in[2];
  p.attn_g = (const float*)d_in[3]; p.w_in = (const float*)d_in[4]; p.qa_g = (const float*)d_in[5]; p.w_qb = (const float*)d_in[6];
  p.kva_g = (const float*)d_in[7]; p.w_kvb = (const float*)d_in[8]; p.gq_g = (const float*)d_in[9]; p.gk_g = (const float*)d_in[10];
  p.mo_g = (const float*)d_in[11]; p.go_g = (const float*)d_in[12]; p.w_out = (const float*)d_in[13]; p.mlp_g = (const float*)d_in[14];
  p.w_up = (const float*)d_in[15]; p.w_dn = (const float*)d_in[16]; p.fin_g = (const float*)d_in[17];
  p.out = (float*)d_out; p.ws = (char*)d_ws;
#if MK_MULTI
  for (int ph = 0; ph < 42; ++ph) {
    p.phase_lo = ph; p.phase_hi = ph + 1; p.probe = PROBE_MASK;
    if (ph > 0 && ph < 41 && ((ph - 1) & 1) == 0 && !((PROBE_MASK >> (((ph - 1) % 20) >> 1)) & 1)) continue;
    hipLaunchKernelGGL(mega, dim3(grid_blocks), dim3(256), 0, stream, p);
  }
#else
  p.phase_lo = 0; p.phase_hi = 42; p.probe = PROBE_MASK;
  void* args[] = {&p};
  hipError_t e = hipLaunchCooperativeKernel((void*)mega, dim3(grid_blocks), dim3(256), args, 0, stream);
  if (e != hipSuccess) fprintf(stderr, "cooperative launch failed: %s (grid %d)\n", hipGetErrorString(e), grid_blocks);
#endif
}
```

```cpp
#include <hip/hip_runtime.h>
#include <hip/hip_cooperative_groups.h>
#include <stdint.h>
#include <cstdio>
namespace cg = cooperative_groups;

#ifndef PROBE_MASK
#define PROBE_MASK 0
#endif
#ifndef MK_MULTI
#define MK_MULTI 0
#endif

typedef unsigned short u16;
typedef short bf16x8 __attribute__((ext_vector_type(8)));
typedef float f32x16 __attribute__((ext_vector_type(16)));
typedef unsigned u32x4 __attribute__((ext_vector_type(4)));
typedef unsigned u32x2 __attribute__((ext_vector_type(2)));
typedef float f32x2v __attribute__((ext_vector_type(2)));
typedef __bf16 bf16x2v __attribute__((ext_vector_type(2)));
#define DI __device__ __forceinline__
#define WAVE_LDS_FENCE() asm volatile("s_waitcnt lgkmcnt(0)" ::: "memory")
#define MFMA(a, b, c) __builtin_amdgcn_mfma_f32_32x32x16_bf16((a), (b), (c), 0, 0, 0)

constexpr int MPAD = 66304;
constexpr int NTM = 518;
constexpr float EPS = 1e-6f;
constexpr float LOG2E = 1.4426950408889634f;
constexpr float QSCALE_M = 0.10206207261596575f * LOG2E;
constexpr float QSCALE_G = 0.125f * LOG2E;

constexpr size_t SZ_WIN = 1536ull * 1024, SZ_WQB = 768ull * 384, SZ_WKVB = 1024ull * 256, SZ_WOUT = 1024ull * 1024,
                 SZ_WUP = 4096ull * 1024, SZ_WDN = 1024ull * 4096;
constexpr size_t WO_IN = 0, WO_QB = WO_IN + SZ_WIN, WO_KVB = WO_QB + SZ_WQB, WO_OUT = WO_KVB + SZ_WKVB, WO_UP = WO_OUT + SZ_WOUT,
                 WO_DN = WO_UP + SZ_WUP, W_LAYER = WO_DN + SZ_WDN;
constexpr size_t OFF_W = 0;
constexpr size_t OFF_TAB = OFF_W + 2 * W_LAYER * 2;
constexpr size_t OFF_XMETA = OFF_TAB + 16400ull * 16 * 8;
constexpr size_t OFF_SSQ = OFF_XMETA + 96ull * 1024 * 4;
constexpr size_t OFF_CNT = OFF_SSQ + 4ull * MPAD * 4;
constexpr size_t OFF_HN = OFF_CNT + 1024;
constexpr size_t OFF_CQ = OFF_HN + (size_t)MPAD * 1024 * 2;
constexpr size_t OFF_CKV = OFF_CQ + (size_t)MPAD * 384 * 2;
constexpr size_t OFF_KN = OFF_CKV + (size_t)MPAD * 256 * 2;
constexpr size_t OFF_KPE = OFF_KN + (size_t)MPAD * 512 * 2;
constexpr size_t OFF_VMT = OFF_KPE + (size_t)MPAD * 32 * 2;
constexpr size_t OFF_QG = OFF_VMT + (size_t)MPAD * 512 * 2;
constexpr size_t OFF_KG = OFF_QG + (size_t)MPAD * 512 * 2;
constexpr size_t OFF_VGT = OFF_KG + (size_t)MPAD * 128 * 2;
constexpr size_t OFF_END = OFF_VGT + (size_t)MPAD * 128 * 2;
constexpr size_t OFF_U = OFF_CQ;
static_assert(OFF_U + (size_t)259 * 128 * 4096 * 2 <= OFF_END, "U fits");
static_assert(OFF_END <= 536870912ull, "workspace");

struct Params {
  const float* xp; const float* xs; const float* meta;
  const float* attn_g; const float* w_in; const float* qa_g; const float* w_qb; const float* kva_g; const float* w_kvb;
  const float* gq_g; const float* gk_g; const float* mo_g; const float* go_g; const float* w_out; const float* mlp_g;
  const float* w_up; const float* w_dn; const float* fin_g;
  float* out; char* ws;
  int phase_lo, phase_hi, probe, pad_;
};

DI unsigned pack2(float a, float b) { f32x2v f = {a, b}; bf16x2v v = __builtin_convertvector(f, bf16x2v); return __builtin_bit_cast(unsigned, v); }
DI u16 f2bf(float a) { return (u16)(pack2(a, 0.f) & 0xffffu); }
DI void store4(u16* dst, float a, float b, float c, float d) { u32x2 v = {pack2(a, b), pack2(c, d)}; *(u32x2*)dst = v; }
DI int crow(int i, int h) { return (i & 3) + 8 * (i >> 2) + 4 * h; }
DI int swap23(int r) { return (r & 0x13) | ((r & 4) << 1) | ((r & 8) >> 1); }
DI float xhalf(float v) { return __shfl_xor(v, 32); }

DI void decode_tile(int T, int& seq, int& i) {
  if (T < 258) { seq = (T >= 129) ? 1 : 0; i = T - seq * 129; }
  else { int u = T - 258; int q = u / 65; seq = 2 + q; i = u - q * 65; }
}
DI int seq_base(int seq) { return seq < 2 ? seq * 16512 : 33024 + (seq - 2) * 8320; }

DI const float* xrow_src(const Params& p, int g, bool from_input) {
  int T = g >> 7, r = g & 127, seq, i; decode_tile(T, seq, i);
  if (i == 0) {
    if (r < 112) return nullptr;
    return from_input ? p.meta + (size_t)(r - 112) * 1024 : (const float*)(p.ws + OFF_XMETA) + (size_t)(seq * 16 + r - 112) * 1024;
  }
  int j = (i - 1) * 128 + r;
  if (seq < 2) { size_t row = (size_t)seq * 16384 + j; return from_input ? p.xp + row * 1024 : p.out + row * 1024; }
  size_t row = (size_t)(seq - 2) * 8192 + j;
  return from_input ? p.xs + row * 1024 : p.out + (32768 + row) * 1024;
}
DI float* xrow_dst(const Params& p, int g) {
  int T = g >> 7, r = g & 127, seq, i; decode_tile(T, seq, i);
  if (i == 0) {
    if (r < 112) return nullptr;
    return (float*)(p.ws + OFF_XMETA) + (size_t)(seq * 16 + r - 112) * 1024;
  }
  int j = (i - 1) * 128 + r;
  if (seq < 2) { size_t row = (size_t)seq * 16384 + j; return p.out + row * 1024; }
  size_t row = (size_t)(seq - 2) * 8192 + j;
  return p.out + (32768 + row) * 1024;
}

DI int mapcol(int kind, int n) {
  if (kind == 1) { if (n < 640) return n; if (n < 1408) return n + 32; if (n < 1440) return 640 + (n - 1408); return -1; }
  if (kind == 2) { if (n < 512) return (n >> 6) * 96 + (n & 63); int m = n - 512; return (m >> 5) * 96 + 64 + (m & 31); }
  if (kind == 3) { if (n < 512) return (n >> 6) * 128 + (n & 63); int m = n - 512; return (m >> 6) * 128 + 64 + (m & 63); }
  return n;
}
DI void prep_weight(const float* __restrict__ src, int Nsrc, u16* __restrict__ dst, int Nout, int K, const float* gA, const float* gB,
                    int ksplit, int kind, int gtid, int gthreads) {
  const int total = Nout * (K >> 3);
  for (int u = gtid; u < total; u += gthreads) {
    const int n = u % Nout, kc = u / Nout;
    const int col = mapcol(kind, n);
    const int k = kc * 8;
    float v[8];
#pragma unroll
    for (int j = 0; j < 8; ++j) {
      float x = 0.f;
      if (col >= 0) {
        x = src[(size_t)(k + j) * Nsrc + col];
        if (gA) x *= (k + j < ksplit) ? gA[k + j] : gB[k + j - ksplit];
      }
      v[j] = x;
    }
    u32x4 o = {pack2(v[0], v[1]), pack2(v[2], v[3]), pack2(v[4], v[5]), pack2(v[6], v[7])};
    *(u32x4*)(dst + (size_t)n * K + k) = o;
  }
}

DI void phase_prep(const Params& p, int tid) {
  const int gtid = blockIdx.x * 256 + tid, gthreads = gridDim.x * 256;
  u16* W = (u16*)(p.ws + OFF_W);
  for (int l = 0; l < 2; ++l) {
    u16* Wl = W + (size_t)l * W_LAYER;
    prep_weight(p.w_in + (size_t)l * 1024 * 1440, 1440, Wl + WO_IN, 1536, 1024, nullptr, nullptr, 0, 1, gtid, gthreads);
    prep_weight(p.w_qb + (size_t)l * 384 * 768, 768, Wl + WO_QB, 768, 384, p.qa_g + l * 384, p.qa_g + l * 384, 384, 2, gtid, gthreads);
    prep_weight(p.w_kvb + (size_t)l * 256 * 1024, 1024, Wl + WO_KVB, 1024, 256, p.kva_g + l * 256, p.kva_g + l * 256, 256, 3, gtid, gthreads);
    prep_weight(p.w_out + (size_t)l * 1024 * 1024, 1024, Wl + WO_OUT, 1024, 1024, p.mo_g + l * 512, p.go_g + l * 512, 512, 0, gtid, gthreads);
    prep_weight(p.w_up + (size_t)l * 1024 * 4096, 4096, Wl + WO_UP, 4096, 1024, nullptr, nullptr, 0, 0, gtid, gthreads);
    prep_weight(p.w_dn + (size_t)l * 4096 * 1024, 1024, Wl + WO_DN, 1024, 4096, nullptr, nullptr, 0, 0, gtid, gthreads);
  }
  float2* tab = (float2*)(p.ws + OFF_TAB);
  for (int u = gtid; u < 16400 * 16; u += gthreads) {
    const int pos = u >> 4, f = u & 15;
    const float invf = 1.0f / powf(10000.0f, (float)(2 * f) / 32.0f);
    const float ang = (float)pos * invf;
    const double rev = (double)ang * 0.15915494309189535;
    const double fr = rev - rint(rev);
    const float x = (float)(2.0 * fr);
    tab[u] = make_float2(cospif(x), sinpif(x));
  }
  float* xm = (float*)(p.ws + OFF_XMETA);
  for (int u = gtid; u < 96 * 1024; u += gthreads) xm[u] = p.meta[u & 16383];
  int* cnt = (int*)(p.ws + OFF_CNT);
  if (gtid < 64) cnt[gtid] = 0;
}

DI void phase_norm(const Params& p, const float* __restrict__ gain, bool from_input, bool zero_ssq, int tid) {
  const int lane = tid & 63;
  const int gw = blockIdx.x * 4 + (tid >> 6), nw = gridDim.x * 4;
  u16* HN = (u16*)(p.ws + OFF_HN);
  float* ssq = (float*)(p.ws + OFF_SSQ);
  for (int g = gw; g < MPAD; g += nw) {
    const float* xr = xrow_src(p, g, from_input);
    u16* hr = HN + (size_t)g * 1024;
    if (!xr) {
      u32x4 z = {0u, 0u, 0u, 0u};
      *(u32x4*)(hr + lane * 16) = z;
      *(u32x4*)(hr + lane * 16 + 8) = z;
    } else {
      float4 v[4];
#pragma unroll
      for (int q = 0; q < 4; ++q) v[q] = ((const float4*)xr)[lane + 64 * q];
      float ss = 0.f;
#pragma unroll
      for (int q = 0; q < 4; ++q) ss += v[q].x * v[q].x + v[q].y * v[q].y + v[q].z * v[q].z + v[q].w * v[q].w;
#pragma unroll
      for (int o = 32; o >= 1; o >>= 1) ss += __shfl_xor(ss, o);
      const float rstd = rsqrtf(ss * (1.0f / 1024.0f) + EPS);
#pragma unroll
      for (int q = 0; q < 4; ++q) {
        const float4 gg = ((const float4*)gain)[lane + 64 * q];
        store4(hr + 4 * (lane + 64 * q), v[q].x * rstd * gg.x, v[q].y * rstd * gg.y, v[q].z * rstd * gg.z, v[q].w * rstd * gg.w);
      }
    }
    if (zero_ssq && lane < 4) ssq[(size_t)lane * MPAD + g] = 0.f;
  }
}

DI void phase_final(const Params& p, int tid) {
  const int lane = tid & 63;
  const int gw = blockIdx.x * 4 + (tid >> 6), nw = gridDim.x * 4;
  for (int g = gw; g < MPAD; g += nw) {
    if (((g >> 7) == 0) || ((g >> 7) == 129) || ((g >> 7) >= 258 && ((g >> 7) - 258) % 65 == 0)) continue;
    float* xr = xrow_dst(p, g);
    float4 v[4];
#pragma unroll
    for (int q = 0; q < 4; ++q) v[q] = ((const float4*)xr)[lane + 64 * q];
    float ss = 0.f;
#pragma unroll
    for (int q = 0; q < 4; ++q) ss += v[q].x * v[q].x + v[q].y * v[q].y + v[q].z * v[q].z + v[q].w * v[q].w;
#pragma unroll
    for (int o = 32; o >= 1; o >>= 1) ss += __shfl_xor(ss, o);
    const float rstd = rsqrtf(ss * (1.0f / 1024.0f) + EPS);
#pragma unroll
    for (int q = 0; q < 4; ++q) {
      const float4 gg = ((const float4*)p.fin_g)[lane + 64 * q];
      float4 o = make_float4(v[q].x * rstd * gg.x, v[q].y * rstd * gg.y, v[q].z * rstd * gg.z, v[q].w * rstd * gg.w);
      ((float4*)xr)[lane + 64 * q] = o;
    }
  }
}

constexpr int GP = 72;
struct APLin { const u16* A; int lda; DI const u16* ptr(int row, int k0) const { return A + (size_t)row * lda + k0; } };
struct APMix { const u16* QM; const u16* QG;
  DI const u16* ptr(int row, int k0) const { return k0 < 512 ? QM + (size_t)row * 768 + (k0 >> 6) * 96 : QG + (size_t)row * 512 + (k0 - 512); } };

template <bool MIDK, class AP, class EPI>
DI void gemm_tile(const AP& ap, const u16* __restrict__ W, int ldw, int K, int m0, int n0, const EPI& epi, char* smem, float r0, float r1, int tid, bool dry) {
  constexpr int SBUF = 2 * 128 * GP;
  u16* sA = (u16*)smem;
  u16* sB = sA + 128 * GP;
  const int lane = tid & 63, wave = tid >> 6, r = lane & 31, h = lane >> 5, wm = wave >> 1, wn = wave & 1;
  const int lrow = tid >> 3, lkc = (tid & 7) * 8;
  u32x4 ra0[4], rb0[4], ra1[4], rb1[4];
  f32x16 acc[2][2];
#pragma unroll
  for (int a = 0; a < 2; ++a)
#pragma unroll
    for (int b = 0; b < 2; ++b)
#pragma unroll
      for (int i = 0; i < 16; ++i) acc[a][b][i] = 0.f;
  const int nk = K >> 6;
#define GLOADQ(RA, RB, KT, q) do { const int k0_ = (KT) << 6; \
    RA[q] = *(const u32x4*)(ap.ptr(m0 + lrow + 32 * (q), k0_) + lkc); RB[q] = *(const u32x4*)(W + (size_t)(n0 + lrow + 32 * (q)) * ldw + k0_ + lkc); } while (0)
#define GLOAD(RA, RB, KT) do { GLOADQ(RA, RB, KT, 0); GLOADQ(RA, RB, KT, 1); GLOADQ(RA, RB, KT, 2); GLOADQ(RA, RB, KT, 3); } while (0)
#define SSTOREQ(RA, RB, ST, q) do { \
    *(u32x4*)(sA + (ST) * SBUF + (lrow + 32 * (q)) * GP + lkc) = RA[q]; *(u32x4*)(sB + (ST) * SBUF + (lrow + 32 * (q)) * GP + lkc) = RB[q]; } while (0)
#define SSTORE(RA, RB, ST) do { SSTOREQ(RA, RB, ST, 0); SSTOREQ(RA, RB, ST, 1); SSTOREQ(RA, RB, ST, 2); SSTOREQ(RA, RB, ST, 3); } while (0)
#define COMPUTE1(ST, ks) do { bf16x8 wf[2], xf[2]; \
    _Pragma("unroll") for (int a = 0; a < 2; ++a) { wf[a] = *(const bf16x8*)(sB + (ST) * SBUF + (wn * 64 + a * 32 + r) * GP + (ks) * 16 + h * 8); \
                                                   xf[a] = *(const bf16x8*)(sA + (ST) * SBUF + (wm * 64 + a * 32 + r) * GP + (ks) * 16 + h * 8); } \
    _Pragma("unroll") for (int a = 0; a < 2; ++a) _Pragma("unroll") for (int b = 0; b < 2; ++b) acc[a][b] = MFMA(wf[a], xf[b], acc[a][b]); } while (0)
  GLOAD(ra0, rb0, 0);
  GLOAD(ra1, rb1, 1);
  __syncthreads();
  SSTORE(ra0, rb0, 0);
  if (nk > 2) GLOAD(ra0, rb0, 2);
  __syncthreads();
  for (int kt = 0; kt < nk; kt += 2) {
    const bool l3 = kt + 3 < nk, s2 = kt + 2 < nk, l4 = kt + 4 < nk;
    COMPUTE1(0, 0); SSTOREQ(ra1, rb1, 1, 0); if (l3) GLOADQ(ra1, rb1, kt + 3, 0);
    COMPUTE1(0, 1); SSTOREQ(ra1, rb1, 1, 1); if (l3) GLOADQ(ra1, rb1, kt + 3, 1);
    COMPUTE1(0, 2); SSTOREQ(ra1, rb1, 1, 2); if (l3) GLOADQ(ra1, rb1, kt + 3, 2);
    COMPUTE1(0, 3); SSTOREQ(ra1, rb1, 1, 3); if (l3) GLOADQ(ra1, rb1, kt + 3, 3);
    __syncthreads();
    COMPUTE1(1, 0); if (s2) SSTOREQ(ra0, rb0, 0, 0); if (l4) GLOADQ(ra0, rb0, kt + 4, 0);
    COMPUTE1(1, 1); if (s2) SSTOREQ(ra0, rb0, 0, 1); if (l4) GLOADQ(ra0, rb0, kt + 4, 1);
    COMPUTE1(1, 2); if (s2) SSTOREQ(ra0, rb0, 0, 2); if (l4) GLOADQ(ra0, rb0, kt + 4, 2);
    COMPUTE1(1, 3); if (s2) SSTOREQ(ra0, rb0, 0, 3); if (l4) GLOADQ(ra0, rb0, kt + 4, 3);
    if (MIDK && kt == 6) {
#pragma unroll
      for (int a = 0; a < 2; ++a)
#pragma unroll
        for (int i = 0; i < 16; ++i) { acc[a][0][i] *= r0; acc[a][1][i] *= r1; }
    }
    __syncthreads();
  }
#undef GLOADQ
#undef SSTOREQ
#undef COMPUTE1
#undef GLOAD
#undef SSTORE
  if (!dry) epi(acc, n0 + wn * 64, m0 + wm * 64, lane, (u16*)smem + wave * 64 * GP);
}

struct ColId { DI int operator()(int ch) const { return ch * 8; } };
struct ColRope { DI int operator()(int ch) const { return (ch >> 2) * 96 + (ch & 3) * 8; } };

template <class COLF>
DI void stage_store(f32x16 (&acc)[2][2], u16* wl, int lane, u16* dst0, size_t pitch, const COLF& colf) {
  const int r = lane & 31, h = lane >> 5;
#pragma unroll
  for (int rb = 0; rb < 2; ++rb)
#pragma unroll
    for (int lb = 0; lb < 2; ++lb)
#pragma unroll
      for (int g4 = 0; g4 < 4; ++g4)
        store4(wl + (lb * 32 + r) * GP + rb * 32 + 8 * g4 + 4 * h, acc[rb][lb][4 * g4], acc[rb][lb][4 * g4 + 1], acc[rb][lb][4 * g4 + 2], acc[rb][lb][4 * g4 + 3]);
  WAVE_LDS_FENCE();
#pragma unroll
  for (int it = 0; it < 8; ++it) {
    const int row = it * 8 + (lane >> 3), ch = lane & 7;
    const u32x4 v = *(const u32x4*)(wl + row * GP + ch * 8);
    *(u32x4*)(dst0 + (size_t)row * pitch + colf(ch)) = v;
  }
  WAVE_LDS_FENCE();
}

DI void rope16(float (&v)[16], const float2* __restrict__ tabrow, int h) {
#pragma unroll
  for (int i = 0; i < 8; ++i) {
    const int f = (i & 3) + 8 * (i >> 2) + 4 * h;
    const float2 cs = tabrow[f];
    const float x1 = v[i], x2 = v[i + 8];
    v[i] = x1 * cs.x - x2 * cs.y;
    v[i + 8] = x2 * cs.x + x1 * cs.y;
  }
}

struct EpiIn {
  u16 *CQ, *CKV, *QG, *KG, *VGT, *KPE; float *ssq_q, *ssq_kv; const float *gq_g, *gk_g; const float2* tab;
  DI void operator()(f32x16 (&acc)[2][2], int nb, int mb, int lane, u16* wl) const {
    const int r = lane & 31, h = lane >> 5;
    int seq, it; decode_tile(mb >> 7, seq, it);
#pragma unroll
    for (int ti = 0; ti < 2; ++ti) {
      const int g = mb + ti * 32 + r, rr = g & 127;
      if (nb < 640) {
        float ss = 0.f;
#pragma unroll
        for (int fi = 0; fi < 2; ++fi)
#pragma unroll
          for (int i = 0; i < 16; ++i) ss += acc[fi][ti][i] * acc[fi][ti][i];
        ss += xhalf(ss);
        if (h == 0) unsafeAtomicAdd((nb < 384 ? ssq_q : ssq_kv) + g, ss);
      } else if (nb < 1280) {
        const bool isq = nb < 1152;
        const float* gg = isq ? gq_g : gk_g;
        float ss = 0.f;
#pragma unroll
        for (int fi = 0; fi < 2; ++fi)
#pragma unroll
          for (int i = 0; i < 16; ++i) ss += acc[fi][ti][i] * acc[fi][ti][i];
        ss += xhalf(ss);
        const float rstd = rsqrtf(ss * (1.0f / 64.0f) + EPS);
        const float osc = isq ? QSCALE_G : 1.0f;
        int prow = 0, pcol = 0;
        if (it > 0) { const int j = (it - 1) * 128 + rr; prow = j >> 6; pcol = j & 63; }
        u16* dst = isq ? QG + (size_t)g * 512 + (nb - 640) : KG + (size_t)g * 128 + (nb - 1152);
#pragma unroll
        for (int fi = 0; fi < 2; ++fi) {
          const int pos = fi == 0 ? prow : pcol;
          float v[16];
#pragma unroll
          for (int i = 0; i < 16; ++i) v[i] = acc[fi][ti][i] * rstd * gg[fi * 32 + crow(i, h)];
          rope16(v, tab + pos * 16, h);
#pragma unroll
          for (int g4 = 0; g4 < 4; ++g4)
            store4(dst + fi * 32 + 8 * g4 + 4 * h, v[4 * g4] * osc, v[4 * g4 + 1] * osc, v[4 * g4 + 2] * osc, v[4 * g4 + 3] * osc);
        }
      } else if (nb < 1408) {
#pragma unroll
        for (int fi = 0; fi < 2; ++fi)
#pragma unroll
          for (int i = 0; i < 16; ++i) VGT[(size_t)(nb - 1280 + fi * 32 + crow(i, h)) * MPAD + g] = f2bf(acc[fi][ti][i]);
      } else if (nb == 1408) {
        int pos = 128 * it + rr - 112; pos = pos < 0 ? 0 : pos;
        float v[16];
#pragma unroll
        for (int i = 0; i < 16; ++i) v[i] = acc[0][ti][i];
        rope16(v, tab + pos * 16, h);
#pragma unroll
        for (int g4 = 0; g4 < 4; ++g4) store4(KPE + (size_t)g * 32 + 8 * g4 + 4 * h, v[4 * g4], v[4 * g4 + 1], v[4 * g4 + 2], v[4 * g4 + 3]);
      }
    }
    if (nb < 384) stage_store(acc, wl, lane, CQ + (size_t)mb * 384 + nb, 384, ColId());
    else if (nb < 640) stage_store(acc, wl, lane, CKV + (size_t)mb * 256 + (nb - 384), 256, ColId());
  }
};

struct EpiQB {
  u16* QM; const float* ssq_q; const float2* tab;
  DI void operator()(f32x16 (&acc)[2][2], int nb, int mb, int lane, u16* wl) const {
    const int r = lane & 31, h = lane >> 5;
    int seq, it; decode_tile(mb >> 7, seq, it);
#pragma unroll
    for (int ti = 0; ti < 2; ++ti) {
      const int g = mb + ti * 32 + r, rr = g & 127;
      const float sc = rsqrtf(ssq_q[g] * (1.0f / 384.0f) + EPS) * QSCALE_M;
      if (nb < 512) {
#pragma unroll
        for (int fi = 0; fi < 2; ++fi)
#pragma unroll
          for (int i = 0; i < 16; ++i) acc[fi][ti][i] *= sc;
      } else {
        int pos = 128 * it + rr - 112; pos = pos < 0 ? 0 : pos;
#pragma unroll
        for (int fi = 0; fi < 2; ++fi) {
          float v[16];
#pragma unroll
          for (int i = 0; i < 16; ++i) v[i] = acc[fi][ti][i] * sc;
          rope16(v, tab + pos * 16, h);
#pragma unroll
          for (int i = 0; i < 16; ++i) acc[fi][ti][i] = v[i];
        }
      }
    }
    if (nb < 512) stage_store(acc, wl, lane, QM + (size_t)mb * 768 + (nb >> 6) * 96, 768, ColId());
    else stage_store(acc, wl, lane, QM + (size_t)mb * 768 + ((nb - 512) >> 5) * 96 + 64, 768, ColRope());
  }
};

struct EpiKVB {
  u16 *KN, *VMT; const float* ssq_kv;
  DI void operator()(f32x16 (&acc)[2][2], int nb, int mb, int lane, u16* wl) const {
    const int r = lane & 31, h = lane >> 5;
#pragma unroll
    for (int ti = 0; ti < 2; ++ti) {
      const int g = mb + ti * 32 + r;
      const float sc = rsqrtf(ssq_kv[g] * (1.0f / 256.0f) + EPS);
      if (nb < 512) {
#pragma unroll
        for (int fi = 0; fi < 2; ++fi)
#pragma unroll
          for (int i = 0; i < 16; ++i) acc[fi][ti][i] *= sc;
      } else {
#pragma unroll
        for (int fi = 0; fi < 2; ++fi)
#pragma unroll
          for (int i = 0; i < 16; ++i) VMT[(size_t)(nb - 512 + fi * 32 + crow(i, h)) * MPAD + g] = f2bf(acc[fi][ti][i] * sc);
      }
    }
    if (nb < 512) stage_store(acc, wl, lane, KN + (size_t)mb * 512 + nb, 512, ColId());
  }
};

DI void res_bases(const Params& p, int mt, bool from_input, const float*& sb, float*& db, int& minrow) {
  int seq, it; decode_tile(mt, seq, it);
  float* xm = (float*)(p.ws + OFF_XMETA);
  if (it == 0) {
    minrow = 112;
    db = xm + ((ptrdiff_t)seq * 16 - 112) * 1024;
    sb = from_input ? p.meta - 112 * 1024 : db;
  } else {
    minrow = 0;
    const size_t row = seq < 2 ? (size_t)seq * 16384 + (size_t)(it - 1) * 128 : 32768 + (size_t)(seq - 2) * 8192 + (size_t)(it - 1) * 128;
    db = p.out + row * 1024;
    sb = from_input ? (seq < 2 ? p.xp + row * 1024 : p.xs + (row - 32768) * 1024) : db;
  }
}

struct EpiRes {
  const float* sb; float* db; int minrow; float fin0, fin1;
  DI void operator()(f32x16 (&acc)[2][2], int nb, int mb, int lane, u16* wl) const {
    const int r = lane & 31, h = lane >> 5, mbl = mb & 127;
    float* wf = (float*)wl;
#pragma unroll
    for (int fi = 0; fi < 2; ++fi) {
#pragma unroll
      for (int ti = 0; ti < 2; ++ti) {
        const float sc = ti == 0 ? fin0 : fin1;
#pragma unroll
        for (int g4 = 0; g4 < 4; ++g4) {
          float4 o = make_float4(acc[fi][ti][4 * g4] * sc, acc[fi][ti][4 * g4 + 1] * sc, acc[fi][ti][4 * g4 + 2] * sc, acc[fi][ti][4 * g4 + 3] * sc);
          *(float4*)(wf + (ti * 32 + r) * 36 + 8 * g4 + 4 * h) = o;
        }
      }
      WAVE_LDS_FENCE();
#pragma unroll
      for (int it = 0; it < 8; ++it) {
        const int row = it * 8 + (lane >> 3), ch = lane & 7;
        const float4 a = *(const float4*)(wf + row * 36 + ch * 4);
        const int trow = mbl + row;
        if (trow >= minrow) {
          const size_t off = (size_t)trow * 1024 + nb + fi * 32 + ch * 4;
          float4 x = *(const float4*)(sb + off);
          x.x += a.x; x.y += a.y; x.z += a.z; x.w += a.w;
          *(float4*)(db + off) = x;
        }
      }
      WAVE_LDS_FENCE();
    }
  }
};

struct EpiUp {
  u16* U0;
  DI void operator()(f32x16 (&acc)[2][2], int nb, int mb, int lane, u16* wl) const {
#pragma unroll
    for (int ti = 0; ti < 2; ++ti)
#pragma unroll
      for (int fi = 0; fi < 2; ++fi)
#pragma unroll
        for (int i = 0; i < 16; ++i) { const float a = fmaxf(acc[fi][ti][i], 0.f); acc[fi][ti][i] = a * a; }
    stage_store(acc, wl, lane, U0 + (size_t)mb * 4096 + nb, 4096, ColId());
  }
};

constexpr float ATT_THR = 8.0f;

template <int DQK>
struct AttnCtx {
  static constexpr int KP = DQK + 8, NKS = DQK / 16, KCH = DQK / 8, NKL = 64 * KCH / 256, KBUF = 64 * KP, VBUF = 64 * GP;
  const u16 *Kb, *KPEb, *Vt; int kpitch, rowk0, nt, tid, r, h, sr;
  u16 *sK, *sV;
  bf16x8 qf[NKS], kone, qm;
  f32x16 o[2];
  float mref, l;
  u32x4 rk[NKL], rv[2];

  int koff[NKL], voff[2];
  DI void init_offs() {
#pragma unroll
    for (int q = 0; q < NKL; ++q) {
      const int c = tid + 256 * q, row = c / KCH, cc = c % KCH;
      koff[q] = (DQK == 96 && cc >= 8) ? row * 32 + (cc - 8) * 8 : row * kpitch + cc * 8;
    }
#pragma unroll
    for (int q = 0; q < 2; ++q) { const int c = tid + 256 * q, dv = c >> 3, kc = c & 7; voff[q] = dv * MPAD + kc * 8; }
  }
  DI void gload_k(int t) {
    const int row0 = rowk0 + t * 64;
    const u16* kt = Kb + (size_t)row0 * kpitch;
    const u16* pt = KPEb + (size_t)row0 * 32;
#pragma unroll
    for (int q = 0; q < NKL; ++q) {
      const int c = tid + 256 * q, cc = c % KCH;
      rk[q] = *(const u32x4*)(((DQK == 96 && cc >= 8) ? pt : kt) + koff[q]);
    }
  }
  DI void gload_v(int t) {
    const u16* vt = Vt + (rowk0 + t * 64);
#pragma unroll
    for (int q = 0; q < 2; ++q) rv[q] = *(const u32x4*)(vt + voff[q]);
  }
  DI void sstore_k(int buf) {
#pragma unroll
    for (int q = 0; q < NKL; ++q) {
      const int c = tid + 256 * q, row = c / KCH, cc = c % KCH;
      *(u32x4*)(sK + buf * KBUF + row * KP + cc * 8) = rk[q];
    }
  }
  DI void sstore_v(int buf) {
#pragma unroll
    for (int q = 0; q < 2; ++q) {
      const int c = tid + 256 * q, dv = c >> 3, kc = c & 7;
      *(u32x4*)(sV + buf * VBUF + dv * GP + kc * 8) = rv[q];
    }
  }
  DI void qk(int buf, f32x16 (&s)[2]) {
    const u16* kb = sK + buf * KBUF + sr * KP + h * 8;
#pragma unroll
    for (int kb2 = 0; kb2 < 2; ++kb2)
#pragma unroll
      for (int i = 0; i < 16; ++i) s[kb2][i] = 0.f;
#pragma unroll
    for (int ks = 0; ks < NKS; ++ks)
#pragma unroll
      for (int kb2 = 0; kb2 < 2; ++kb2) {
        const bf16x8 a = *(const bf16x8*)(kb + kb2 * 32 * KP + ks * 16);
        s[kb2] = MFMA(a, qf[ks], s[kb2]);
      }
    s[0] = MFMA(kone, qm, s[0]);
    s[1] = MFMA(kone, qm, s[1]);
  }
  template <int PAR>
  DI void step(int t, f32x16 (&cur)[2], f32x16 (&nxt)[2]) {
    if (t + 1 < nt) sstore_k(PAR ^ 1);
    if (t > 0) sstore_v(PAR);
    __syncthreads();
    if (t + 1 < nt) qk(PAR ^ 1, nxt);
    float mx = fmaxf(cur[0][0], cur[1][0]);
#pragma unroll
    for (int i = 1; i < 16; ++i) mx = fmaxf(fmaxf(cur[0][i], cur[1][i]), mx);
    if (__builtin_amdgcn_ballot_w64(mx > ATT_THR) != 0ull) {
      asm volatile("" ::: "memory");
      mx = fmaxf(mx, xhalf(mx));
      const float want = mref + fmaxf(mx, 0.f);
      const float mn = __uint_as_float(pack2(want, 0.f) << 16);
      const float d = mn - mref;
      const float alpha = __builtin_amdgcn_exp2f(-d);
      mref = mn;
      l *= alpha;
#pragma unroll
      for (int a = 0; a < 2; ++a)
#pragma unroll
        for (int i = 0; i < 16; ++i) { o[a][i] *= alpha; cur[a][i] -= d; nxt[a][i] -= d; }
      u32x4 q4 = {h == 0 ? (pack2(-mn, 0.f) & 0xffffu) : 0u, 0u, 0u, 0u};
      qm = __builtin_bit_cast(bf16x8, q4);
    }
    float psum = 0.f;
#pragma unroll
    for (int kb2 = 0; kb2 < 2; ++kb2)
#pragma unroll
      for (int i = 0; i < 16; ++i) { const float pv = __builtin_amdgcn_exp2f(cur[kb2][i]); cur[kb2][i] = pv; psum += pv; }
    l += psum;
    if (t + 2 < nt) gload_k(t + 2);
    if (t + 1 < nt) gload_v(t + 1);
    const u16* vb = sV + PAR * VBUF + r * GP + h * 8;
#pragma unroll
    for (int kb2 = 0; kb2 < 2; ++kb2)
#pragma unroll
      for (int s2 = 0; s2 < 2; ++s2) {
        u32x4 pk = {pack2(cur[kb2][8 * s2], cur[kb2][8 * s2 + 1]), pack2(cur[kb2][8 * s2 + 2], cur[kb2][8 * s2 + 3]),
                    pack2(cur[kb2][8 * s2 + 4], cur[kb2][8 * s2 + 5]), pack2(cur[kb2][8 * s2 + 6], cur[kb2][8 * s2 + 7])};
        const bf16x8 pf = __builtin_bit_cast(bf16x8, pk);
#pragma unroll
        for (int db = 0; db < 2; ++db) {
          const bf16x8 a = *(const bf16x8*)(vb + db * 32 * GP + kb2 * 32 + s2 * 16);
          o[db] = MFMA(a, pf, o[db]);
        }
      }
  }
};

template <int DQK>
DI void attn_item(const u16* __restrict__ Qb, int qpitch, const u16* __restrict__ Kb, int kpitch, const u16* __restrict__ KPEb,
                  const u16* __restrict__ Vt, float* __restrict__ ssq, int rowq0, int rowk0, int nt, char* smem, int tid, bool dry) {
  typedef AttnCtx<DQK> C;
  C c;
  const int lane = tid & 63, wave = tid >> 6, r = lane & 31, h = lane >> 5;
  c.Kb = Kb; c.KPEb = KPEb; c.Vt = Vt; c.kpitch = kpitch; c.rowk0 = rowk0; c.nt = nt; c.tid = tid; c.r = r; c.h = h; c.sr = swap23(r);
  c.sK = (u16*)smem; c.sV = c.sK + 2 * C::KBUF;
  c.init_offs();
  const int myrow = rowq0 + wave * 32 + r;
  {
    const u16* qrow = Qb + (size_t)myrow * qpitch + h * 8;
#pragma unroll
    for (int ks = 0; ks < C::NKS; ++ks) c.qf[ks] = *(const bf16x8*)(qrow + ks * 16);
  }
#pragma unroll
  for (int a = 0; a < 2; ++a)
#pragma unroll
    for (int i = 0; i < 16; ++i) c.o[a][i] = 0.f;
  c.mref = 0.f; c.l = 0.f;
  {
    u32x4 k1 = {h == 0 ? 0x3F80u : 0u, 0u, 0u, 0u}, z4 = {0u, 0u, 0u, 0u};
    c.kone = __builtin_bit_cast(bf16x8, k1); c.qm = __builtin_bit_cast(bf16x8, z4);
  }
  f32x16 sa[2], sb[2];
  c.gload_k(0); c.gload_v(0);
  __syncthreads();
  c.sstore_k(0); c.sstore_v(0);
  if (nt > 1) c.gload_k(1);
  __syncthreads();
  c.qk(0, sa);
#pragma unroll
  for (int i = 0; i < 16; ++i) {
    sa[0][i] = -1e30f;
    if (swap23(crow(i, h)) < 16) sa[1][i] = -1e30f;
  }
  int t = 0;
  for (; t + 1 < nt; t += 2) {
    c.template step<0>(t, sa, sb);
    c.template step<1>(t + 1, sb, sa);
  }
  if (t < nt) c.template step<0>(t, sa, sb);
  if (dry) return;
  float l = c.l;
  l += xhalf(l);
  const float inv = 1.0f / l;
  float ss = 0.f;
  u16* orow = (u16*)Qb + (size_t)myrow * qpitch;
#pragma unroll
  for (int db = 0; db < 2; ++db)
#pragma unroll
    for (int g4 = 0; g4 < 4; ++g4) {
      const float a0 = c.o[db][4 * g4] * inv, a1 = c.o[db][4 * g4 + 1] * inv, a2 = c.o[db][4 * g4 + 2] * inv, a3 = c.o[db][4 * g4 + 3] * inv;
      ss += a0 * a0 + a1 * a1 + a2 * a2 + a3 * a3;
      store4(orow + db * 32 + 8 * g4 + 4 * h, a0, a1, a2, a3);
    }
  ss += xhalf(ss);
  if (h == 0) unsafeAtomicAdd(ssq + myrow, ss);
}

constexpr int N_ITEMS = 8288;
DI void phase_attn(const Params& p, int layer, char* smem, int* s_item, int tid, bool dry) {
  int* cnt = (int*)(p.ws + OFF_CNT) + layer + (dry ? 2 : 0);
  u16* QM = (u16*)(p.ws + OFF_HN);
  const u16* KN = (const u16*)(p.ws + OFF_KN);
  const u16* KPE = (const u16*)(p.ws + OFF_KPE);
  const u16* VMT = (const u16*)(p.ws + OFF_VMT);
  u16* QG = (u16*)(p.ws + OFF_QG);
  const u16* KG = (const u16*)(p.ws + OFF_KG);
  const u16* VGT = (const u16*)(p.ws + OFF_VGT);
  float* ssq = (float*)(p.ws + OFF_SSQ);
  for (;;) {
    if (tid == 0) *s_item = atomicAdd(cnt, 1);
    __syncthreads();
    const int it = *s_item;
    __syncthreads();
    if (it >= N_ITEMS) break;
    int grp, seq, head, qi, nt;
    if (it < 4128) { grp = it / 2064; const int u = it - grp * 2064; const int sh = u / 129; qi = u - sh * 129; seq = sh >> 3; head = sh & 7; nt = 257; }
    else { const int u0 = it - 4128; grp = u0 / 2080; const int u = u0 - grp * 2080; const int sh = u / 65; qi = u - sh * 65; seq = 2 + (sh >> 3); head = sh & 7; nt = 129; }
    const int P = seq_base(seq);
    if (grp == 0)
      attn_item<96>(QM + head * 96, 768, KN + head * 64, 512, KPE, VMT + (size_t)head * 64 * MPAD, ssq + 2 * (size_t)MPAD, P + qi * 128, P + 64, nt, smem, tid, dry);
    else
      attn_item<64>(QG + head * 64, 512, KG + (head >> 2) * 64, 128, nullptr, VGT + (size_t)(head >> 2) * 64 * MPAD, ssq + 3 * (size_t)MPAD, P + qi * 128, P + 64, nt, smem, tid, dry);
  }
}

__global__ void __launch_bounds__(256, 2) mega(Params pin) {
  __shared__ __attribute__((aligned(16))) char smem[2 * 2 * 128 * GP * 2];
  __shared__ int s_item;
  const int G = gridDim.x, b = blockIdx.x;
  const int vb = ((G & 7) == 0) ? ((b & 7) * (G >> 3) + (b >> 3)) : b;
  for (int st = pin.phase_lo; st < pin.phase_hi; ++st) {
    int ph; bool dry = false;
    if (st == 0) ph = 0;
    else if (st == 41) ph = 21;
    else {
      const int u = st - 1, lay = u / 20, v = u - lay * 20, sb = v >> 1;
      dry = (v & 1) == 0;
      if (dry && !((pin.probe >> sb) & 1)) continue;
      ph = 1 + lay * 10 + sb;
    }
    if (st > pin.phase_lo) cg::this_grid().sync();
    Params p = pin;
    asm volatile("" : "+s"(p.xp), "+s"(p.xs), "+s"(p.meta), "+s"(p.attn_g), "+s"(p.w_in), "+s"(p.qa_g), "+s"(p.w_qb), "+s"(p.kva_g), "+s"(p.w_kvb), "+s"(p.gq_g));
    asm volatile("" : "+s"(p.gk_g), "+s"(p.mo_g), "+s"(p.go_g), "+s"(p.w_out), "+s"(p.mlp_g), "+s"(p.w_up), "+s"(p.w_dn), "+s"(p.fin_g), "+s"(p.out), "+s"(p.ws));
    int tid = threadIdx.x;
    asm volatile("" : "+v"(tid));
    const int lane = tid & 63, wave = tid >> 6, r = lane & 31;
    float* ssq = (float*)(p.ws + OFF_SSQ);
    const float2* tab = (const float2*)(p.ws + OFF_TAB);
    if (ph == 0) { phase_prep(p, tid); continue; }
    if (ph == 21) { phase_final(p, tid); continue; }
    const int layer = (ph - 1) / 10, sub = (ph - 1) % 10;
    const u16* Wl = (const u16*)(p.ws + OFF_W) + (size_t)layer * W_LAYER;
    if (sub == 0) {
      phase_norm(p, p.attn_g + layer * 1024, layer == 0, true, tid);
    } else if (sub == 1) {
      EpiIn e; e.CQ = (u16*)(p.ws + OFF_CQ); e.CKV = (u16*)(p.ws + OFF_CKV); e.QG = (u16*)(p.ws + OFF_QG); e.KG = (u16*)(p.ws + OFF_KG);
      e.VGT = (u16*)(p.ws + OFF_VGT); e.KPE = (u16*)(p.ws + OFF_KPE); e.ssq_q = ssq; e.ssq_kv = ssq + MPAD;
      e.gq_g = p.gq_g + layer * 64; e.gk_g = p.gk_g + layer * 64; e.tab = tab;
      APLin ap{(const u16*)(p.ws + OFF_HN), 1024};
      for (int t = vb; t < NTM * 12; t += G) { const int mt = t / 12, nt = t - mt * 12; gemm_tile<false>(ap, Wl + WO_IN, 1024, 1024, mt * 128, nt * 128, e, smem, 1.f, 1.f, tid, dry); }
    } else if (sub == 2) {
      EpiQB e2; e2.QM = (u16*)(p.ws + OFF_HN); e2.ssq_q = ssq; e2.tab = tab;
      EpiKVB e3; e3.KN = (u16*)(p.ws + OFF_KN); e3.VMT = (u16*)(p.ws + OFF_VMT); e3.ssq_kv = ssq + MPAD;
      APLin a2{(const u16*)(p.ws + OFF_CQ), 384};
      APLin a3{(const u16*)(p.ws + OFF_CKV), 256};
      for (int t = vb; t < NTM * 14; t += G) {
        if (t < NTM * 6) { const int mt = t / 6, nt = t - mt * 6; gemm_tile<false>(a2, Wl + WO_QB, 384, 384, mt * 128, nt * 128, e2, smem, 1.f, 1.f, tid, dry); }
        else { const int u = t - NTM * 6; const int mt = u >> 3, nt = u & 7; gemm_tile<false>(a3, Wl + WO_KVB, 256, 256, mt * 128, nt * 128, e3, smem, 1.f, 1.f, tid, dry); }
      }
    } else if (sub == 3) {
      phase_attn(p, layer, smem, &s_item, tid, dry);
    } else if (sub == 4) {
      APMix ap{(const u16*)(p.ws + OFF_HN), (const u16*)(p.ws + OFF_QG)};
      for (int t = vb; t < NTM * 8; t += G) {
        const int mt = t >> 3, nt = t & 7;
        const int g0 = mt * 128 + (wave >> 1) * 64 + r;
        const float ra0 = rsqrtf(ssq[2 * (size_t)MPAD + g0] * (1.0f / 512.0f) + EPS), rg0 = rsqrtf(ssq[3 * (size_t)MPAD + g0] * (1.0f / 512.0f) + EPS);
        const float ra1 = rsqrtf(ssq[2 * (size_t)MPAD + g0 + 32] * (1.0f / 512.0f) + EPS), rg1 = rsqrtf(ssq[3 * (size_t)MPAD + g0 + 32] * (1.0f / 512.0f) + EPS);
        EpiRes e; res_bases(p, mt, layer == 0, e.sb, e.db, e.minrow); e.fin0 = rg0; e.fin1 = rg1;
        gemm_tile<true>(ap, Wl + WO_OUT, 1024, 1024, mt * 128, nt * 128, e, smem, ra0 / rg0, ra1 / rg1, tid, dry);
      }
    } else if (sub == 5) {
      phase_norm(p, p.mlp_g + layer * 1024, false, false, tid);
    } else if (sub == 6 || sub == 8) {
      const int mh = (sub - 6) >> 1;
      EpiUp e; e.U0 = (u16*)(p.ws + OFF_U) - (size_t)mh * 259 * 128 * 4096;
      APLin ap{(const u16*)(p.ws + OFF_HN), 1024};
      for (int t = vb; t < 259 * 32; t += G) {
        int ml, nt;
        if (t < 256 * 32) { const int blk = t >> 6, w = t & 63; ml = (blk >> 2) * 8 + (w >> 3); nt = (blk & 3) * 8 + (w & 7); }
        else { ml = t >> 5; nt = t & 31; }
        gemm_tile<false>(ap, Wl + WO_UP, 1024, 1024, (mh * 259 + ml) * 128, nt * 128, e, smem, 1.f, 1.f, tid, dry);
      }
    } else {
      const int mh = (sub - 7) >> 1;
      APLin ap{(const u16*)(p.ws + OFF_U) - (size_t)mh * 259 * 128 * 4096, 4096};
      for (int t = vb; t < 259 * 8; t += G) {
        const int mt = mh * 259 + (t >> 3), nt = t & 7;
        EpiRes e; res_bases(p, mt, false, e.sb, e.db, e.minrow); e.fin0 = 1.f; e.fin1 = 1.f;
        gemm_tile<false>(ap, Wl + WO_DN, 4096, 4096, mt * 128, nt * 128, e, smem, 1.f, 1.f, tid, dry);
      }
    }
  }
}

extern "C" void kernel_launch(void* const* d_in, const int* in_sizes, int n_in, void* d_out, int out_size, void* d_ws, size_t ws_size,
                              hipStream_t stream) {
  static int grid_blocks = 0;
  if (!grid_blocks) {
    int dev = 0, cus = 0, per_cu = 0;
    hipGetDevice(&dev);
    hipDeviceGetAttribute(&cus, hipDeviceAttributeMultiprocessorCount, dev);
    hipOccupancyMaxActiveBlocksPerMultiprocessor(&per_cu, mega, 256, 0);
    if (per_cu > 2) per_cu = 2;
    if (per_cu < 1) per_cu = 1;
    grid_blocks = cus * per_cu;
  }
  Params p{};
  p.xp = (const float*)d_in[0]; p.xs = (const float*)d_in[1]; p.meta = (const float*)d_in[2];
  p.attn_g = (const float*)d_in[3]; p.w_in = (const float*)d_in[4]; p.qa_g = (const float*)d_in[5]; p.w_qb = (const float*)d_in[6];
  p.kva_g = (const float*)d_in[7]; p.w_kvb = (const float*)d_in[8]; p.gq_g = (const float*)d_in[9]; p.gk_g = (const float*)d_in[10];
  p.mo_g = (const float*)d_in[11]; p.go_g = (const float*)d_in[12]; p.w_out = (const float*)d_in[13]; p.mlp_g = (const float*)d_in[14];
  p.w_up = (const float*)d_in[15]; p.w_dn = (const float*)d_in[16]; p.fin_g = (const float*)d_in[17];
  p.out = (float*)d_out; p.ws = (char*)d_ws;
#if MK_MULTI
  for (int ph = 0; ph < 42; ++ph) {
    p.phase_lo = ph; p.phase_hi = ph + 1; p.probe = PROBE_MASK;
    if (ph > 0 && ph < 41 && ((ph - 1) & 1) == 0 && !((PROBE_MASK >> (((ph - 1) % 20) >> 1)) & 1)) continue;
    hipLaunchKernelGGL(mega, dim3(grid_blocks), dim3(256), 0, stream, p);
  }
#else
  p.phase_lo = 0; p.phase_hi = 42; p.probe = PROBE_MASK;
  void* args[] = {&p};
  hipError_t e = hipLaunchCooperativeKernel((void*)mega, dim3(grid_blocks), dim3(256), args, 0, stream);
  if (e != hipSuccess) fprintf(stderr, "cooperative launch failed: %s (grid %d)\n", hipGetErrorString(e), grid_blocks);
#endif
}
```

```cpp
#include <hip/hip_runtime.h>
#include <hip/hip_cooperative_groups.h>
#include <stdint.h>
#include <cstdio>
namespace cg = cooperative_groups;

#ifndef PROBE_MASK
#define PROBE_MASK 0
#endif
#ifndef MK_MULTI
#define MK_MULTI 0
#endif

typedef unsigned short u16;
typedef short bf16x8 __attribute__((ext_vector_type(8)));
typedef float f32x16 __attribute__((ext_vector_type(16)));
typedef unsigned u32x4 __attribute__((ext_vector_type(4)));
typedef unsigned u32x2 __attribute__((ext_vector_type(2)));
typedef float f32x2v __attribute__((ext_vector_type(2)));
typedef __bf16 bf16x2v __attribute__((ext_vector_type(2)));
#define DI __device__ __forceinline__
#define WAVE_LDS_FENCE() asm volatile("s_waitcnt lgkmcnt(0)" ::: "memory")
#define MFMA(a, b, c) __builtin_amdgcn_mfma_f32_32x32x16_bf16((a), (b), (c), 0, 0, 0)

constexpr int MPAD = 66304;
constexpr int NTM = 518;
constexpr float EPS = 1e-6f;
constexpr float LOG2E = 1.4426950408889634f;
constexpr float QSCALE_M = 0.10206207261596575f * LOG2E;
constexpr float QSCALE_G = 0.125f * LOG2E;

constexpr size_t SZ_WIN = 1536ull * 1024, SZ_WQB = 768ull * 384, SZ_WKVB = 1024ull * 256, SZ_WOUT = 1024ull * 1024,
                 SZ_WUP = 4096ull * 1024, SZ_WDN = 1024ull * 4096;
constexpr size_t WO_IN = 0, WO_QB = WO_IN + SZ_WIN, WO_KVB = WO_QB + SZ_WQB, WO_OUT = WO_KVB + SZ_WKVB, WO_UP = WO_OUT + SZ_WOUT,
                 WO_DN = WO_UP + SZ_WUP, W_LAYER = WO_DN + SZ_WDN;
constexpr size_t OFF_W = 0;
constexpr size_t OFF_TAB = OFF_W + 2 * W_LAYER * 2;
constexpr size_t OFF_XMETA = OFF_TAB + 16400ull * 16 * 8;
constexpr size_t OFF_SSQ = OFF_XMETA + 96ull * 1024 * 4;
constexpr size_t OFF_CNT = OFF_SSQ + 4ull * MPAD * 4;
constexpr size_t OFF_HN = OFF_CNT + 1024;
constexpr size_t OFF_CQ = OFF_HN + (size_t)MPAD * 1024 * 2;
constexpr size_t OFF_CKV = OFF_CQ + (size_t)MPAD * 384 * 2;
constexpr size_t OFF_KN = OFF_CKV + (size_t)MPAD * 256 * 2;
constexpr size_t OFF_KPE = OFF_KN + (size_t)MPAD * 512 * 2;
constexpr size_t OFF_VMT = OFF_KPE + (size_t)MPAD * 32 * 2;
constexpr size_t OFF_QG = OFF_VMT + (size_t)MPAD * 512 * 2;
constexpr size_t OFF_KG = OFF_QG + (size_t)MPAD * 512 * 2;
constexpr size_t OFF_VGT = OFF_KG + (size_t)MPAD * 128 * 2;
constexpr size_t OFF_END = OFF_VGT + (size_t)MPAD * 128 * 2;
constexpr size_t OFF_U = OFF_CQ;
static_assert(OFF_U + (size_t)259 * 128 * 4096 * 2 <= OFF_END, "U fits");
static_assert(OFF_END <= 536870912ull, "workspace");

struct Params {
  const float* xp; const float* xs; const float* meta;
  const float* attn_g; const float* w_in; const float* qa_g; const float* w_qb; const float* kva_g; const float* w_kvb;
  const float* gq_g; const float* gk_g; const float* mo_g; const float* go_g; const float* w_out; const float* mlp_g;
  const float* w_up; const float* w_dn; const float* fin_g;
  float* out; char* ws;
  int phase_lo, phase_hi, probe, pad_;
};

DI unsigned pack2(float a, float b) { f32x2v f = {a, b}; bf16x2v v = __builtin_convertvector(f, bf16x2v); return __builtin_bit_cast(unsigned, v); }
DI u16 f2bf(float a) { return (u16)(pack2(a, 0.f) & 0xffffu); }
DI void store4(u16* dst, float a, float b, float c, float d) { u32x2 v = {pack2(a, b), pack2(c, d)}; *(u32x2*)dst = v; }
DI int crow(int i, int h) { return (i & 3) + 8 * (i >> 2) + 4 * h; }
DI int swap23(int r) { return (r & 0x13) | ((r & 4) << 1) | ((r & 8) >> 1); }
DI float xhalf(float v) { return __shfl_xor(v, 32); }

DI void decode_tile(int T, int& seq, int& i) {
  if (T < 258) { seq = (T >= 129) ? 1 : 0; i = T - seq * 129; }
  else { int u = T - 258; int q = u / 65; seq = 2 + q; i = u - q * 65; }
}
DI int seq_base(int seq) { return seq < 2 ? seq * 16512 : 33024 + (seq - 2) * 8320; }

DI const float* xrow_src(const Params& p, int g, bool from_input) {
  int T = g >> 7, r = g & 127, seq, i; decode_tile(T, seq, i);
  if (i == 0) {
    if (r < 112) return nullptr;
    return from_input ? p.meta + (size_t)(r - 112) * 1024 : (const float*)(p.ws + OFF_XMETA) + (size_t)(seq * 16 + r - 112) * 1024;
  }
  int j = (i - 1) * 128 + r;
  if (seq < 2) { size_t row = (size_t)seq * 16384 + j; return from_input ? p.xp + row * 1024 : p.out + row * 1024; }
  size_t row = (size_t)(seq - 2) * 8192 + j;
  return from_input ? p.xs + row * 1024 : p.out + (32768 + row) * 1024;
}
DI float* xrow_dst(const Params& p, int g) {
  int T = g >> 7, r = g & 127, seq, i; decode_tile(T, seq, i);
  if (i == 0) {
    if (r < 112) return nullptr;
    return (float*)(p.ws + OFF_XMETA) + (size_t)(seq * 16 + r - 112) * 1024;
  }
  int j = (i - 1) * 128 + r;
  if (seq < 2) { size_t row = (size_t)seq * 16384 + j; return p.out + row * 1024; }
  size_t row = (size_t)(seq - 2) * 8192 + j;
  return p.out + (32768 + row) * 1024;
}

DI int mapcol(int kind, int n) {
  if (kind == 1) { if (n < 640) return n; if (n < 1408) return n + 32; if (n < 1440) return 640 + (n - 1408); return -1; }
  if (kind == 2) { if (n < 512) return (n >> 6) * 96 + (n & 63); int m = n - 512; return (m >> 5) * 96 + 64 + (m & 31); }
  if (kind == 3) { if (n < 512) return (n >> 6) * 128 + (n & 63); int m = n - 512; return (m >> 6) * 128 + 64 + (m & 63); }
  return n;
}
DI void prep_weight(const float* __restrict__ src, int Nsrc, u16* __restrict__ dst, int Nout, int K, const float* gA, const float* gB,
                    int ksplit, int kind, int gtid, int gthreads) {
  const int total = Nout * (K >> 3);
  for (int u = gtid; u < total; u += gthreads) {
    const int n = u % Nout, kc = u / Nout;
    const int col = mapcol(kind, n);
    const int k = kc * 8;
    float v[8];
#pragma unroll
    for (int j = 0; j < 8; ++j) {
      float x = 0.f;
      if (col >= 0) {
        x = src[(size_t)(k + j) * Nsrc + col];
        if (gA) x *= (k + j < ksplit) ? gA[k + j] : gB[k + j - ksplit];
      }
      v[j] = x;
    }
    u32x4 o = {pack2(v[0], v[1]), pack2(v[2], v[3]), pack2(v[4], v[5]), pack2(v[6], v[7])};
    *(u32x4*)(dst + (size_t)n * K + k) = o;
  }
}

DI void phase_prep(const Params& p, int tid) {
  const int gtid = blockIdx.x * 256 + tid, gthreads = gridDim.x * 256;
  u16* W = (u16*)(p.ws + OFF_W);
  for (int l = 0; l < 2; ++l) {
    u16* Wl = W + (size_t)l * W_LAYER;
    prep_weight(p.w_in + (size_t)l * 1024 * 1440, 1440, Wl + WO_IN, 1536, 1024, nullptr, nullptr, 0, 1, gtid, gthreads);
    prep_weight(p.w_qb + (size_t)l * 384 * 768, 768, Wl + WO_QB, 768, 384, p.qa_g + l * 384, p.qa_g + l * 384, 384, 2, gtid, gthreads);
    prep_weight(p.w_kvb + (size_t)l * 256 * 1024, 1024, Wl + WO_KVB, 1024, 256, p.kva_g + l * 256, p.kva_g + l * 256, 256, 3, gtid, gthreads);
    prep_weight(p.w_out + (size_t)l * 1024 * 1024, 1024, Wl + WO_OUT, 1024, 1024, p.mo_g + l * 512, p.go_g + l * 512, 512, 0, gtid, gthreads);
    prep_weight(p.w_up + (size_t)l * 1024 * 4096, 4096, Wl + WO_UP, 4096, 1024, nullptr, nullptr, 0, 0, gtid, gthreads);
    prep_weight(p.w_dn + (size_t)l * 4096 * 1024, 1024, Wl + WO_DN, 1024, 4096, nullptr, nullptr, 0, 0, gtid, gthreads);
  }
  float2* tab = (float2*)(p.ws + OFF_TAB);
  for (int u = gtid; u < 16400 * 16; u += gthreads) {
    const int pos = u >> 4, f = u & 15;
    const float invf = 1.0f / powf(10000.0f, (float)(2 * f) / 32.0f);
    const float ang = (float)pos * invf;
    const double rev = (double)ang * 0.15915494309189535;
    const double fr = rev - rint(rev);
    const float x = (float)(2.0 * fr);
    tab[u] = make_float2(cospif(x), sinpif(x));
  }
  float* xm = (float*)(p.ws + OFF_XMETA);
  for (int u = gtid; u < 96 * 1024; u += gthreads) xm[u] = p.meta[u & 16383];
  int* cnt = (int*)(p.ws + OFF_CNT);
  if (gtid < 64) cnt[gtid] = 0;
}

DI void phase_norm(const Params& p, const float* __restrict__ gain, bool from_input, bool zero_ssq, int tid) {
  const int lane = tid & 63;
  const int gw = blockIdx.x * 4 + (tid >> 6), nw = gridDim.x * 4;
  u16* HN = (u16*)(p.ws + OFF_HN);
  float* ssq = (float*)(p.ws + OFF_SSQ);
  for (int g = gw; g < MPAD; g += nw) {
    const float* xr = xrow_src(p, g, from_input);
    u16* hr = HN + (size_t)g * 1024;
    if (!xr) {
      u32x4 z = {0u, 0u, 0u, 0u};
      *(u32x4*)(hr + lane * 16) = z;
      *(u32x4*)(hr + lane * 16 + 8) = z;
    } else {
      float4 v[4];
#pragma unroll
      for (int q = 0; q < 4; ++q) v[q] = ((const float4*)xr)[lane + 64 * q];
      float ss = 0.f;
#pragma unroll
      for (int q = 0; q < 4; ++q) ss += v[q].x * v[q].x + v[q].y * v[q].y + v[q].z * v[q].z + v[q].w * v[q].w;
#pragma unroll
      for (int o = 32; o >= 1; o >>= 1) ss += __shfl_xor(ss, o);
      const float rstd = rsqrtf(ss * (1.0f / 1024.0f) + EPS);
#pragma unroll
      for (int q = 0; q < 4; ++q) {
        const float4 gg = ((const float4*)gain)[lane + 64 * q];
        store4(hr + 4 * (lane + 64 * q), v[q].x * rstd * gg.x, v[q].y * rstd * gg.y, v[q].z * rstd * gg.z, v[q].w * rstd * gg.w);
      }
    }
    if (zero_ssq && lane < 4) ssq[(size_t)lane * MPAD + g] = 0.f;
  }
}

DI void phase_final(const Params& p, int tid) {
  const int lane = tid & 63;
  const int gw = blockIdx.x * 4 + (tid >> 6), nw = gridDim.x * 4;
  for (int g = gw; g < MPAD; g += nw) {
    if (((g >> 7) == 0) || ((g >> 7) == 129) || ((g >> 7) >= 258 && ((g >> 7) - 258) % 65 == 0)) continue;
    float* xr = xrow_dst(p, g);
    float4 v[4];
#pragma unroll
    for (int q = 0; q < 4; ++q) v[q] = ((const float4*)xr)[lane + 64 * q];
    float ss = 0.f;
#pragma unroll
    for (int q = 0; q < 4; ++q) ss += v[q].x * v[q].x + v[q].y * v[q].y + v[q].z * v[q].z + v[q].w * v[q].w;
#pragma unroll
    for (int o = 32; o >= 1; o >>= 1) ss += __shfl_xor(ss, o);
    const float rstd = rsqrtf(ss * (1.0f / 1024.0f) + EPS);
#pragma unroll
    for (int q = 0; q < 4; ++q) {
      const float4 gg = ((const float4*)p.fin_g)[lane + 64 * q];
      float4 o = make_float4(v[q].x * rstd * gg.x, v[q].y * rstd * gg.y, v[q].z * rstd * gg.z, v[q].w * rstd * gg.w);
      ((float4*)xr)[lane + 64 * q] = o;
    }
  }
}

constexpr int GP = 72;
struct APLin { const u16* A; int lda; DI const u16* ptr(int row, int k0) const { return A + (size_t)row * lda + k0; } };
struct APMix { const u16* QM; const u16* QG;
  DI const u16* ptr(int row, int k0) const { return k0 < 512 ? QM + (size_t)row * 768 + (k0 >> 6) * 96 : QG + (size_t)row * 512 + (k0 - 512); } };

template <bool MIDK, class AP, class EPI>
DI void gemm_tile(const AP& ap, const u16* __restrict__ W, int ldw, int K, int m0, int n0, const EPI& epi, char* smem, float r0, float r1, int tid, bool dry) {
  constexpr int SBUF = 2 * 128 * GP;
  u16* sA = (u16*)smem;
  u16* sB = sA + 128 * GP;
  const int lane = tid & 63, wave = tid >> 6, r = lane & 31, h = lane >> 5, wm = wave >> 1, wn = wave & 1;
  const int lrow = tid >> 3, lkc = (tid & 7) * 8;
  u32x4 ra0[4], rb0[4], ra1[4], rb1[4];
  f32x16 acc[2][2];
#pragma unroll
  for (int a = 0; a < 2; ++a)
#pragma unroll
    for (int b = 0; b < 2; ++b)
#pragma unroll
      for (int i = 0; i < 16; ++i) acc[a][b][i] = 0.f;
  const int nk = K >> 6;
#define GLOADQ(RA, RB, KT, q) do { const int k0_ = (KT) << 6; \
    RA[q] = *(const u32x4*)(ap.ptr(m0 + lrow + 32 * (q), k0_) + lkc); RB[q] = *(const u32x4*)(W + (size_t)(n0 + lrow + 32 * (q)) * ldw + k0_ + lkc); } while (0)
#define GLOAD(RA, RB, KT) do { GLOADQ(RA, RB, KT, 0); GLOADQ(RA, RB, KT, 1); GLOADQ(RA, RB, KT, 2); GLOADQ(RA, RB, KT, 3); } while (0)
#define SSTOREQ(RA, RB, ST, q) do { \
    *(u32x4*)(sA + (ST) * SBUF + (lrow + 32 * (q)) * GP + lkc) = RA[q]; *(u32x4*)(sB + (ST) * SBUF + (lrow + 32 * (q)) * GP + lkc) = RB[q]; } while (0)
#define SSTORE(RA, RB, ST) do { SSTOREQ(RA, RB, ST, 0); SSTOREQ(RA, RB, ST, 1); SSTOREQ(RA, RB, ST, 2); SSTOREQ(RA, RB, ST, 3); } while (0)
#define FLOAD(F, ST, ks) do { _Pragma("unroll") for (int a = 0; a < 2; ++a) { \
    F[a] = *(const bf16x8*)(sB + (ST) * SBUF + (wn * 64 + a * 32 + r) * GP + (ks) * 16 + h * 8); \
    F[2 + a] = *(const bf16x8*)(sA + (ST) * SBUF + (wm * 64 + a * 32 + r) * GP + (ks) * 16 + h * 8); } } while (0)
#define FMMA(F) do { _Pragma("unroll") for (int a = 0; a < 2; ++a) _Pragma("unroll") for (int b = 0; b < 2; ++b) acc[a][b] = MFMA(F[a], F[2 + b], acc[a][b]); } while (0)
  bf16x8 f0[4], f1[4];
  GLOAD(ra0, rb0, 0);
  GLOAD(ra1, rb1, 1);
  __syncthreads();
  SSTORE(ra0, rb0, 0);
  if (nk > 2) GLOAD(ra0, rb0, 2);
  __syncthreads();
  for (int kt = 0; kt < nk; kt += 2) {
    const bool l3 = kt + 3 < nk, s2 = kt + 2 < nk, l4 = kt + 4 < nk;
    FLOAD(f0, 0, 0); FLOAD(f1, 0, 1);
    FMMA(f0); SSTOREQ(ra1, rb1, 1, 0); if (l3) GLOADQ(ra1, rb1, kt + 3, 0);
    FLOAD(f0, 0, 2);
    FMMA(f1); SSTOREQ(ra1, rb1, 1, 1); if (l3) GLOADQ(ra1, rb1, kt + 3, 1);
    FLOAD(f1, 0, 3);
    FMMA(f0); SSTOREQ(ra1, rb1, 1, 2); if (l3) GLOADQ(ra1, rb1, kt + 3, 2);
    FMMA(f1); SSTOREQ(ra1, rb1, 1, 3); if (l3) GLOADQ(ra1, rb1, kt + 3, 3);
    __syncthreads();
    FLOAD(f0, 1, 0); FLOAD(f1, 1, 1);
    FMMA(f0); if (s2) SSTOREQ(ra0, rb0, 0, 0); if (l4) GLOADQ(ra0, rb0, kt + 4, 0);
    FLOAD(f0, 1, 2);
    FMMA(f1); if (s2) SSTOREQ(ra0, rb0, 0, 1); if (l4) GLOADQ(ra0, rb0, kt + 4, 1);
    FLOAD(f1, 1, 3);
    FMMA(f0); if (s2) SSTOREQ(ra0, rb0, 0, 2); if (l4) GLOADQ(ra0, rb0, kt + 4, 2);
    FMMA(f1); if (s2) SSTOREQ(ra0, rb0, 0, 3); if (l4) GLOADQ(ra0, rb0, kt + 4, 3);
    if (MIDK && kt == 6) {
#pragma unroll
      for (int a = 0; a < 2; ++a)
#pragma unroll
        for (int i = 0; i < 16; ++i) { acc[a][0][i] *= r0; acc[a][1][i] *= r1; }
    }
    __syncthreads();
  }
#undef GLOADQ
#undef SSTOREQ
#undef FLOAD
#undef FMMA
#undef GLOAD
#undef SSTORE
  if (!dry) epi(acc, n0 + wn * 64, m0 + wm * 64, lane, (u16*)smem + wave * 64 * GP);
}

struct ColId { DI int operator()(int ch) const { return ch * 8; } };
struct ColRope { DI int operator()(int ch) const { return (ch >> 2) * 96 + (ch & 3) * 8; } };

template <class COLF>
DI void stage_store(f32x16 (&acc)[2][2], u16* wl, int lane, u16* dst0, size_t pitch, const COLF& colf) {
  const int r = lane & 31, h = lane >> 5;
#pragma unroll
  for (int rb = 0; rb < 2; ++rb)
#pragma unroll
    for (int lb = 0; lb < 2; ++lb)
#pragma unroll
      for (int g4 = 0; g4 < 4; ++g4)
        store4(wl + (lb * 32 + r) * GP + rb * 32 + 8 * g4 + 4 * h, acc[rb][lb][4 * g4], acc[rb][lb][4 * g4 + 1], acc[rb][lb][4 * g4 + 2], acc[rb][lb][4 * g4 + 3]);
  WAVE_LDS_FENCE();
#pragma unroll
  for (int it = 0; it < 8; ++it) {
    const int row = it * 8 + (lane >> 3), ch = lane & 7;
    const u32x4 v = *(const u32x4*)(wl + row * GP + ch * 8);
    *(u32x4*)(dst0 + (size_t)row * pitch + colf(ch)) = v;
  }
  WAVE_LDS_FENCE();
}

DI void rope16(float (&v)[16], const float2* __restrict__ tabrow, int h) {
#pragma unroll
  for (int i = 0; i < 8; ++i) {
    const int f = (i & 3) + 8 * (i >> 2) + 4 * h;
    const float2 cs = tabrow[f];
    const float x1 = v[i], x2 = v[i + 8];
    v[i] = x1 * cs.x - x2 * cs.y;
    v[i + 8] = x2 * cs.x + x1 * cs.y;
  }
}

struct EpiIn {
  u16 *CQ, *CKV, *QG, *KG, *VGT, *KPE; float *ssq_q, *ssq_kv; const float *gq_g, *gk_g; const float2* tab;
  DI void operator()(f32x16 (&acc)[2][2], int nb, int mb, int lane, u16* wl) const {
    const int r = lane & 31, h = lane >> 5;
    int seq, it; decode_tile(mb >> 7, seq, it);
#pragma unroll
    for (int ti = 0; ti < 2; ++ti) {
      const int g = mb + ti * 32 + r, rr = g & 127;
      if (nb < 640) {
        float ss = 0.f;
#pragma unroll
        for (int fi = 0; fi < 2; ++fi)
#pragma unroll
          for (int i = 0; i < 16; ++i) ss += acc[fi][ti][i] * acc[fi][ti][i];
        ss += xhalf(ss);
        if (h == 0) unsafeAtomicAdd((nb < 384 ? ssq_q : ssq_kv) + g, ss);
      } else if (nb < 1280) {
        const bool isq = nb < 1152;
        const float* gg = isq ? gq_g : gk_g;
        float ss = 0.f;
#pragma unroll
        for (int fi = 0; fi < 2; ++fi)
#pragma unroll
          for (int i = 0; i < 16; ++i) ss += acc[fi][ti][i] * acc[fi][ti][i];
        ss += xhalf(ss);
        const float rstd = rsqrtf(ss * (1.0f / 64.0f) + EPS);
        const float osc = isq ? QSCALE_G : 1.0f;
        int prow = 0, pcol = 0;
        if (it > 0) { const int j = (it - 1) * 128 + rr; prow = j >> 6; pcol = j & 63; }
        u16* dst = isq ? QG + (size_t)g * 512 + (nb - 640) : KG + (size_t)g * 128 + (nb - 1152);
#pragma unroll
        for (int fi = 0; fi < 2; ++fi) {
          const int pos = fi == 0 ? prow : pcol;
          float v[16];
#pragma unroll
          for (int i = 0; i < 16; ++i) v[i] = acc[fi][ti][i] * rstd * gg[fi * 32 + crow(i, h)];
          rope16(v, tab + pos * 16, h);
#pragma unroll
          for (int g4 = 0; g4 < 4; ++g4)
            store4(dst + fi * 32 + 8 * g4 + 4 * h, v[4 * g4] * osc, v[4 * g4 + 1] * osc, v[4 * g4 + 2] * osc, v[4 * g4 + 3] * osc);
        }
      } else if (nb < 1408) {
#pragma unroll
        for (int fi = 0; fi < 2; ++fi)
#pragma unroll
          for (int i = 0; i < 16; ++i) VGT[(size_t)(nb - 1280 + fi * 32 + crow(i, h)) * MPAD + g] = f2bf(acc[fi][ti][i]);
      } else if (nb == 1408) {
        int pos = 128 * it + rr - 112; pos = pos < 0 ? 0 : pos;
        float v[16];
#pragma unroll
        for (int i = 0; i < 16; ++i) v[i] = acc[0][ti][i];
        rope16(v, tab + pos * 16, h);
#pragma unroll
        for (int g4 = 0; g4 < 4; ++g4) store4(KPE + (size_t)g * 32 + 8 * g4 + 4 * h, v[4 * g4], v[4 * g4 + 1], v[4 * g4 + 2], v[4 * g4 + 3]);
      }
    }
    if (nb < 384) stage_store(acc, wl, lane, CQ + (size_t)mb * 384 + nb, 384, ColId());
    else if (nb < 640) stage_store(acc, wl, lane, CKV + (size_t)mb * 256 + (nb - 384), 256, ColId());
  }
};

struct EpiQB {
  u16* QM; const float* ssq_q; const float2* tab;
  DI void operator()(f32x16 (&acc)[2][2], int nb, int mb, int lane, u16* wl) const {
    const int r = lane & 31, h = lane >> 5;
    int seq, it; decode_tile(mb >> 7, seq, it);
#pragma unroll
    for (int ti = 0; ti < 2; ++ti) {
      const int g = mb + ti * 32 + r, rr = g & 127;
      const float sc = rsqrtf(ssq_q[g] * (1.0f / 384.0f) + EPS) * QSCALE_M;
      if (nb < 512) {
#pragma unroll
        for (int fi = 0; fi < 2; ++fi)
#pragma unroll
          for (int i = 0; i < 16; ++i) acc[fi][ti][i] *= sc;
      } else {
        int pos = 128 * it + rr - 112; pos = pos < 0 ? 0 : pos;
#pragma unroll
        for (int fi = 0; fi < 2; ++fi) {
          float v[16];
#pragma unroll
          for (int i = 0; i < 16; ++i) v[i] = acc[fi][ti][i] * sc;
          rope16(v, tab + pos * 16, h);
#pragma unroll
          for (int i = 0; i < 16; ++i) acc[fi][ti][i] = v[i];
        }
      }
    }
    if (nb < 512) stage_store(acc, wl, lane, QM + (size_t)mb * 768 + (nb >> 6) * 96, 768, ColId());
    else stage_store(acc, wl, lane, QM + (size_t)mb * 768 + ((nb - 512) >> 5) * 96 + 64, 768, ColRope());
  }
};

struct EpiKVB {
  u16 *KN, *VMT; const float* ssq_kv;
  DI void operator()(f32x16 (&acc)[2][2], int nb, int mb, int lane, u16* wl) const {
    const int r = lane & 31, h = lane >> 5;
#pragma unroll
    for (int ti = 0; ti < 2; ++ti) {
      const int g = mb + ti * 32 + r;
      const float sc = rsqrtf(ssq_kv[g] * (1.0f / 256.0f) + EPS);
      if (nb < 512) {
#pragma unroll
        for (int fi = 0; fi < 2; ++fi)
#pragma unroll
          for (int i = 0; i < 16; ++i) acc[fi][ti][i] *= sc;
      } else {
#pragma unroll
        for (int fi = 0; fi < 2; ++fi)
#pragma unroll
          for (int i = 0; i < 16; ++i) VMT[(size_t)(nb - 512 + fi * 32 + crow(i, h)) * MPAD + g] = f2bf(acc[fi][ti][i] * sc);
      }
    }
    if (nb < 512) stage_store(acc, wl, lane, KN + (size_t)mb * 512 + nb, 512, ColId());
  }
};

DI void res_bases(const Params& p, int mt, bool from_input, const float*& sb, float*& db, int& minrow) {
  int seq, it; decode_tile(mt, seq, it);
  float* xm = (float*)(p.ws + OFF_XMETA);
  if (it == 0) {
    minrow = 112;
    db = xm + ((ptrdiff_t)seq * 16 - 112) * 1024;
    sb = from_input ? p.meta - 112 * 1024 : db;
  } else {
    minrow = 0;
    const size_t row = seq < 2 ? (size_t)seq * 16384 + (size_t)(it - 1) * 128 : 32768 + (size_t)(seq - 2) * 8192 + (size_t)(it - 1) * 128;
    db = p.out + row * 1024;
    sb = from_input ? (seq < 2 ? p.xp + row * 1024 : p.xs + (row - 32768) * 1024) : db;
  }
}

struct EpiRes {
  const float* sb; float* db; int minrow; float fin0, fin1;
  DI void operator()(f32x16 (&acc)[2][2], int nb, int mb, int lane, u16* wl) const {
    const int r = lane & 31, h = lane >> 5, mbl = mb & 127;
    float* wf = (float*)wl;
#pragma unroll
    for (int fi = 0; fi < 2; ++fi) {
#pragma unroll
      for (int ti = 0; ti < 2; ++ti) {
        const float sc = ti == 0 ? fin0 : fin1;
#pragma unroll
        for (int g4 = 0; g4 < 4; ++g4) {
          float4 o = make_float4(acc[fi][ti][4 * g4] * sc, acc[fi][ti][4 * g4 + 1] * sc, acc[fi][ti][4 * g4 + 2] * sc, acc[fi][ti][4 * g4 + 3] * sc);
          *(float4*)(wf + (ti * 32 + r) * 36 + 8 * g4 + 4 * h) = o;
        }
      }
      WAVE_LDS_FENCE();
#pragma unroll
      for (int it = 0; it < 8; ++it) {
        const int row = it * 8 + (lane >> 3), ch = lane & 7;
        const float4 a = *(const float4*)(wf + row * 36 + ch * 4);
        const int trow = mbl + row;
        if (trow >= minrow) {
          const size_t off = (size_t)trow * 1024 + nb + fi * 32 + ch * 4;
          float4 x = *(const float4*)(sb + off);
          x.x += a.x; x.y += a.y; x.z += a.z; x.w += a.w;
          *(float4*)(db + off) = x;
        }
      }
      WAVE_LDS_FENCE();
    }
  }
};

struct EpiUp {
  u16* U0;
  DI void operator()(f32x16 (&acc)[2][2], int nb, int mb, int lane, u16* wl) const {
#pragma unroll
    for (int ti = 0; ti < 2; ++ti)
#pragma unroll
      for (int fi = 0; fi < 2; ++fi)
#pragma unroll
        for (int i = 0; i < 16; ++i) { const float a = fmaxf(acc[fi][ti][i], 0.f); acc[fi][ti][i] = a * a; }
    stage_store(acc, wl, lane, U0 + (size_t)mb * 4096 + nb, 4096, ColId());
  }
};

constexpr float ATT_THR = 8.0f;

template <int DQK>
struct AttnCtx {
  static constexpr int KP = DQK + 8, NKS = DQK / 16, KCH = DQK / 8, NKL = 64 * KCH / 256, KBUF = 64 * KP, VBUF = 64 * GP;
  const u16 *Kb, *KPEb, *Vt; int kpitch, rowk0, nt, tid, r, h, sr;
  u16 *sK, *sV;
  bf16x8 qf[NKS], kone, qm;
  f32x16 o[2];
  float mref, l;
  u32x4 rk[NKL], rv[2];

  int koff[NKL], voff[2];
  DI void init_offs() {
#pragma unroll
    for (int q = 0; q < NKL; ++q) {
      const int c = tid + 256 * q, row = c / KCH, cc = c % KCH;
      koff[q] = (DQK == 96 && cc >= 8) ? row * 32 + (cc - 8) * 8 : row * kpitch + cc * 8;
    }
#pragma unroll
    for (int q = 0; q < 2; ++q) { const int c = tid + 256 * q, dv = c >> 3, kc = c & 7; voff[q] = dv * MPAD + kc * 8; }
  }
  DI void gload_k(int t) {
    const int row0 = rowk0 + t * 64;
    const u16* kt = Kb + (size_t)row0 * kpitch;
    const u16* pt = KPEb + (size_t)row0 * 32;
#pragma unroll
    for (int q = 0; q < NKL; ++q) {
      const int c = tid + 256 * q, cc = c % KCH;
      rk[q] = *(const u32x4*)(((DQK == 96 && cc >= 8) ? pt : kt) + koff[q]);
    }
  }
  DI void gload_v(int t) {
    const u16* vt = Vt + (rowk0 + t * 64);
#pragma unroll
    for (int q = 0; q < 2; ++q) rv[q] = *(const u32x4*)(vt + voff[q]);
  }
  DI void sstore_k(int buf) {
#pragma unroll
    for (int q = 0; q < NKL; ++q) {
      const int c = tid + 256 * q, row = c / KCH, cc = c % KCH;
      *(u32x4*)(sK + buf * KBUF + row * KP + cc * 8) = rk[q];
    }
  }
  DI void sstore_v(int buf) {
#pragma unroll
    for (int q = 0; q < 2; ++q) {
      const int c = tid + 256 * q, dv = c >> 3, kc = c & 7;
      *(u32x4*)(sV + buf * VBUF + dv * GP + kc * 8) = rv[q];
    }
  }
  DI void qk(int buf, f32x16 (&s)[2]) {
    const u16* kb = sK + buf * KBUF + sr * KP + h * 8;
#pragma unroll
    for (int kb2 = 0; kb2 < 2; ++kb2)
#pragma unroll
      for (int i = 0; i < 16; ++i) s[kb2][i] = 0.f;
#pragma unroll
    for (int ks = 0; ks < NKS; ++ks)
#pragma unroll
      for (int kb2 = 0; kb2 < 2; ++kb2) {
        const bf16x8 a = *(const bf16x8*)(kb + kb2 * 32 * KP + ks * 16);
        s[kb2] = MFMA(a, qf[ks], s[kb2]);
      }
    s[0] = MFMA(kone, qm, s[0]);
    s[1] = MFMA(kone, qm, s[1]);
  }
  template <int PAR>
  DI void step(int t, f32x16 (&cur)[2], f32x16 (&nxt)[2]) {
    if (t + 1 < nt) sstore_k(PAR ^ 1);
    if (t > 0) sstore_v(PAR);
    __syncthreads();
    if (t + 1 < nt) qk(PAR ^ 1, nxt);
    float mx = fmaxf(cur[0][0], cur[1][0]);
#pragma unroll
    for (int i = 1; i < 16; ++i) mx = fmaxf(fmaxf(cur[0][i], cur[1][i]), mx);
    if (__builtin_amdgcn_ballot_w64(mx > ATT_THR) != 0ull) {
      asm volatile("" ::: "memory");
      mx = fmaxf(mx, xhalf(mx));
      const float want = mref + fmaxf(mx, 0.f);
      const float mn = __uint_as_float(pack2(want, 0.f) << 16);
      const float d = mn - mref;
      const float alpha = __builtin_amdgcn_exp2f(-d);
      mref = mn;
      l *= alpha;
#pragma unroll
      for (int a = 0; a < 2; ++a)
#pragma unroll
        for (int i = 0; i < 16; ++i) { o[a][i] *= alpha; cur[a][i] -= d; nxt[a][i] -= d; }
      u32x4 q4 = {h == 0 ? (pack2(-mn, 0.f) & 0xffffu) : 0u, 0u, 0u, 0u};
      qm = __builtin_bit_cast(bf16x8, q4);
    }
    float psum = 0.f;
#pragma unroll
    for (int kb2 = 0; kb2 < 2; ++kb2)
#pragma unroll
      for (int i = 0; i < 16; ++i) { const float pv = __builtin_amdgcn_exp2f(cur[kb2][i]); cur[kb2][i] = pv; psum += pv; }
    l += psum;
    if (t + 2 < nt) gload_k(t + 2);
    if (t + 1 < nt) gload_v(t + 1);
    const u16* vb = sV + PAR * VBUF + r * GP + h * 8;
#pragma unroll
    for (int kb2 = 0; kb2 < 2; ++kb2)
#pragma unroll
      for (int s2 = 0; s2 < 2; ++s2) {
        u32x4 pk = {pack2(cur[kb2][8 * s2], cur[kb2][8 * s2 + 1]), pack2(cur[kb2][8 * s2 + 2], cur[kb2][8 * s2 + 3]),
                    pack2(cur[kb2][8 * s2 + 4], cur[kb2][8 * s2 + 5]), pack2(cur[kb2][8 * s2 + 6], cur[kb2][8 * s2 + 7])};
        const bf16x8 pf = __builtin_bit_cast(bf16x8, pk);
#pragma unroll
        for (int db = 0; db < 2; ++db) {
          const bf16x8 a = *(const bf16x8*)(vb + db * 32 * GP + kb2 * 32 + s2 * 16);
          o[db] = MFMA(a, pf, o[db]);
        }
      }
  }
};

template <int DQK>
DI void attn_item(const u16* __restrict__ Qb, int qpitch, const u16* __restrict__ Kb, int kpitch, const u16* __restrict__ KPEb,
                  const u16* __restrict__ Vt, float* __restrict__ ssq, int rowq0, int rowk0, int nt, char* smem, int tid, bool dry) {
  typedef AttnCtx<DQK> C;
  C c;
  const int lane = tid & 63, wave = tid >> 6, r = lane & 31, h = lane >> 5;
  c.Kb = Kb; c.KPEb = KPEb; c.Vt = Vt; c.kpitch = kpitch; c.rowk0 = rowk0; c.nt = nt; c.tid = tid; c.r = r; c.h = h; c.sr = swap23(r);
  c.sK = (u16*)smem; c.sV = c.sK + 2 * C::KBUF;
  c.init_offs();
  const int myrow = rowq0 + wave * 32 + r;
  {
    const u16* qrow = Qb + (size_t)myrow * qpitch + h * 8;
#pragma unroll
    for (int ks = 0; ks < C::NKS; ++ks) c.qf[ks] = *(const bf16x8*)(qrow + ks * 16);
  }
#pragma unroll
  for (int a = 0; a < 2; ++a)
#pragma unroll
    for (int i = 0; i < 16; ++i) c.o[a][i] = 0.f;
  c.mref = 0.f; c.l = 0.f;
  {
    u32x4 k1 = {h == 0 ? 0x3F80u : 0u, 0u, 0u, 0u}, z4 = {0u, 0u, 0u, 0u};
    c.kone = __builtin_bit_cast(bf16x8, k1); c.qm = __builtin_bit_cast(bf16x8, z4);
  }
  f32x16 sa[2], sb[2];
  c.gload_k(0); c.gload_v(0);
  __syncthreads();
  c.sstore_k(0); c.sstore_v(0);
  if (nt > 1) c.gload_k(1);
  __syncthreads();
  c.qk(0, sa);
#pragma unroll
  for (int i = 0; i < 16; ++i) {
    sa[0][i] = -1e30f;
    if (swap23(crow(i, h)) < 16) sa[1][i] = -1e30f;
  }
  int t = 0;
  for (; t + 1 < nt; t += 2) {
    c.template step<0>(t, sa, sb);
    c.template step<1>(t + 1, sb, sa);
  }
  if (t < nt) c.template step<0>(t, sa, sb);
  if (dry) return;
  float l = c.l;
  l += xhalf(l);
  const float inv = 1.0f / l;
  float ss = 0.f;
  u16* orow = (u16*)Qb + (size_t)myrow * qpitch;
#pragma unroll
  for (int db = 0; db < 2; ++db)
#pragma unroll
    for (int g4 = 0; g4 < 4; ++g4) {
      const float a0 = c.o[db][4 * g4] * inv, a1 = c.o[db][4 * g4 + 1] * inv, a2 = c.o[db][4 * g4 + 2] * inv, a3 = c.o[db][4 * g4 + 3] * inv;
      ss += a0 * a0 + a1 * a1 + a2 * a2 + a3 * a3;
      store4(orow + db * 32 + 8 * g4 + 4 * h, a0, a1, a2, a3);
    }
  ss += xhalf(ss);
  if (h == 0) unsafeAtomicAdd(ssq + myrow, ss);
}

constexpr int N_ITEMS = 8288;
DI void phase_attn(const Params& p, int layer, char* smem, int* s_item, int tid, bool dry) {
  int* cnt = (int*)(p.ws + OFF_CNT) + layer + (dry ? 2 : 0);
  u16* QM = (u16*)(p.ws + OFF_HN);
  const u16* KN = (const u16*)(p.ws + OFF_KN);
  const u16* KPE = (const u16*)(p.ws + OFF_KPE);
  const u16* VMT = (const u16*)(p.ws + OFF_VMT);
  u16* QG = (u16*)(p.ws + OFF_QG);
  const u16* KG = (const u16*)(p.ws + OFF_KG);
  const u16* VGT = (const u16*)(p.ws + OFF_VGT);
  float* ssq = (float*)(p.ws + OFF_SSQ);
  for (;;) {
    if (tid == 0) *s_item = atomicAdd(cnt, 1);
    __syncthreads();
    const int it = *s_item;
    __syncthreads();
    if (it >= N_ITEMS) break;
    int grp, seq, head, qi, nt;
    if (it < 4128) { grp = it / 2064; const int u = it - grp * 2064; const int sh = u / 129; qi = u - sh * 129; seq = sh >> 3; head = sh & 7; nt = 257; }
    else { const int u0 = it - 4128; grp = u0 / 2080; const int u = u0 - grp * 2080; const int sh = u / 65; qi = u - sh * 65; seq = 2 + (sh >> 3); head = sh & 7; nt = 129; }
    const int P = seq_base(seq);
    if (grp == 0)
      attn_item<96>(QM + head * 96, 768, KN + head * 64, 512, KPE, VMT + (size_t)head * 64 * MPAD, ssq + 2 * (size_t)MPAD, P + qi * 128, P + 64, nt, smem, tid, dry);
    else
      attn_item<64>(QG + head * 64, 512, KG + (head >> 2) * 64, 128, nullptr, VGT + (size_t)(head >> 2) * 64 * MPAD, ssq + 3 * (size_t)MPAD, P + qi * 128, P + 64, nt, smem, tid, dry);
  }
}

__global__ void __launch_bounds__(256, 2) mega(Params pin) {
  __shared__ __attribute__((aligned(16))) char smem[2 * 2 * 128 * GP * 2];
  __shared__ int s_item;
  const int G = gridDim.x, b = blockIdx.x;
  const int vb = ((G & 7) == 0) ? ((b & 7) * (G >> 3) + (b >> 3)) : b;
  for (int st = pin.phase_lo; st < pin.phase_hi; ++st) {
    int ph; bool dry = false;
    if (st == 0) ph = 0;
    else if (st == 41) ph = 21;
    else {
      const int u = st - 1, lay = u / 20, v = u - lay * 20, sb = v >> 1;
      dry = (v & 1) == 0;
      if (dry && !((pin.probe >> sb) & 1)) continue;
      ph = 1 + lay * 10 + sb;
    }
    if (st > pin.phase_lo) cg::this_grid().sync();
    Params p = pin;
    asm volatile("" : "+s"(p.xp), "+s"(p.xs), "+s"(p.meta), "+s"(p.attn_g), "+s"(p.w_in), "+s"(p.qa_g), "+s"(p.w_qb), "+s"(p.kva_g), "+s"(p.w_kvb), "+s"(p.gq_g));
    asm volatile("" : "+s"(p.gk_g), "+s"(p.mo_g), "+s"(p.go_g), "+s"(p.w_out), "+s"(p.mlp_g), "+s"(p.w_up), "+s"(p.w_dn), "+s"(p.fin_g), "+s"(p.out), "+s"(p.ws));
    int tid = threadIdx.x;
    asm volatile("" : "+v"(tid));
    const int lane = tid & 63, wave = tid >> 6, r = lane & 31;
    float* ssq = (float*)(p.ws + OFF_SSQ);
    const float2* tab = (const float2*)(p.ws + OFF_TAB);
    if (ph == 0) { phase_prep(p, tid); continue; }
    if (ph == 21) { phase_final(p, tid); continue; }
    const int layer = (ph - 1) / 10, sub = (ph - 1) % 10;
    const u16* Wl = (const u16*)(p.ws + OFF_W) + (size_t)layer * W_LAYER;
    if (sub == 0) {
      phase_norm(p, p.attn_g + layer * 1024, layer == 0, true, tid);
    } else if (sub == 1) {
      EpiIn e; e.CQ = (u16*)(p.ws + OFF_CQ); e.CKV = (u16*)(p.ws + OFF_CKV); e.QG = (u16*)(p.ws + OFF_QG); e.KG = (u16*)(p.ws + OFF_KG);
      e.VGT = (u16*)(p.ws + OFF_VGT); e.KPE = (u16*)(p.ws + OFF_KPE); e.ssq_q = ssq; e.ssq_kv = ssq + MPAD;
      e.gq_g = p.gq_g + layer * 64; e.gk_g = p.gk_g + layer * 64; e.tab = tab;
      APLin ap{(const u16*)(p.ws + OFF_HN), 1024};
      for (int t = vb; t < NTM * 12; t += G) { const int mt = t / 12, nt = t - mt * 12; gemm_tile<false>(ap, Wl + WO_IN, 1024, 1024, mt * 128, nt * 128, e, smem, 1.f, 1.f, tid, dry); }
    } else if (sub == 2) {
      EpiQB e2; e2.QM = (u16*)(p.ws + OFF_HN); e2.ssq_q = ssq; e2.tab = tab;
      EpiKVB e3; e3.KN = (u16*)(p.ws + OFF_KN); e3.VMT = (u16*)(p.ws + OFF_VMT); e3.ssq_kv = ssq + MPAD;
      APLin a2{(const u16*)(p.ws + OFF_CQ), 384};
      APLin a3{(const u16*)(p.ws + OFF_CKV), 256};
      for (int t = vb; t < NTM * 14; t += G) {
        if (t < NTM * 6) { const int mt = t / 6, nt = t - mt * 6; gemm_tile<false>(a2, Wl + WO_QB, 384, 384, mt * 128, nt * 128, e2, smem, 1.f, 1.f, tid, dry); }
        else { const int u = t - NTM * 6; const int mt = u >> 3, nt = u & 7; gemm_tile<false>(a3, Wl + WO_KVB, 256, 256, mt * 128, nt * 128, e3, smem, 1.f, 1.f, tid, dry); }
      }
    } else if (sub == 3) {
      phase_attn(p, layer, smem, &s_item, tid, dry);
    } else if (sub == 4) {
      APMix ap{(const u16*)(p.ws + OFF_HN), (const u16*)(p.ws + OFF_QG)};
      for (int t = vb; t < NTM * 8; t += G) {
        const int mt = t >> 3, nt = t & 7;
        const int g0 = mt * 128 + (wave >> 1) * 64 + r;
        const float ra0 = rsqrtf(ssq[2 * (size_t)MPAD + g0] * (1.0f / 512.0f) + EPS), rg0 = rsqrtf(ssq[3 * (size_t)MPAD + g0] * (1.0f / 512.0f) + EPS);
        const float ra1 = rsqrtf(ssq[2 * (size_t)MPAD + g0 + 32] * (1.0f / 512.0f) + EPS), rg1 = rsqrtf(ssq[3 * (size_t)MPAD + g0 + 32] * (1.0f / 512.0f) + EPS);
        EpiRes e; res_bases(p, mt, layer == 0, e.sb, e.db, e.minrow); e.fin0 = rg0; e.fin1 = rg1;
        gemm_tile<true>(ap, Wl + WO_OUT, 1024, 1024, mt * 128, nt * 128, e, smem, ra0 / rg0, ra1 / rg1, tid, dry);
      }
    } else if (sub == 5) {
      phase_norm(p, p.mlp_g + layer * 1024, false, false, tid);
    } else if (sub == 6 || sub == 8) {
      const int mh = (sub - 6) >> 1;
      EpiUp e; e.U0 = (u16*)(p.ws + OFF_U) - (size_t)mh * 259 * 128 * 4096;
      APLin ap{(const u16*)(p.ws + OFF_HN), 1024};
      for (int t = vb; t < 259 * 32; t += G) {
        int ml, nt;
        if (t < 256 * 32) { const int blk = t >> 6, w = t & 63; ml = (blk >> 2) * 8 + (w >> 3); nt = (blk & 3) * 8 + (w & 7); }
        else { ml = t >> 5; nt = t & 31; }
        gemm_tile<false>(ap, Wl + WO_UP, 1024, 1024, (mh * 259 + ml) * 128, nt * 128, e, smem, 1.f, 1.f, tid, dry);
      }
    } else {
      const int mh = (sub - 7) >> 1;
      APLin ap{(const u16*)(p.ws + OFF_U) - (size_t)mh * 259 * 128 * 4096, 4096};
      for (int t = vb; t < 259 * 8; t += G) {
        const int mt = mh * 259 + (t >> 3), nt = t & 7;
        EpiRes e; res_bases(p, mt, false, e.sb, e.db, e.minrow); e.fin0 = 1.f; e.fin1 = 1.f;
        gemm_tile<false>(ap, Wl + WO_DN, 4096, 4096, mt * 128, nt * 128, e, smem, 1.f, 1.f, tid, dry);
      }
    }
  }
}

extern "C" void kernel_launch(void* const* d_in, const int* in_sizes, int n_in, void* d_out, int out_size, void* d_ws, size_t ws_size,
                              hipStream_t stream) {
  static int grid_blocks = 0;
  if (!grid_blocks) {
    int dev = 0, cus = 0, per_cu = 0;
    hipGetDevice(&dev);
    hipDeviceGetAttribute(&cus, hipDeviceAttributeMultiprocessorCount, dev);
    hipOccupancyMaxActiveBlocksPerMultiprocessor(&per_cu, mega, 256, 0);
    if (per_cu > 2) per_cu = 2;
    if (per_cu < 1) per_cu = 1;
    grid_blocks = cus * per_cu;
  }
  Params p{};
  p.xp = (const float*)d_in[0]; p.xs = (const float*)d_in[1]; p.meta = (const float*)d_in[2];
  p.attn_g = (const float*)d_in[3]; p.w_in = (const float*)d_in[4]; p.qa_g = (const float*)d_in[5]; p.w_qb = (const float*)d_in[6];
  p.kva_g = (const float*)d_in[7]; p.w_kvb = (const float*)d_in[8]; p.gq_g = (const float*)d_in[9]; p.gk_g = (const float*)d_in[10];
  p.mo_g = (const float*)d_in[11]; p.go_g = (const float*)d_in[12]; p.w_out = (const float*)d_in[13]; p.mlp_g = (const float*)d_in[14];
  p.w_up = (const float*)d_in[15]; p.w_dn = (const float*)d_in[16]; p.fin_g = (const float*)d_in[17];
  p.out = (float*)d_out; p.ws = (char*)d_ws;
#if MK_MULTI
  for (int ph = 0; ph < 42; ++ph) {
    p.phase_lo = ph; p.phase_hi = ph + 1; p.probe = PROBE_MASK;
    if (ph > 0 && ph < 41 && ((ph - 1) & 1) == 0 && !((PROBE_MASK >> (((ph - 1) % 20) >> 1)) & 1)) continue;
    hipLaunchKernelGGL(mega, dim3(grid_blocks), dim3(256), 0, stream, p);
  }
#else
  p.phase_lo = 0; p.phase_hi = 42; p.probe = PROBE_MASK;
  void* args[] = {&p};
  hipError_t e = hipLaunchCooperativeKernel((void*)mega, dim3(grid_blocks), dim3(256), args, 0, stream);
  if (e != hipSuccess) fprintf(stderr, "cooperative launch failed: %s (grid %d)\n", hipGetErrorString(e), grid_blocks);
#endif
}
```

```cpp
#include <hip/hip_runtime.h>
#include <hip/hip_cooperative_groups.h>
#include <stdint.h>
#include <cstdio>
namespace cg = cooperative_groups;

#ifndef PROBE_MASK
#define PROBE_MASK 0
#endif
#ifndef MK_MULTI
#define MK_MULTI 0
#endif

typedef unsigned short u16;
typedef short bf16x8 __attribute__((ext_vector_type(8)));
typedef float f32x16 __attribute__((ext_vector_type(16)));
typedef unsigned u32x4 __attribute__((ext_vector_type(4)));
typedef unsigned u32x2 __attribute__((ext_vector_type(2)));
typedef float f32x2v __attribute__((ext_vector_type(2)));
typedef __bf16 bf16x2v __attribute__((ext_vector_type(2)));
#define DI __device__ __forceinline__
#define WAVE_LDS_FENCE() asm volatile("s_waitcnt lgkmcnt(0)" ::: "memory")
#define MFMA(a, b, c) __builtin_amdgcn_mfma_f32_32x32x16_bf16((a), (b), (c), 0, 0, 0)

constexpr int MPAD = 66304;
constexpr int NTM = 518;
constexpr float EPS = 1e-6f;
constexpr float LOG2E = 1.4426950408889634f;
constexpr float QSCALE_M = 0.10206207261596575f * LOG2E;
constexpr float QSCALE_G = 0.125f * LOG2E;

constexpr size_t SZ_WIN = 1536ull * 1024, SZ_WQB = 768ull * 384, SZ_WKVB = 1024ull * 256, SZ_WOUT = 1024ull * 1024,
                 SZ_WUP = 4096ull * 1024, SZ_WDN = 1024ull * 4096;
constexpr size_t WO_IN = 0, WO_QB = WO_IN + SZ_WIN, WO_KVB = WO_QB + SZ_WQB, WO_OUT = WO_KVB + SZ_WKVB, WO_UP = WO_OUT + SZ_WOUT,
                 WO_DN = WO_UP + SZ_WUP, W_LAYER = WO_DN + SZ_WDN;
constexpr size_t OFF_W = 0;
constexpr size_t OFF_TAB = OFF_W + 2 * W_LAYER * 2;
constexpr size_t OFF_XMETA = OFF_TAB + 16400ull * 16 * 8;
constexpr size_t OFF_SSQ = OFF_XMETA + 96ull * 1024 * 4;
constexpr size_t OFF_CNT = OFF_SSQ + 4ull * MPAD * 4;
constexpr size_t OFF_BAR = OFF_CNT + 1024;
constexpr size_t OFF_HN = OFF_BAR + 16384;
constexpr size_t OFF_CQ = OFF_HN + (size_t)MPAD * 1024 * 2;
constexpr size_t OFF_CKV = OFF_CQ + (size_t)MPAD * 384 * 2;
constexpr size_t OFF_KN = OFF_CKV + (size_t)MPAD * 256 * 2;
constexpr size_t OFF_KPE = OFF_KN + (size_t)MPAD * 512 * 2;
constexpr size_t OFF_VMT = OFF_KPE + (size_t)MPAD * 32 * 2;
constexpr size_t OFF_QG = OFF_VMT + (size_t)MPAD * 512 * 2;
constexpr size_t OFF_KG = OFF_QG + (size_t)MPAD * 512 * 2;
constexpr size_t OFF_VGT = OFF_KG + (size_t)MPAD * 128 * 2;
constexpr size_t OFF_END = OFF_VGT + (size_t)MPAD * 128 * 2;
constexpr size_t OFF_U = OFF_CQ;
static_assert(OFF_U + (size_t)259 * 128 * 4096 * 2 <= OFF_END, "U fits");
static_assert(OFF_END <= 536870912ull, "workspace");

struct Params {
  const float* xp; const float* xs; const float* meta;
  const float* attn_g; const float* w_in; const float* qa_g; const float* w_qb; const float* kva_g; const float* w_kvb;
  const float* gq_g; const float* gk_g; const float* mo_g; const float* go_g; const float* w_out; const float* mlp_g;
  const float* w_up; const float* w_dn; const float* fin_g;
  float* out; char* ws;
  int phase_lo, phase_hi, probe, pad_;
};

DI unsigned pack2(float a, float b) { f32x2v f = {a, b}; bf16x2v v = __builtin_convertvector(f, bf16x2v); return __builtin_bit_cast(unsigned, v); }
DI u16 f2bf(float a) { return (u16)(pack2(a, 0.f) & 0xffffu); }
DI void store4(u16* dst, float a, float b, float c, float d) { u32x2 v = {pack2(a, b), pack2(c, d)}; *(u32x2*)dst = v; }
DI int crow(int i, int h) { return (i & 3) + 8 * (i >> 2) + 4 * h; }
DI int swap23(int r) { return (r & 0x13) | ((r & 4) << 1) | ((r & 8) >> 1); }
DI float xhalf(float v) { return __shfl_xor(v, 32); }

DI void decode_tile(int T, int& seq, int& i) {
  if (T < 258) { seq = (T >= 129) ? 1 : 0; i = T - seq * 129; }
  else { int u = T - 258; int q = u / 65; seq = 2 + q; i = u - q * 65; }
}
DI int seq_base(int seq) { return seq < 2 ? seq * 16512 : 33024 + (seq - 2) * 8320; }

DI const float* xrow_src(const Params& p, int g, bool from_input) {
  int T = g >> 7, r = g & 127, seq, i; decode_tile(T, seq, i);
  if (i == 0) {
    if (r < 112) return nullptr;
    return from_input ? p.meta + (size_t)(r - 112) * 1024 : (const float*)(p.ws + OFF_XMETA) + (size_t)(seq * 16 + r - 112) * 1024;
  }
  int j = (i - 1) * 128 + r;
  if (seq < 2) { size_t row = (size_t)seq * 16384 + j; return from_input ? p.xp + row * 1024 : p.out + row * 1024; }
  size_t row = (size_t)(seq - 2) * 8192 + j;
  return from_input ? p.xs + row * 1024 : p.out + (32768 + row) * 1024;
}
DI float* xrow_dst(const Params& p, int g) {
  int T = g >> 7, r = g & 127, seq, i; decode_tile(T, seq, i);
  if (i == 0) {
    if (r < 112) return nullptr;
    return (float*)(p.ws + OFF_XMETA) + (size_t)(seq * 16 + r - 112) * 1024;
  }
  int j = (i - 1) * 128 + r;
  if (seq < 2) { size_t row = (size_t)seq * 16384 + j; return p.out + row * 1024; }
  size_t row = (size_t)(seq - 2) * 8192 + j;
  return p.out + (32768 + row) * 1024;
}

DI int mapcol(int kind, int n) {
  if (kind == 1) { if (n < 640) return n; if (n < 1408) return n + 32; if (n < 1440) return 640 + (n - 1408); return -1; }
  if (kind == 2) { if (n < 512) return (n >> 6) * 96 + (n & 63); int m = n - 512; return (m >> 5) * 96 + 64 + (m & 31); }
  if (kind == 3) { if (n < 512) return (n >> 6) * 128 + (n & 63); int m = n - 512; return (m >> 6) * 128 + 64 + (m & 63); }
  return n;
}
DI void prep_weight(const float* __restrict__ src, int Nsrc, u16* __restrict__ dst, int Nout, int K, const float* gA, const float* gB,
                    int ksplit, int kind, int gtid, int gthreads) {
  const int total = Nout * (K >> 3);
  for (int u = gtid; u < total; u += gthreads) {
    const int n = u % Nout, kc = u / Nout;
    const int col = mapcol(kind, n);
    const int k = kc * 8;
    float v[8];
#pragma unroll
    for (int j = 0; j < 8; ++j) {
      float x = 0.f;
      if (col >= 0) {
        x = src[(size_t)(k + j) * Nsrc + col];
        if (gA) x *= (k + j < ksplit) ? gA[k + j] : gB[k + j - ksplit];
      }
      v[j] = x;
    }
    u32x4 o = {pack2(v[0], v[1]), pack2(v[2], v[3]), pack2(v[4], v[5]), pack2(v[6], v[7])};
    *(u32x4*)(dst + (size_t)n * K + k) = o;
  }
}

DI void phase_prep(const Params& p, int tid) {
  const int gtid = blockIdx.x * 256 + tid, gthreads = gridDim.x * 256;
  u16* W = (u16*)(p.ws + OFF_W);
  for (int l = 0; l < 2; ++l) {
    u16* Wl = W + (size_t)l * W_LAYER;
    prep_weight(p.w_in + (size_t)l * 1024 * 1440, 1440, Wl + WO_IN, 1536, 1024, nullptr, nullptr, 0, 1, gtid, gthreads);
    prep_weight(p.w_qb + (size_t)l * 384 * 768, 768, Wl + WO_QB, 768, 384, p.qa_g + l * 384, p.qa_g + l * 384, 384, 2, gtid, gthreads);
    prep_weight(p.w_kvb + (size_t)l * 256 * 1024, 1024, Wl + WO_KVB, 1024, 256, p.kva_g + l * 256, p.kva_g + l * 256, 256, 3, gtid, gthreads);
    prep_weight(p.w_out + (size_t)l * 1024 * 1024, 1024, Wl + WO_OUT, 1024, 1024, p.mo_g + l * 512, p.go_g + l * 512, 512, 0, gtid, gthreads);
    prep_weight(p.w_up + (size_t)l * 1024 * 4096, 4096, Wl + WO_UP, 4096, 1024, nullptr, nullptr, 0, 0, gtid, gthreads);
    prep_weight(p.w_dn + (size_t)l * 4096 * 1024, 1024, Wl + WO_DN, 1024, 4096, nullptr, nullptr, 0, 0, gtid, gthreads);
  }
  float2* tab = (float2*)(p.ws + OFF_TAB);
  for (int u = gtid; u < 16400 * 16; u += gthreads) {
    const int pos = u >> 4, f = u & 15;
    const float invf = 1.0f / powf(10000.0f, (float)(2 * f) / 32.0f);
    const float ang = (float)pos * invf;
    const double rev = (double)ang * 0.15915494309189535;
    const double fr = rev - rint(rev);
    const float x = (float)(2.0 * fr);
    tab[u] = make_float2(cospif(x), sinpif(x));
  }
  float* xm = (float*)(p.ws + OFF_XMETA);
  for (int u = gtid; u < 96 * 1024; u += gthreads) xm[u] = p.meta[u & 16383];
  int* cnt = (int*)(p.ws + OFF_CNT);
  if (gtid < 64) cnt[gtid] = 0;
  unsigned* bar = (unsigned*)(p.ws + OFF_BAR);
  if (gtid < 4096) bar[gtid] = 0u;
}

DI void phase_norm(const Params& p, const float* __restrict__ gain, bool from_input, bool zero_ssq, int tid) {
  const int lane = tid & 63;
  const int gw = blockIdx.x * 4 + (tid >> 6), nw = gridDim.x * 4;
  u16* HN = (u16*)(p.ws + OFF_HN);
  float* ssq = (float*)(p.ws + OFF_SSQ);
  for (int g = gw; g < MPAD; g += nw) {
    const float* xr = xrow_src(p, g, from_input);
    u16* hr = HN + (size_t)g * 1024;
    if (!xr) {
      u32x4 z = {0u, 0u, 0u, 0u};
      *(u32x4*)(hr + lane * 16) = z;
      *(u32x4*)(hr + lane * 16 + 8) = z;
    } else {
      float4 v[4];
#pragma unroll
      for (int q = 0; q < 4; ++q) v[q] = ((const float4*)xr)[lane + 64 * q];
      float ss = 0.f;
#pragma unroll
      for (int q = 0; q < 4; ++q) ss += v[q].x * v[q].x + v[q].y * v[q].y + v[q].z * v[q].z + v[q].w * v[q].w;
#pragma unroll
      for (int o = 32; o >= 1; o >>= 1) ss += __shfl_xor(ss, o);
      const float rstd = rsqrtf(ss * (1.0f / 1024.0f) + EPS);
#pragma unroll
      for (int q = 0; q < 4; ++q) {
        const float4 gg = ((const float4*)gain)[lane + 64 * q];
        store4(hr + 4 * (lane + 64 * q), v[q].x * rstd * gg.x, v[q].y * rstd * gg.y, v[q].z * rstd * gg.z, v[q].w * rstd * gg.w);
      }
    }
    if (zero_ssq && lane < 4) ssq[(size_t)lane * MPAD + g] = 0.f;
  }
}

DI void phase_final(const Params& p, int tid) {
  const int lane = tid & 63;
  const int gw = blockIdx.x * 4 + (tid >> 6), nw = gridDim.x * 4;
  for (int g = gw; g < MPAD; g += nw) {
    if (((g >> 7) == 0) || ((g >> 7) == 129) || ((g >> 7) >= 258 && ((g >> 7) - 258) % 65 == 0)) continue;
    float* xr = xrow_dst(p, g);
    float4 v[4];
#pragma unroll
    for (int q = 0; q < 4; ++q) v[q] = ((const float4*)xr)[lane + 64 * q];
    float ss = 0.f;
#pragma unroll
    for (int q = 0; q < 4; ++q) ss += v[q].x * v[q].x + v[q].y * v[q].y + v[q].z * v[q].z + v[q].w * v[q].w;
#pragma unroll
    for (int o = 32; o >= 1; o >>= 1) ss += __shfl_xor(ss, o);
    const float rstd = rsqrtf(ss * (1.0f / 1024.0f) + EPS);
#pragma unroll
    for (int q = 0; q < 4; ++q) {
      const float4 gg = ((const float4*)p.fin_g)[lane + 64 * q];
      float4 o = make_float4(v[q].x * rstd * gg.x, v[q].y * rstd * gg.y, v[q].z * rstd * gg.z, v[q].w * rstd * gg.w);
      ((float4*)xr)[lane + 64 * q] = o;
    }
  }
}

constexpr int GP = 72;
struct APLin { const u16* A; int lda; DI const u16* ptr(int row, int k0) const { return A + (size_t)row * lda + k0; } };
struct APMix { const u16* QM; const u16* QG;
  DI const u16* ptr(int row, int k0) const { return k0 < 512 ? QM + (size_t)row * 768 + (k0 >> 6) * 96 : QG + (size_t)row * 512 + (k0 - 512); } };

template <bool MIDK, class AP, class EPI>
DI void gemm_tile(const AP& ap, const u16* __restrict__ W, int ldw, int K, int m0, int n0, const EPI& epi, char* smem, float r0, float r1, int tid, bool dry) {
  constexpr int SBUF = 2 * 128 * GP;
  u16* sA = (u16*)smem;
  u16* sB = sA + 128 * GP;
  const int lane = tid & 63, wave = tid >> 6, r = lane & 31, h = lane >> 5, wm = wave >> 1, wn = wave & 1;
  const int lrow = tid >> 3, lkc = (tid & 7) * 8;
  u32x4 ra0[4], rb0[4], ra1[4], rb1[4];
  f32x16 acc[2][2];
#pragma unroll
  for (int a = 0; a < 2; ++a)
#pragma unroll
    for (int b = 0; b < 2; ++b)
#pragma unroll
      for (int i = 0; i < 16; ++i) acc[a][b][i] = 0.f;
  const int nk = K >> 6;
#define GLOADQ(RA, RB, KT, q) do { const int k0_ = (KT) << 6; \
    RA[q] = *(const u32x4*)(ap.ptr(m0 + lrow + 32 * (q), k0_) + lkc); RB[q] = *(const u32x4*)(W + (size_t)(n0 + lrow + 32 * (q)) * ldw + k0_ + lkc); } while (0)
#define GLOAD(RA, RB, KT) do { GLOADQ(RA, RB, KT, 0); GLOADQ(RA, RB, KT, 1); GLOADQ(RA, RB, KT, 2); GLOADQ(RA, RB, KT, 3); } while (0)
#define SSTOREQ(RA, RB, ST, q) do { \
    *(u32x4*)(sA + (ST) * SBUF + (lrow + 32 * (q)) * GP + lkc) = RA[q]; *(u32x4*)(sB + (ST) * SBUF + (lrow + 32 * (q)) * GP + lkc) = RB[q]; } while (0)
#define SSTORE(RA, RB, ST) do { SSTOREQ(RA, RB, ST, 0); SSTOREQ(RA, RB, ST, 1); SSTOREQ(RA, RB, ST, 2); SSTOREQ(RA, RB, ST, 3); } while (0)
#define FLOAD(F, ST, ks) do { _Pragma("unroll") for (int a = 0; a < 2; ++a) { \
    F[a] = *(const bf16x8*)(sB + (ST) * SBUF + (wn * 64 + a * 32 + r) * GP + (ks) * 16 + h * 8); \
    F[2 + a] = *(const bf16x8*)(sA + (ST) * SBUF + (wm * 64 + a * 32 + r) * GP + (ks) * 16 + h * 8); } } while (0)
#define FMMA(F) do { _Pragma("unroll") for (int a = 0; a < 2; ++a) _Pragma("unroll") for (int b = 0; b < 2; ++b) acc[a][b] = MFMA(F[a], F[2 + b], acc[a][b]); } while (0)
  bf16x8 f0[4], f1[4];
  GLOAD(ra0, rb0, 0);
  GLOAD(ra1, rb1, 1);
  __syncthreads();
  SSTORE(ra0, rb0, 0);
  if (nk > 2) GLOAD(ra0, rb0, 2);
  __syncthreads();
  for (int kt = 0; kt < nk; kt += 2) {
    const bool l3 = kt + 3 < nk, s2 = kt + 2 < nk, l4 = kt + 4 < nk;
    FLOAD(f0, 0, 0); FLOAD(f1, 0, 1);
    FMMA(f0); SSTOREQ(ra1, rb1, 1, 0); if (l3) GLOADQ(ra1, rb1, kt + 3, 0);
    FLOAD(f0, 0, 2);
    FMMA(f1); SSTOREQ(ra1, rb1, 1, 1); if (l3) GLOADQ(ra1, rb1, kt + 3, 1);
    FLOAD(f1, 0, 3);
    FMMA(f0); SSTOREQ(ra1, rb1, 1, 2); if (l3) GLOADQ(ra1, rb1, kt + 3, 2);
    FMMA(f1); SSTOREQ(ra1, rb1, 1, 3); if (l3) GLOADQ(ra1, rb1, kt + 3, 3);
    __syncthreads();
    FLOAD(f0, 1, 0); FLOAD(f1, 1, 1);
    FMMA(f0); if (s2) SSTOREQ(ra0, rb0, 0, 0); if (l4) GLOADQ(ra0, rb0, kt + 4, 0);
    FLOAD(f0, 1, 2);
    FMMA(f1); if (s2) SSTOREQ(ra0, rb0, 0, 1); if (l4) GLOADQ(ra0, rb0, kt + 4, 1);
    FLOAD(f1, 1, 3);
    FMMA(f0); if (s2) SSTOREQ(ra0, rb0, 0, 2); if (l4) GLOADQ(ra0, rb0, kt + 4, 2);
    FMMA(f1); if (s2) SSTOREQ(ra0, rb0, 0, 3); if (l4) GLOADQ(ra0, rb0, kt + 4, 3);
    if (MIDK && kt == 6) {
#pragma unroll
      for (int a = 0; a < 2; ++a)
#pragma unroll
        for (int i = 0; i < 16; ++i) { acc[a][0][i] *= r0; acc[a][1][i] *= r1; }
    }
    __syncthreads();
  }
#undef GLOADQ
#undef SSTOREQ
#undef FLOAD
#undef FMMA
#undef GLOAD
#undef SSTORE
  if (!dry) epi(acc, n0 + wn * 64, m0 + wm * 64, lane, (u16*)smem + wave * 64 * GP);
}

struct ColId { DI int operator()(int ch) const { return ch * 8; } };
struct ColRope { DI int operator()(int ch) const { return (ch >> 2) * 96 + (ch & 3) * 8; } };

template <class COLF>
DI void stage_store(f32x16 (&acc)[2][2], u16* wl, int lane, u16* dst0, size_t pitch, const COLF& colf) {
  const int r = lane & 31, h = lane >> 5;
#pragma unroll
  for (int rb = 0; rb < 2; ++rb)
#pragma unroll
    for (int lb = 0; lb < 2; ++lb)
#pragma unroll
      for (int g4 = 0; g4 < 4; ++g4)
        store4(wl + (lb * 32 + r) * GP + rb * 32 + 8 * g4 + 4 * h, acc[rb][lb][4 * g4], acc[rb][lb][4 * g4 + 1], acc[rb][lb][4 * g4 + 2], acc[rb][lb][4 * g4 + 3]);
  WAVE_LDS_FENCE();
#pragma unroll
  for (int it = 0; it < 8; ++it) {
    const int row = it * 8 + (lane >> 3), ch = lane & 7;
    const u32x4 v = *(const u32x4*)(wl + row * GP + ch * 8);
    *(u32x4*)(dst0 + (size_t)row * pitch + colf(ch)) = v;
  }
  WAVE_LDS_FENCE();
}

DI void rope16(float (&v)[16], const float2* __restrict__ tabrow, int h) {
#pragma unroll
  for (int i = 0; i < 8; ++i) {
    const int f = (i & 3) + 8 * (i >> 2) + 4 * h;
    const float2 cs = tabrow[f];
    const float x1 = v[i], x2 = v[i + 8];
    v[i] = x1 * cs.x - x2 * cs.y;
    v[i + 8] = x2 * cs.x + x1 * cs.y;
  }
}

struct EpiIn {
  u16 *CQ, *CKV, *QG, *KG, *VGT, *KPE; float *ssq_q, *ssq_kv; const float *gq_g, *gk_g; const float2* tab;
  DI void operator()(f32x16 (&acc)[2][2], int nb, int mb, int lane, u16* wl) const {
    const int r = lane & 31, h = lane >> 5;
    int seq, it; decode_tile(mb >> 7, seq, it);
#pragma unroll
    for (int ti = 0; ti < 2; ++ti) {
      const int g = mb + ti * 32 + r, rr = g & 127;
      if (nb < 640) {
        float ss = 0.f;
#pragma unroll
        for (int fi = 0; fi < 2; ++fi)
#pragma unroll
          for (int i = 0; i < 16; ++i) ss += acc[fi][ti][i] * acc[fi][ti][i];
        ss += xhalf(ss);
        if (h == 0) unsafeAtomicAdd((nb < 384 ? ssq_q : ssq_kv) + g, ss);
      } else if (nb < 1280) {
        const bool isq = nb < 1152;
        const float* gg = isq ? gq_g : gk_g;
        float ss = 0.f;
#pragma unroll
        for (int fi = 0; fi < 2; ++fi)
#pragma unroll
          for (int i = 0; i < 16; ++i) ss += acc[fi][ti][i] * acc[fi][ti][i];
        ss += xhalf(ss);
        const float rstd = rsqrtf(ss * (1.0f / 64.0f) + EPS);
        const float osc = isq ? QSCALE_G : 1.0f;
        int prow = 0, pcol = 0;
        if (it > 0) { const int j = (it - 1) * 128 + rr; prow = j >> 6; pcol = j & 63; }
        u16* dst = isq ? QG + (size_t)g * 512 + (nb - 640) : KG + (size_t)g * 128 + (nb - 1152);
#pragma unroll
        for (int fi = 0; fi < 2; ++fi) {
          const int pos = fi == 0 ? prow : pcol;
          float v[16];
#pragma unroll
          for (int i = 0; i < 16; ++i) v[i] = acc[fi][ti][i] * rstd * gg[fi * 32 + crow(i, h)];
          rope16(v, tab + pos * 16, h);
#pragma unroll
          for (int g4 = 0; g4 < 4; ++g4)
            store4(dst + fi * 32 + 8 * g4 + 4 * h, v[4 * g4] * osc, v[4 * g4 + 1] * osc, v[4 * g4 + 2] * osc, v[4 * g4 + 3] * osc);
        }
      } else if (nb < 1408) {
#pragma unroll
        for (int fi = 0; fi < 2; ++fi)
#pragma unroll
          for (int i = 0; i < 16; ++i) VGT[(size_t)(nb - 1280 + fi * 32 + crow(i, h)) * MPAD + g] = f2bf(acc[fi][ti][i]);
      } else if (nb == 1408) {
        int pos = 128 * it + rr - 112; pos = pos < 0 ? 0 : pos;
        float v[16];
#pragma unroll
        for (int i = 0; i < 16; ++i) v[i] = acc[0][ti][i];
        rope16(v, tab + pos * 16, h);
#pragma unroll
        for (int g4 = 0; g4 < 4; ++g4) store4(KPE + (size_t)g * 32 + 8 * g4 + 4 * h, v[4 * g4], v[4 * g4 + 1], v[4 * g4 + 2], v[4 * g4 + 3]);
      }
    }
    if (nb < 384) stage_store(acc, wl, lane, CQ + (size_t)mb * 384 + nb, 384, ColId());
    else if (nb < 640) stage_store(acc, wl, lane, CKV + (size_t)mb * 256 + (nb - 384), 256, ColId());
  }
};

struct EpiQB {
  u16* QM; const float* ssq_q; const float2* tab;
  DI void operator()(f32x16 (&acc)[2][2], int nb, int mb, int lane, u16* wl) const {
    const int r = lane & 31, h = lane >> 5;
    int seq, it; decode_tile(mb >> 7, seq, it);
#pragma unroll
    for (int ti = 0; ti < 2; ++ti) {
      const int g = mb + ti * 32 + r, rr = g & 127;
      const float sc = rsqrtf(ssq_q[g] * (1.0f / 384.0f) + EPS) * QSCALE_M;
      if (nb < 512) {
#pragma unroll
        for (int fi = 0; fi < 2; ++fi)
#pragma unroll
          for (int i = 0; i < 16; ++i) acc[fi][ti][i] *= sc;
      } else {
        int pos = 128 * it + rr - 112; pos = pos < 0 ? 0 : pos;
#pragma unroll
        for (int fi = 0; fi < 2; ++fi) {
          float v[16];
#pragma unroll
          for (int i = 0; i < 16; ++i) v[i] = acc[fi][ti][i] * sc;
          rope16(v, tab + pos * 16, h);
#pragma unroll
          for (int i = 0; i < 16; ++i) acc[fi][ti][i] = v[i];
        }
      }
    }
    if (nb < 512) stage_store(acc, wl, lane, QM + (size_t)mb * 768 + (nb >> 6) * 96, 768, ColId());
    else stage_store(acc, wl, lane, QM + (size_t)mb * 768 + ((nb - 512) >> 5) * 96 + 64, 768, ColRope());
  }
};

struct EpiKVB {
  u16 *KN, *VMT; const float* ssq_kv;
  DI void operator()(f32x16 (&acc)[2][2], int nb, int mb, int lane, u16* wl) const {
    const int r = lane & 31, h = lane >> 5;
#pragma unroll
    for (int ti = 0; ti < 2; ++ti) {
      const int g = mb + ti * 32 + r;
      const float sc = rsqrtf(ssq_kv[g] * (1.0f / 256.0f) + EPS);
      if (nb < 512) {
#pragma unroll
        for (int fi = 0; fi < 2; ++fi)
#pragma unroll
          for (int i = 0; i < 16; ++i) acc[fi][ti][i] *= sc;
      } else {
#pragma unroll
        for (int fi = 0; fi < 2; ++fi)
#pragma unroll
          for (int i = 0; i < 16; ++i) VMT[(size_t)(nb - 512 + fi * 32 + crow(i, h)) * MPAD + g] = f2bf(acc[fi][ti][i] * sc);
      }
    }
    if (nb < 512) stage_store(acc, wl, lane, KN + (size_t)mb * 512 + nb, 512, ColId());
  }
};

DI void res_bases(const Params& p, int mt, bool from_input, const float*& sb, float*& db, int& minrow) {
  int seq, it; decode_tile(mt, seq, it);
  float* xm = (float*)(p.ws + OFF_XMETA);
  if (it == 0) {
    minrow = 112;
    db = xm + ((ptrdiff_t)seq * 16 - 112) * 1024;
    sb = from_input ? p.meta - 112 * 1024 : db;
  } else {
    minrow = 0;
    const size_t row = seq < 2 ? (size_t)seq * 16384 + (size_t)(it - 1) * 128 : 32768 + (size_t)(seq - 2) * 8192 + (size_t)(it - 1) * 128;
    db = p.out + row * 1024;
    sb = from_input ? (seq < 2 ? p.xp + row * 1024 : p.xs + (row - 32768) * 1024) : db;
  }
}

struct EpiRes {
  const float* sb; float* db; int minrow; float fin0, fin1;
  DI void operator()(f32x16 (&acc)[2][2], int nb, int mb, int lane, u16* wl) const {
    const int r = lane & 31, h = lane >> 5, mbl = mb & 127;
    float* wf = (float*)wl;
#pragma unroll
    for (int fi = 0; fi < 2; ++fi) {
#pragma unroll
      for (int ti = 0; ti < 2; ++ti) {
        const float sc = ti == 0 ? fin0 : fin1;
#pragma unroll
        for (int g4 = 0; g4 < 4; ++g4) {
          float4 o = make_float4(acc[fi][ti][4 * g4] * sc, acc[fi][ti][4 * g4 + 1] * sc, acc[fi][ti][4 * g4 + 2] * sc, acc[fi][ti][4 * g4 + 3] * sc);
          *(float4*)(wf + (ti * 32 + r) * 36 + 8 * g4 + 4 * h) = o;
        }
      }
      WAVE_LDS_FENCE();
#pragma unroll
      for (int it = 0; it < 8; ++it) {
        const int row = it * 8 + (lane >> 3), ch = lane & 7;
        const float4 a = *(const float4*)(wf + row * 36 + ch * 4);
        const int trow = mbl + row;
        if (trow >= minrow) {
          const size_t off = (size_t)trow * 1024 + nb + fi * 32 + ch * 4;
          float4 x = *(const float4*)(sb + off);
          x.x += a.x; x.y += a.y; x.z += a.z; x.w += a.w;
          *(float4*)(db + off) = x;
        }
      }
      WAVE_LDS_FENCE();
    }
  }
};

struct EpiUp {
  u16* U0;
  DI void operator()(f32x16 (&acc)[2][2], int nb, int mb, int lane, u16* wl) const {
#pragma unroll
    for (int ti = 0; ti < 2; ++ti)
#pragma unroll
      for (int fi = 0; fi < 2; ++fi)
#pragma unroll
        for (int i = 0; i < 16; ++i) { const float a = fmaxf(acc[fi][ti][i], 0.f); acc[fi][ti][i] = a * a; }
    stage_store(acc, wl, lane, U0 + (size_t)mb * 4096 + nb, 4096, ColId());
  }
};

constexpr float ATT_THR = 8.0f;

template <int DQK>
struct AttnCtx {
  static constexpr int KP = DQK + 8, NKS = DQK / 16, KCH = DQK / 8, NKL = 64 * KCH / 256, KBUF = 64 * KP, VBUF = 64 * GP;
  const u16 *Kb, *KPEb, *Vt; int kpitch, rowk0, nt, tid, r, h, sr;
  u16 *sK, *sV;
  bf16x8 qf[NKS], kone, qm;
  f32x16 o[2];
  float mref, l;
  u32x4 rk[NKL], rv[2];

  int koff[NKL], voff[2];
  DI void init_offs() {
#pragma unroll
    for (int q = 0; q < NKL; ++q) {
      const int c = tid + 256 * q, row = c / KCH, cc = c % KCH;
      koff[q] = (DQK == 96 && cc >= 8) ? row * 32 + (cc - 8) * 8 : row * kpitch + cc * 8;
    }
#pragma unroll
    for (int q = 0; q < 2; ++q) { const int c = tid + 256 * q, dv = c >> 3, kc = c & 7; voff[q] = dv * MPAD + kc * 8; }
  }
  DI void gload_k(int t) {
    const int row0 = rowk0 + t * 64;
    const u16* kt = Kb + (size_t)row0 * kpitch;
    const u16* pt = KPEb + (size_t)row0 * 32;
#pragma unroll
    for (int q = 0; q < NKL; ++q) {
      const int c = tid + 256 * q, cc = c % KCH;
      rk[q] = *(const u32x4*)(((DQK == 96 && cc >= 8) ? pt : kt) + koff[q]);
    }
  }
  DI void gload_v(int t) {
    const u16* vt = Vt + (rowk0 + t * 64);
#pragma unroll
    for (int q = 0; q < 2; ++q) rv[q] = *(const u32x4*)(vt + voff[q]);
  }
  DI void sstore_k(int buf) {
#pragma unroll
    for (int q = 0; q < NKL; ++q) {
      const int c = tid + 256 * q, row = c / KCH, cc = c % KCH;
      *(u32x4*)(sK + buf * KBUF + row * KP + cc * 8) = rk[q];
    }
  }
  DI void sstore_v(int buf) {
#pragma unroll
    for (int q = 0; q < 2; ++q) {
      const int c = tid + 256 * q, dv = c >> 3, kc = c & 7;
      *(u32x4*)(sV + buf * VBUF + dv * GP + kc * 8) = rv[q];
    }
  }
  DI void qk(int buf, f32x16 (&s)[2]) {
    const u16* kb = sK + buf * KBUF + sr * KP + h * 8;
#pragma unroll
    for (int kb2 = 0; kb2 < 2; ++kb2)
#pragma unroll
      for (int i = 0; i < 16; ++i) s[kb2][i] = 0.f;
#pragma unroll
    for (int ks = 0; ks < NKS; ++ks)
#pragma unroll
      for (int kb2 = 0; kb2 < 2; ++kb2) {
        const bf16x8 a = *(const bf16x8*)(kb + kb2 * 32 * KP + ks * 16);
        s[kb2] = MFMA(a, qf[ks], s[kb2]);
      }
    s[0] = MFMA(kone, qm, s[0]);
    s[1] = MFMA(kone, qm, s[1]);
  }
  template <int PAR>
  DI void step(int t, f32x16 (&cur)[2], f32x16 (&nxt)[2]) {
    if (t + 1 < nt) sstore_k(PAR ^ 1);
    if (t > 0) sstore_v(PAR);
    __syncthreads();
    if (t + 1 < nt) qk(PAR ^ 1, nxt);
    float mx = fmaxf(cur[0][0], cur[1][0]);
#pragma unroll
    for (int i = 1; i < 16; ++i) mx = fmaxf(fmaxf(cur[0][i], cur[1][i]), mx);
    if (__builtin_amdgcn_ballot_w64(mx > ATT_THR) != 0ull) {
      asm volatile("" ::: "memory");
      mx = fmaxf(mx, xhalf(mx));
      const float want = mref + fmaxf(mx, 0.f);
      const float mn = __uint_as_float(pack2(want, 0.f) << 16);
      const float d = mn - mref;
      const float alpha = __builtin_amdgcn_exp2f(-d);
      mref = mn;
      l *= alpha;
#pragma unroll
      for (int a = 0; a < 2; ++a)
#pragma unroll
        for (int i = 0; i < 16; ++i) { o[a][i] *= alpha; cur[a][i] -= d; nxt[a][i] -= d; }
      u32x4 q4 = {h == 0 ? (pack2(-mn, 0.f) & 0xffffu) : 0u, 0u, 0u, 0u};
      qm = __builtin_bit_cast(bf16x8, q4);
    }
    float psum = 0.f;
#pragma unroll
    for (int kb2 = 0; kb2 < 2; ++kb2)
#pragma unroll
      for (int i = 0; i < 16; ++i) { const float pv = __builtin_amdgcn_exp2f(cur[kb2][i]); cur[kb2][i] = pv; psum += pv; }
    l += psum;
    if (t + 2 < nt) gload_k(t + 2);
    if (t + 1 < nt) gload_v(t + 1);
    const u16* vb = sV + PAR * VBUF + r * GP + h * 8;
#pragma unroll
    for (int kb2 = 0; kb2 < 2; ++kb2)
#pragma unroll
      for (int s2 = 0; s2 < 2; ++s2) {
        u32x4 pk = {pack2(cur[kb2][8 * s2], cur[kb2][8 * s2 + 1]), pack2(cur[kb2][8 * s2 + 2], cur[kb2][8 * s2 + 3]),
                    pack2(cur[kb2][8 * s2 + 4], cur[kb2][8 * s2 + 5]), pack2(cur[kb2][8 * s2 + 6], cur[kb2][8 * s2 + 7])};
        const bf16x8 pf = __builtin_bit_cast(bf16x8, pk);
#pragma unroll
        for (int db = 0; db < 2; ++db) {
          const bf16x8 a = *(const bf16x8*)(vb + db * 32 * GP + kb2 * 32 + s2 * 16);
          o[db] = MFMA(a, pf, o[db]);
        }
      }
  }
};

template <int DQK>
DI void attn_item(const u16* __restrict__ Qb, int qpitch, const u16* __restrict__ Kb, int kpitch, const u16* __restrict__ KPEb,
                  const u16* __restrict__ Vt, float* __restrict__ ssq, int rowq0, int rowk0, int nt, char* smem, int tid, bool dry) {
  typedef AttnCtx<DQK> C;
  C c;
  const int lane = tid & 63, wave = tid >> 6, r = lane & 31, h = lane >> 5;
  c.Kb = Kb; c.KPEb = KPEb; c.Vt = Vt; c.kpitch = kpitch; c.rowk0 = rowk0; c.nt = nt; c.tid = tid; c.r = r; c.h = h; c.sr = swap23(r);
  c.sK = (u16*)smem; c.sV = c.sK + 2 * C::KBUF;
  c.init_offs();
  const int myrow = rowq0 + wave * 32 + r;
  {
    const u16* qrow = Qb + (size_t)myrow * qpitch + h * 8;
#pragma unroll
    for (int ks = 0; ks < C::NKS; ++ks) c.qf[ks] = *(const bf16x8*)(qrow + ks * 16);
  }
#pragma unroll
  for (int a = 0; a < 2; ++a)
#pragma unroll
    for (int i = 0; i < 16; ++i) c.o[a][i] = 0.f;
  c.mref = 0.f; c.l = 0.f;
  {
    u32x4 k1 = {h == 0 ? 0x3F80u : 0u, 0u, 0u, 0u}, z4 = {0u, 0u, 0u, 0u};
    c.kone = __builtin_bit_cast(bf16x8, k1); c.qm = __builtin_bit_cast(bf16x8, z4);
  }
  f32x16 sa[2], sb[2];
  c.gload_k(0); c.gload_v(0);
  __syncthreads();
  c.sstore_k(0); c.sstore_v(0);
  if (nt > 1) c.gload_k(1);
  __syncthreads();
  c.qk(0, sa);
#pragma unroll
  for (int i = 0; i < 16; ++i) {
    sa[0][i] = -1e30f;
    if (swap23(crow(i, h)) < 16) sa[1][i] = -1e30f;
  }
  int t = 0;
  for (; t + 1 < nt; t += 2) {
    c.template step<0>(t, sa, sb);
    c.template step<1>(t + 1, sb, sa);
  }
  if (t < nt) c.template step<0>(t, sa, sb);
  if (dry) return;
  float l = c.l;
  l += xhalf(l);
  const float inv = 1.0f / l;
  float ss = 0.f;
  u16* orow = (u16*)Qb + (size_t)myrow * qpitch;
#pragma unroll
  for (int db = 0; db < 2; ++db)
#pragma unroll
    for (int g4 = 0; g4 < 4; ++g4) {
      const float a0 = c.o[db][4 * g4] * inv, a1 = c.o[db][4 * g4 + 1] * inv, a2 = c.o[db][4 * g4 + 2] * inv, a3 = c.o[db][4 * g4 + 3] * inv;
      ss += a0 * a0 + a1 * a1 + a2 * a2 + a3 * a3;
      store4(orow + db * 32 + 8 * g4 + 4 * h, a0, a1, a2, a3);
    }
  ss += xhalf(ss);
  if (h == 0) unsafeAtomicAdd(ssq + myrow, ss);
}

constexpr int N_ITEMS = 8288;
DI void phase_attn(const Params& p, int layer, char* smem, int* s_item, int tid, bool dry) {
  int* cnt = (int*)(p.ws + OFF_CNT) + layer + (dry ? 2 : 0);
  u16* QM = (u16*)(p.ws + OFF_HN);
  const u16* KN = (const u16*)(p.ws + OFF_KN);
  const u16* KPE = (const u16*)(p.ws + OFF_KPE);
  const u16* VMT = (const u16*)(p.ws + OFF_VMT);
  u16* QG = (u16*)(p.ws + OFF_QG);
  const u16* KG = (const u16*)(p.ws + OFF_KG);
  const u16* VGT = (const u16*)(p.ws + OFF_VGT);
  float* ssq = (float*)(p.ws + OFF_SSQ);
  for (;;) {
    if (tid == 0) *s_item = atomicAdd(cnt, 1);
    __syncthreads();
    const int it = *s_item;
    __syncthreads();
    if (it >= N_ITEMS) break;
    int grp, seq, head, qi, nt;
    if (it < 4128) { grp = it / 2064; const int u = it - grp * 2064; const int sh = u / 129; qi = u - sh * 129; seq = sh >> 3; head = sh & 7; nt = 257; }
    else { const int u0 = it - 4128; grp = u0 / 2080; const int u = u0 - grp * 2080; const int sh = u / 65; qi = u - sh * 65; seq = 2 + (sh >> 3); head = sh & 7; nt = 129; }
    const int P = seq_base(seq);
    if (grp == 0)
      attn_item<96>(QM + head * 96, 768, KN + head * 64, 512, KPE, VMT + (size_t)head * 64 * MPAD, ssq + 2 * (size_t)MPAD, P + qi * 128, P + 64, nt, smem, tid, dry);
    else
      attn_item<64>(QG + head * 64, 512, KG + (head >> 2) * 64, 128, nullptr, VGT + (size_t)(head >> 2) * 64 * MPAD, ssq + 3 * (size_t)MPAD, P + qi * 128, P + 64, nt, smem, tid, dry);
  }
}

#define XB_TMO      128
#define XB_XCNT(j)  (256  + 64 * (j))
#define XB_XSUB(j)  (1280 + 64 * (j))
#define XB_XGEN(j)  (2304 + 64 * (j))
#define XB_TOP      3328
#define XB_TOPGEN   3392
#define XCD_BAR_WORDS 3456
#define XB_SPIN_CAP (1u << 18)
#define LAS __attribute__((address_space(3)))

__device__ __forceinline__ unsigned xb_ld(unsigned* p)              { return __hip_atomic_load(p, __ATOMIC_RELAXED, __HIP_MEMORY_SCOPE_AGENT); }
__device__ __forceinline__ unsigned xb_add(unsigned* p, unsigned v) { return __hip_atomic_fetch_add(p, v, __ATOMIC_RELAXED, __HIP_MEMORY_SCOPE_AGENT); }
__device__ __forceinline__ unsigned xb_xcc_id() { return (unsigned)__builtin_amdgcn_s_getreg((3 << 11) | 20) & 0xFu; }
#define XB_SPIN(cond, bar) do { unsigned _sp = 0; while (cond) { __builtin_amdgcn_s_sleep(1); \
    if ((++_sp & 255u) == 0u) { if (xb_ld(&(bar)[XB_TMO])) break; if (_sp > XB_SPIN_CAP) { atomicAdd(&(bar)[XB_TMO], 1u); break; } } } } while (0)

struct XcdBarrier {
    unsigned* bar; unsigned x;
    volatile LAS unsigned* st;
};

__device__ __forceinline__ XcdBarrier xcd_barrier_post(unsigned* bar, volatile LAS unsigned* st) {
    XcdBarrier b; b.bar = bar; b.x = xb_xcc_id(); b.st = st;
    if (threadIdx.x == 0) (void)xb_add(&bar[XB_XCNT(b.x)], 1u);
    return b;
}
__device__ __forceinline__ void xcd_barrier_complete(unsigned* bar, unsigned x, unsigned& nloc, unsigned& nx) {
    const unsigned G = gridDim.x * gridDim.y * gridDim.z;
    unsigned sum, cnt, mine, sp = 0u;
    for (;;) {
        sum = 0u; cnt = 0u; mine = 0u;
#pragma unroll
        for (unsigned j = 0; j < 16; ++j) { const unsigned c = xb_ld(&bar[XB_XCNT(j)]); sum += c; cnt += (c > 0u) ? 1u : 0u; mine = (j == x) ? c : mine; }
        if (sum == G) break;
        __builtin_amdgcn_s_sleep(1);
        if ((++sp & 255u) == 0u) { if (xb_ld(&bar[XB_TMO])) break; if (sp > XB_SPIN_CAP) { atomicAdd(&bar[XB_TMO], 1u); break; } }
    }
    nloc = mine > 0u ? mine : 1u; nx = cnt > 0u ? cnt : 1u;
}

__device__ __forceinline__ void xcd_barrier(const XcdBarrier& b) {
    asm volatile("s_waitcnt vmcnt(0)" ::: "memory");
    __syncthreads();
    if (threadIdx.x == 0) {
        unsigned* bar = b.bar;
        __builtin_amdgcn_s_waitcnt(0);
        unsigned nloc = b.st[0], nx = b.st[1];
        if (nloc == 0u) { xcd_barrier_complete(bar, b.x, nloc, nx); b.st[0] = nloc; b.st[1] = nx; }
        const unsigned old = xb_add(&bar[XB_XSUB(b.x)], 1u);
        const unsigned gen = old / nloc;
        if (old + 1u == (gen + 1u) * nloc) {
            __builtin_amdgcn_fence(__ATOMIC_RELEASE, "agent");
            asm volatile("s_waitcnt vmcnt(0)" ::: "memory");
            const unsigned og = xb_add(&bar[XB_TOP], 1u);
            const unsigned tg = og / nx;
            if (og + 1u == (tg + 1u) * nx) xb_add(&bar[XB_TOPGEN], 1u);
            else XB_SPIN(xb_ld(&bar[XB_TOPGEN]) == tg, bar);
            __builtin_amdgcn_fence(__ATOMIC_ACQUIRE, "agent");
            xb_add(&bar[XB_XGEN(b.x)], 1u);
            asm volatile("s_waitcnt vmcnt(0)" ::: "memory");
        } else {
            XB_SPIN(xb_ld(&bar[XB_XGEN(b.x)]) == gen, bar);
            __builtin_amdgcn_fence(__ATOMIC_ACQUIRE, "agent");
            asm volatile("s_waitcnt vmcnt(0)" ::: "memory");
        }
    }
    __syncthreads();
}


__global__ void __launch_bounds__(256, 2) mega(Params pin) {
  __shared__ __attribute__((aligned(16))) char smem[2 * 2 * 128 * GP * 2];
  __shared__ int s_item;
  __shared__ uint4 xb_words;
  if (threadIdx.x == 0) xb_words = make_uint4(0u, 0u, 0u, 0u);
  __syncthreads();
  XcdBarrier xb; xb.bar = nullptr; xb.x = 0u; xb.st = (volatile LAS unsigned*)&xb_words;
  bool xb_posted = false;
  const int G = gridDim.x, b = blockIdx.x;
  const int vb = ((G & 7) == 0) ? ((b & 7) * (G >> 3) + (b >> 3)) : b;
  for (int st = pin.phase_lo; st < pin.phase_hi; ++st) {
    int ph; bool dry = false;
    if (st == 0) ph = 0;
    else if (st == 41) ph = 21;
    else {
      const int u = st - 1, lay = u / 20, v = u - lay * 20, sb = v >> 1;
      dry = (v & 1) == 0;
      if (dry && !((pin.probe >> sb) & 1)) continue;
      ph = 1 + lay * 10 + sb;
    }
    if (st > pin.phase_lo) {
      if (!xb_posted) {
        cg::this_grid().sync();
        xb = xcd_barrier_post((unsigned*)(pin.ws + OFF_BAR), (volatile LAS unsigned*)&xb_words);
        xb_posted = true;
      } else xcd_barrier(xb);
    }
    Params p = pin;
    asm volatile("" : "+s"(p.xp), "+s"(p.xs), "+s"(p.meta), "+s"(p.attn_g), "+s"(p.w_in), "+s"(p.qa_g), "+s"(p.w_qb), "+s"(p.kva_g), "+s"(p.w_kvb), "+s"(p.gq_g));
    asm volatile("" : "+s"(p.gk_g), "+s"(p.mo_g), "+s"(p.go_g), "+s"(p.w_out), "+s"(p.mlp_g), "+s"(p.w_up), "+s"(p.w_dn), "+s"(p.fin_g), "+s"(p.out), "+s"(p.ws));
    int tid = threadIdx.x;
    asm volatile("" : "+v"(tid));
    const int lane = tid & 63, wave = tid >> 6, r = lane & 31;
    float* ssq = (float*)(p.ws + OFF_SSQ);
    const float2* tab = (const float2*)(p.ws + OFF_TAB);
    if (ph == 0) { phase_prep(p, tid); continue; }
    if (ph == 21) { phase_final(p, tid); continue; }
    const int layer = (ph - 1) / 10, sub = (ph - 1) % 10;
    const u16* Wl = (const u16*)(p.ws + OFF_W) + (size_t)layer * W_LAYER;
    if (sub == 0) {
      phase_norm(p, p.attn_g + layer * 1024, layer == 0, true, tid);
    } else if (sub == 1) {
      EpiIn e; e.CQ = (u16*)(p.ws + OFF_CQ); e.CKV = (u16*)(p.ws + OFF_CKV); e.QG = (u16*)(p.ws + OFF_QG); e.KG = (u16*)(p.ws + OFF_KG);
      e.VGT = (u16*)(p.ws + OFF_VGT); e.KPE = (u16*)(p.ws + OFF_KPE); e.ssq_q = ssq; e.ssq_kv = ssq + MPAD;
      e.gq_g = p.gq_g + layer * 64; e.gk_g = p.gk_g + layer * 64; e.tab = tab;
      APLin ap{(const u16*)(p.ws + OFF_HN), 1024};
      for (int t = vb; t < NTM * 12; t += G) { const int mt = t / 12, nt = t - mt * 12; gemm_tile<false>(ap, Wl + WO_IN, 1024, 1024, mt * 128, nt * 128, e, smem, 1.f, 1.f, tid, dry); }
    } else if (sub == 2) {
      EpiQB e2; e2.QM = (u16*)(p.ws + OFF_HN); e2.ssq_q = ssq; e2.tab = tab;
      EpiKVB e3; e3.KN = (u16*)(p.ws + OFF_KN); e3.VMT = (u16*)(p.ws + OFF_VMT); e3.ssq_kv = ssq + MPAD;
      APLin a2{(const u16*)(p.ws + OFF_CQ), 384};
      APLin a3{(const u16*)(p.ws + OFF_CKV), 256};
      for (int t = vb; t < NTM * 14; t += G) {
        if (t < NTM * 6) { const int mt = t / 6, nt = t - mt * 6; gemm_tile<false>(a2, Wl + WO_QB, 384, 384, mt * 128, nt * 128, e2, smem, 1.f, 1.f, tid, dry); }
        else { const int u = t - NTM * 6; const int mt = u >> 3, nt = u & 7; gemm_tile<false>(a3, Wl + WO_KVB, 256, 256, mt * 128, nt * 128, e3, smem, 1.f, 1.f, tid, dry); }
      }
    } else if (sub == 3) {
      phase_attn(p, layer, smem, &s_item, tid, dry);
    } else if (sub == 4) {
      APMix ap{(const u16*)(p.ws + OFF_HN), (const u16*)(p.ws + OFF_QG)};
      for (int t = vb; t < NTM * 8; t += G) {
        const int mt = t >> 3, nt = t & 7;
        const int g0 = mt * 128 + (wave >> 1) * 64 + r;
        const float ra0 = rsqrtf(ssq[2 * (size_t)MPAD + g0] * (1.0f / 512.0f) + EPS), rg0 = rsqrtf(ssq[3 * (size_t)MPAD + g0] * (1.0f / 512.0f) + EPS);
        const float ra1 = rsqrtf(ssq[2 * (size_t)MPAD + g0 + 32] * (1.0f / 512.0f) + EPS), rg1 = rsqrtf(ssq[3 * (size_t)MPAD + g0 + 32] * (1.0f / 512.0f) + EPS);
        EpiRes e; res_bases(p, mt, layer == 0, e.sb, e.db, e.minrow); e.fin0 = rg0; e.fin1 = rg1;
        gemm_tile<true>(ap, Wl + WO_OUT, 1024, 1024, mt * 128, nt * 128, e, smem, ra0 / rg0, ra1 / rg1, tid, dry);
      }
    } else if (sub == 5) {
      phase_norm(p, p.mlp_g + layer * 1024, false, false, tid);
    } else if (sub == 6 || sub == 8) {
      const int mh = (sub - 6) >> 1;
      EpiUp e; e.U0 = (u16*)(p.ws + OFF_U) - (size_t)mh * 259 * 128 * 4096;
      APLin ap{(const u16*)(p.ws + OFF_HN), 1024};
      for (int t = vb; t < 259 * 32; t += G) {
        int ml, nt;
        if (t < 256 * 32) { const int blk = t >> 6, w = t & 63; ml = (blk >> 2) * 8 + (w >> 3); nt = (blk & 3) * 8 + (w & 7); }
        else { ml = t >> 5; nt = t & 31; }
        gemm_tile<false>(ap, Wl + WO_UP, 1024, 1024, (mh * 259 + ml) * 128, nt * 128, e, smem, 1.f, 1.f, tid, dry);
      }
    } else {
      const int mh = (sub - 7) >> 1;
      APLin ap{(const u16*)(p.ws + OFF_U) - (size_t)mh * 259 * 128 * 4096, 4096};
      for (int t = vb; t < 259 * 8; t += G) {
        const int mt = mh * 259 + (t >> 3), nt = t & 7;
        EpiRes e; res_bases(p, mt, false, e.sb, e.db, e.minrow); e.fin0 = 1.f; e.fin1 = 1.f;
        gemm_tile<false>(ap, Wl + WO_DN, 4096, 4096, mt * 128, nt * 128, e, smem, 1.f, 1.f, tid, dry);
      }
    }
  }
}

extern "C" void kernel_launch(void* const* d_in, const int* in_sizes, int n_in, void* d_out, int out_size, void* d_ws, size_t ws_size,
                              hipStream_t stream) {
  static int grid_blocks = 0;
  if (!grid_blocks) {
    int dev = 0, cus = 0, per_cu = 0;
    hipGetDevice(&dev);
    hipDeviceGetAttribute(&cus, hipDeviceAttributeMultiprocessorCount, dev);
    hipOccupancyMaxActiveBlocksPerMultiprocessor(&per_cu, mega, 256, 0);
    if (per_cu > 2) per_cu = 2;
    if (per_cu < 1) per_cu = 1;
    grid_blocks = cus * per_cu;
  }
  Params p{};
  p.xp = (const float*)d_in[0]; p.xs = (const float*)d_in[1]; p.meta = (const float*)d_in[2];
  p.attn_g = (const float*)d_in[3]; p.w_in = (const float*)d_in[4]; p.qa_g = (const float*)d_in[5]; p.w_qb = (const float*)d_in[6];
  p.kva_g = (const float*)d_in[7]; p.w_kvb = (const float*)d_in[8]; p.gq_g = (const float*)d_in[9]; p.gk_g = (const float*)d_in[10];
  p.mo_g = (const float*)d_in[11]; p.go_g = (const float*)d_in[12]; p.w_out = (const float*)d_in[13]; p.mlp_g = (const float*)d_in[14];
  p.w_up = (const float*)d_in[15]; p.w_dn = (const float*)d_in[16]; p.fin_g = (const float*)d_in[17];
  p.out = (float*)d_out; p.ws = (char*)d_ws;
#if MK_MULTI
  for (int ph = 0; ph < 42; ++ph) {
    p.phase_lo = ph; p.phase_hi = ph + 1; p.probe = PROBE_MASK;
    if (ph > 0 && ph < 41 && ((ph - 1) & 1) == 0 && !((PROBE_MASK >> (((ph - 1) % 20) >> 1)) & 1)) continue;
    hipLaunchKernelGGL(mega, dim3(grid_blocks), dim3(256), 0, stream, p);
  }
#else
  p.phase_lo = 0; p.phase_hi = 42; p.probe = PROBE_MASK;
  void* args[] = {&p};
  hipError_t e = hipLaunchCooperativeKernel((void*)mega, dim3(grid_blocks), dim3(256), args, 0, stream);
  if (e != hipSuccess) fprintf(stderr, "cooperative launch failed: %s (grid %d)\n", hipGetErrorString(e), grid_blocks);
#endif
}
```

```cpp
#include <hip/hip_runtime.h>
#include <hip/hip_cooperative_groups.h>
#include <stdint.h>
#include <cstdio>
namespace cg = cooperative_groups;

#ifndef PROBE_MASK
#define PROBE_MASK 0
#endif
#ifndef MK_MULTI
#define MK_MULTI 0
#endif

typedef unsigned short u16;
typedef short bf16x8 __attribute__((ext_vector_type(8)));
typedef float f32x16 __attribute__((ext_vector_type(16)));
typedef unsigned u32x4 __attribute__((ext_vector_type(4)));
typedef unsigned u32x2 __attribute__((ext_vector_type(2)));
typedef float f32x2v __attribute__((ext_vector_type(2)));
typedef __bf16 bf16x2v __attribute__((ext_vector_type(2)));
#define DI __device__ __forceinline__
#define WAVE_LDS_FENCE() asm volatile("s_waitcnt lgkmcnt(0)" ::: "memory")
#define MFMA(a, b, c) __builtin_amdgcn_mfma_f32_32x32x16_bf16((a), (b), (c), 0, 0, 0)

constexpr int MPAD = 66304;
constexpr int NTM = 518;
constexpr float EPS = 1e-6f;
constexpr float LOG2E = 1.4426950408889634f;
constexpr float QSCALE_M = 0.10206207261596575f * LOG2E;
constexpr float QSCALE_G = 0.125f * LOG2E;

constexpr size_t SZ_WIN = 1536ull * 1024, SZ_WQB = 768ull * 384, SZ_WKVB = 1024ull * 256, SZ_WOUT = 1024ull * 1024,
                 SZ_WUP = 4096ull * 1024, SZ_WDN = 1024ull * 4096;
constexpr size_t WO_IN = 0, WO_QB = WO_IN + SZ_WIN, WO_KVB = WO_QB + SZ_WQB, WO_OUT = WO_KVB + SZ_WKVB, WO_UP = WO_OUT + SZ_WOUT,
                 WO_DN = WO_UP + SZ_WUP, W_LAYER = WO_DN + SZ_WDN;
constexpr size_t OFF_W = 0;
constexpr size_t OFF_TAB = OFF_W + 2 * W_LAYER * 2;
constexpr size_t OFF_XMETA = OFF_TAB + 16400ull * 16 * 8;
constexpr size_t OFF_SSQ = OFF_XMETA + 96ull * 1024 * 4;
constexpr size_t OFF_CNT = OFF_SSQ + 4ull * MPAD * 4;
constexpr size_t OFF_BAR = OFF_CNT + 1024;
constexpr size_t OFF_HN = OFF_BAR + 16384;
constexpr size_t OFF_CQ = OFF_HN + (size_t)MPAD * 1024 * 2;
constexpr size_t OFF_CKV = OFF_CQ + (size_t)MPAD * 384 * 2;
constexpr size_t OFF_KN = OFF_CKV + (size_t)MPAD * 256 * 2;
constexpr size_t OFF_KPE = OFF_KN + (size_t)MPAD * 512 * 2;
constexpr size_t OFF_VMT = OFF_KPE + (size_t)MPAD * 32 * 2;
constexpr size_t OFF_QG = OFF_VMT + (size_t)MPAD * 512 * 2;
constexpr size_t OFF_KG = OFF_QG + (size_t)MPAD * 512 * 2;
constexpr size_t OFF_VGT = OFF_KG + (size_t)MPAD * 128 * 2;
constexpr size_t OFF_END = OFF_VGT + (size_t)MPAD * 128 * 2;
constexpr size_t OFF_U = OFF_CQ;
static_assert(OFF_U + (size_t)259 * 128 * 4096 * 2 <= OFF_END, "U fits");
static_assert(OFF_END <= 536870912ull, "workspace");

struct Params {
  const float* xp; const float* xs; const float* meta;
  const float* attn_g; const float* w_in; const float* qa_g; const float* w_qb; const float* kva_g; const float* w_kvb;
  const float* gq_g; const float* gk_g; const float* mo_g; const float* go_g; const float* w_out; const float* mlp_g;
  const float* w_up; const float* w_dn; const float* fin_g;
  float* out; char* ws;
  int phase_lo, phase_hi, probe, pad_;
};

DI unsigned pack2(float a, float b) { f32x2v f = {a, b}; bf16x2v v = __builtin_convertvector(f, bf16x2v); return __builtin_bit_cast(unsigned, v); }
DI u16 f2bf(float a) { return (u16)(pack2(a, 0.f) & 0xffffu); }
DI void store4(u16* dst, float a, float b, float c, float d) { u32x2 v = {pack2(a, b), pack2(c, d)}; *(u32x2*)dst = v; }
DI int crow(int i, int h) { return (i & 3) + 8 * (i >> 2) + 4 * h; }
DI int swap23(int r) { return (r & 0x13) | ((r & 4) << 1) | ((r & 8) >> 1); }
DI float xhalf(float v) { return __shfl_xor(v, 32); }

DI void decode_tile(int T, int& seq, int& i) {
  if (T < 258) { seq = (T >= 129) ? 1 : 0; i = T - seq * 129; }
  else { int u = T - 258; int q = u / 65; seq = 2 + q; i = u - q * 65; }
}
DI int seq_base(int seq) { return seq < 2 ? seq * 16512 : 33024 + (seq - 2) * 8320; }

DI const float* xrow_src(const Params& p, int g, bool from_input) {
  int T = g >> 7, r = g & 127, seq, i; decode_tile(T, seq, i);
  if (i == 0) {
    if (r < 112) return nullptr;
    return from_input ? p.meta + (size_t)(r - 112) * 1024 : (const float*)(p.ws + OFF_XMETA) + (size_t)(seq * 16 + r - 112) * 1024;
  }
  int j = (i - 1) * 128 + r;
  if (seq < 2) { size_t row = (size_t)seq * 16384 + j; return from_input ? p.xp + row * 1024 : p.out + row * 1024; }
  size_t row = (size_t)(seq - 2) * 8192 + j;
  return from_input ? p.xs + row * 1024 : p.out + (32768 + row) * 1024;
}
DI float* xrow_dst(const Params& p, int g) {
  int T = g >> 7, r = g & 127, seq, i; decode_tile(T, seq, i);
  if (i == 0) {
    if (r < 112) return nullptr;
    return (float*)(p.ws + OFF_XMETA) + (size_t)(seq * 16 + r - 112) * 1024;
  }
  int j = (i - 1) * 128 + r;
  if (seq < 2) { size_t row = (size_t)seq * 16384 + j; return p.out + row * 1024; }
  size_t row = (size_t)(seq - 2) * 8192 + j;
  return p.out + (32768 + row) * 1024;
}

DI int mapcol(int kind, int n) {
  if (kind == 1) { if (n < 640) return n; if (n < 1408) return n + 32; if (n < 1440) return 640 + (n - 1408); return -1; }
  if (kind == 2) { if (n < 512) return (n >> 6) * 96 + (n & 63); int m = n - 512; return (m >> 5) * 96 + 64 + (m & 31); }
  if (kind == 3) { if (n < 512) return (n >> 6) * 128 + (n & 63); int m = n - 512; return (m >> 6) * 128 + 64 + (m & 63); }
  return n;
}
DI void prep_weight(const float* __restrict__ src, int Nsrc, u16* __restrict__ dst, int Nout, int K, const float* gA, const float* gB,
                    int ksplit, int kind, int gtid, int gthreads) {
  const int total = Nout * (K >> 3);
  for (int u = gtid; u < total; u += gthreads) {
    const int n = u % Nout, kc = u / Nout;
    const int col = mapcol(kind, n);
    const int k = kc * 8;
    float v[8];
#pragma unroll
    for (int j = 0; j < 8; ++j) {
      float x = 0.f;
      if (col >= 0) {
        x = src[(size_t)(k + j) * Nsrc + col];
        if (gA) x *= (k + j < ksplit) ? gA[k + j] : gB[k + j - ksplit];
      }
      v[j] = x;
    }
    u32x4 o = {pack2(v[0], v[1]), pack2(v[2], v[3]), pack2(v[4], v[5]), pack2(v[6], v[7])};
    *(u32x4*)(dst + (size_t)n * K + k) = o;
  }
}

DI void phase_prep(const Params& p, int tid) {
  const int gtid = blockIdx.x * 256 + tid, gthreads = gridDim.x * 256;
  u16* W = (u16*)(p.ws + OFF_W);
  for (int l = 0; l < 2; ++l) {
    u16* Wl = W + (size_t)l * W_LAYER;
    prep_weight(p.w_in + (size_t)l * 1024 * 1440, 1440, Wl + WO_IN, 1536, 1024, nullptr, nullptr, 0, 1, gtid, gthreads);
    prep_weight(p.w_qb + (size_t)l * 384 * 768, 768, Wl + WO_QB, 768, 384, p.qa_g + l * 384, p.qa_g + l * 384, 384, 2, gtid, gthreads);
    prep_weight(p.w_kvb + (size_t)l * 256 * 1024, 1024, Wl + WO_KVB, 1024, 256, p.kva_g + l * 256, p.kva_g + l * 256, 256, 3, gtid, gthreads);
    prep_weight(p.w_out + (size_t)l * 1024 * 1024, 1024, Wl + WO_OUT, 1024, 1024, p.mo_g + l * 512, p.go_g + l * 512, 512, 0, gtid, gthreads);
    prep_weight(p.w_up + (size_t)l * 1024 * 4096, 4096, Wl + WO_UP, 4096, 1024, nullptr, nullptr, 0, 0, gtid, gthreads);
    prep_weight(p.w_dn + (size_t)l * 4096 * 1024, 1024, Wl + WO_DN, 1024, 4096, nullptr, nullptr, 0, 0, gtid, gthreads);
  }
  float2* tab = (float2*)(p.ws + OFF_TAB);
  for (int u = gtid; u < 16400 * 16; u += gthreads) {
    const int pos = u >> 4, f = u & 15;
    const float invf = 1.0f / powf(10000.0f, (float)(2 * f) / 32.0f);
    const float ang = (float)pos * invf;
    const double rev = (double)ang * 0.15915494309189535;
    const double fr = rev - rint(rev);
    const float x = (float)(2.0 * fr);
    tab[u] = make_float2(cospif(x), sinpif(x));
  }
  float* xm = (float*)(p.ws + OFF_XMETA);
  for (int u = gtid; u < 96 * 1024; u += gthreads) xm[u] = p.meta[u & 16383];
  int* cnt = (int*)(p.ws + OFF_CNT);
  if (gtid < 64) cnt[gtid] = 0;
  unsigned* bar = (unsigned*)(p.ws + OFF_BAR);
  if (gtid < 4096) bar[gtid] = 0u;
}

DI void phase_norm(const Params& p, const float* __restrict__ gain, bool from_input, bool zero_ssq, int tid) {
  const int lane = tid & 63;
  const int gw = blockIdx.x * 4 + (tid >> 6), nw = gridDim.x * 4;
  u16* HN = (u16*)(p.ws + OFF_HN);
  float* ssq = (float*)(p.ws + OFF_SSQ);
  for (int g = gw; g < MPAD; g += nw) {
    const float* xr = xrow_src(p, g, from_input);
    u16* hr = HN + (size_t)g * 1024;
    if (!xr) {
      u32x4 z = {0u, 0u, 0u, 0u};
      *(u32x4*)(hr + lane * 16) = z;
      *(u32x4*)(hr + lane * 16 + 8) = z;
    } else {
      float4 v[4];
#pragma unroll
      for (int q = 0; q < 4; ++q) v[q] = ((const float4*)xr)[lane + 64 * q];
      float ss = 0.f;
#pragma unroll
      for (int q = 0; q < 4; ++q) ss += v[q].x * v[q].x + v[q].y * v[q].y + v[q].z * v[q].z + v[q].w * v[q].w;
#pragma unroll
      for (int o = 32; o >= 1; o >>= 1) ss += __shfl_xor(ss, o);
      const float rstd = rsqrtf(ss * (1.0f / 1024.0f) + EPS);
#pragma unroll
      for (int q = 0; q < 4; ++q) {
        const float4 gg = ((const float4*)gain)[lane + 64 * q];
        store4(hr + 4 * (lane + 64 * q), v[q].x * rstd * gg.x, v[q].y * rstd * gg.y, v[q].z * rstd * gg.z, v[q].w * rstd * gg.w);
      }
    }
    if (zero_ssq && lane < 4) ssq[(size_t)lane * MPAD + g] = 0.f;
  }
}

DI void phase_final(const Params& p, int tid) {
  const int lane = tid & 63;
  const int gw = blockIdx.x * 4 + (tid >> 6), nw = gridDim.x * 4;
  for (int g = gw; g < MPAD; g += nw) {
    if (((g >> 7) == 0) || ((g >> 7) == 129) || ((g >> 7) >= 258 && ((g >> 7) - 258) % 65 == 0)) continue;
    float* xr = xrow_dst(p, g);
    float4 v[4];
#pragma unroll
    for (int q = 0; q < 4; ++q) v[q] = ((const float4*)xr)[lane + 64 * q];
    float ss = 0.f;
#pragma unroll
    for (int q = 0; q < 4; ++q) ss += v[q].x * v[q].x + v[q].y * v[q].y + v[q].z * v[q].z + v[q].w * v[q].w;
#pragma unroll
    for (int o = 32; o >= 1; o >>= 1) ss += __shfl_xor(ss, o);
    const float rstd = rsqrtf(ss * (1.0f / 1024.0f) + EPS);
#pragma unroll
    for (int q = 0; q < 4; ++q) {
      const float4 gg = ((const float4*)p.fin_g)[lane + 64 * q];
      float4 o = make_float4(v[q].x * rstd * gg.x, v[q].y * rstd * gg.y, v[q].z * rstd * gg.z, v[q].w * rstd * gg.w);
      ((float4*)xr)[lane + 64 * q] = o;
    }
  }
}

constexpr int GP = 72;
struct APLin { const u16* A; int lda; DI const u16* ptr(int row, int k0) const { return A + (size_t)row * lda + k0; } };
struct APMix { const u16* QM; const u16* QG;
  DI const u16* ptr(int row, int k0) const { return k0 < 512 ? QM + (size_t)row * 768 + (k0 >> 6) * 96 : QG + (size_t)row * 512 + (k0 - 512); } };

template <bool MIDK, class AP, class EPI>
DI void gemm_tile(const AP& ap, const u16* __restrict__ W, int ldw, int K, int m0, int n0, const EPI& epi, char* smem, float r0, float r1, int tid, bool dry) {
  constexpr int SBUF = 2 * 128 * GP;
  u16* sA = (u16*)smem;
  u16* sB = sA + 128 * GP;
  const int lane = tid & 63, wave = tid >> 6, r = lane & 31, h = lane >> 5, wm = wave >> 1, wn = wave & 1;
  const int lrow = tid >> 3, lkc = (tid & 7) * 8;
  u32x4 ra0[4], rb0[4], ra1[4], rb1[4];
  f32x16 acc[2][2];
#pragma unroll
  for (int a = 0; a < 2; ++a)
#pragma unroll
    for (int b = 0; b < 2; ++b)
#pragma unroll
      for (int i = 0; i < 16; ++i) acc[a][b][i] = 0.f;
  const int nk = K >> 6;
#define GLOADQ(RA, RB, KT, q) do { const int k0_ = (KT) << 6; \
    RA[q] = *(const u32x4*)(ap.ptr(m0 + lrow + 32 * (q), k0_) + lkc); RB[q] = *(const u32x4*)(W + (size_t)(n0 + lrow + 32 * (q)) * ldw + k0_ + lkc); } while (0)
#define GLOAD(RA, RB, KT) do { GLOADQ(RA, RB, KT, 0); GLOADQ(RA, RB, KT, 1); GLOADQ(RA, RB, KT, 2); GLOADQ(RA, RB, KT, 3); } while (0)
#define SSTOREQ(RA, RB, ST, q) do { \
    *(u32x4*)(sA + (ST) * SBUF + (lrow + 32 * (q)) * GP + lkc) = RA[q]; *(u32x4*)(sB + (ST) * SBUF + (lrow + 32 * (q)) * GP + lkc) = RB[q]; } while (0)
#define SSTORE(RA, RB, ST) do { SSTOREQ(RA, RB, ST, 0); SSTOREQ(RA, RB, ST, 1); SSTOREQ(RA, RB, ST, 2); SSTOREQ(RA, RB, ST, 3); } while (0)
#define FLOAD(F, ST, ks) do { _Pragma("unroll") for (int a = 0; a < 2; ++a) { \
    F[a] = *(const bf16x8*)(sB + (ST) * SBUF + (wn * 64 + a * 32 + r) * GP + (ks) * 16 + h * 8); \
    F[2 + a] = *(const bf16x8*)(sA + (ST) * SBUF + (wm * 64 + a * 32 + r) * GP + (ks) * 16 + h * 8); } } while (0)
#define FMMA(F) do { _Pragma("unroll") for (int a = 0; a < 2; ++a) _Pragma("unroll") for (int b = 0; b < 2; ++b) acc[a][b] = MFMA(F[a], F[2 + b], acc[a][b]); } while (0)
  bf16x8 f0[4], f1[4];
  GLOAD(ra0, rb0, 0);
  GLOAD(ra1, rb1, 1);
  __syncthreads();
  SSTORE(ra0, rb0, 0);
  if (nk > 2) GLOAD(ra0, rb0, 2);
  __syncthreads();
  for (int kt = 0; kt < nk; kt += 2) {
    const bool l3 = kt + 3 < nk, s2 = kt + 2 < nk, l4 = kt + 4 < nk;
    FLOAD(f0, 0, 0); FLOAD(f1, 0, 1);
    FMMA(f0); SSTOREQ(ra1, rb1, 1, 0); if (l3) GLOADQ(ra1, rb1, kt + 3, 0);
    FLOAD(f0, 0, 2);
    FMMA(f1); SSTOREQ(ra1, rb1, 1, 1); if (l3) GLOADQ(ra1, rb1, kt + 3, 1);
    FLOAD(f1, 0, 3);
    FMMA(f0); SSTOREQ(ra1, rb1, 1, 2); if (l3) GLOADQ(ra1, rb1, kt + 3, 2);
    FMMA(f1); SSTOREQ(ra1, rb1, 1, 3); if (l3) GLOADQ(ra1, rb1, kt + 3, 3);
    __syncthreads();
    FLOAD(f0, 1, 0); FLOAD(f1, 1, 1);
    FMMA(f0); if (s2) SSTOREQ(ra0, rb0, 0, 0); if (l4) GLOADQ(ra0, rb0, kt + 4, 0);
    FLOAD(f0, 1, 2);
    FMMA(f1); if (s2) SSTOREQ(ra0, rb0, 0, 1); if (l4) GLOADQ(ra0, rb0, kt + 4, 1);
    FLOAD(f1, 1, 3);
    FMMA(f0); if (s2) SSTOREQ(ra0, rb0, 0, 2); if (l4) GLOADQ(ra0, rb0, kt + 4, 2);
    FMMA(f1); if (s2) SSTOREQ(ra0, rb0, 0, 3); if (l4) GLOADQ(ra0, rb0, kt + 4, 3);
    if (MIDK && kt == 6) {
#pragma unroll
      for (int a = 0; a < 2; ++a)
#pragma unroll
        for (int i = 0; i < 16; ++i) { acc[a][0][i] *= r0; acc[a][1][i] *= r1; }
    }
    __syncthreads();
  }
#undef GLOADQ
#undef SSTOREQ
#undef FLOAD
#undef FMMA
#undef GLOAD
#undef SSTORE
  if (!dry) epi(acc, n0 + wn * 64, m0 + wm * 64, lane, (u16*)smem + wave * 64 * GP);
}

struct ColId { DI int operator()(int ch) const { return ch * 8; } };
struct ColRope { DI int operator()(int ch) const { return (ch >> 2) * 96 + (ch & 3) * 8; } };

template <class COLF>
DI void stage_store(f32x16 (&acc)[2][2], u16* wl, int lane, u16* dst0, size_t pitch, const COLF& colf) {
  const int r = lane & 31, h = lane >> 5;
#pragma unroll
  for (int rb = 0; rb < 2; ++rb)
#pragma unroll
    for (int lb = 0; lb < 2; ++lb)
#pragma unroll
      for (int g4 = 0; g4 < 4; ++g4)
        store4(wl + (lb * 32 + r) * GP + rb * 32 + 8 * g4 + 4 * h, acc[rb][lb][4 * g4], acc[rb][lb][4 * g4 + 1], acc[rb][lb][4 * g4 + 2], acc[rb][lb][4 * g4 + 3]);
  WAVE_LDS_FENCE();
#pragma unroll
  for (int it = 0; it < 8; ++it) {
    const int row = it * 8 + (lane >> 3), ch = lane & 7;
    const u32x4 v = *(const u32x4*)(wl + row * GP + ch * 8);
    *(u32x4*)(dst0 + (size_t)row * pitch + colf(ch)) = v;
  }
  WAVE_LDS_FENCE();
}

DI void rope16(float (&v)[16], const float2* __restrict__ tabrow, int h) {
#pragma unroll
  for (int i = 0; i < 8; ++i) {
    const int f = (i & 3) + 8 * (i >> 2) + 4 * h;
    const float2 cs = tabrow[f];
    const float x1 = v[i], x2 = v[i + 8];
    v[i] = x1 * cs.x - x2 * cs.y;
    v[i + 8] = x2 * cs.x + x1 * cs.y;
  }
}

struct EpiIn {
  u16 *CQ, *CKV, *QG, *KG, *VGT, *KPE; float *ssq_q, *ssq_kv; const float *gq_g, *gk_g; const float2* tab;
  DI void operator()(f32x16 (&acc)[2][2], int nb, int mb, int lane, u16* wl) const {
    const int r = lane & 31, h = lane >> 5;
    int seq, it; decode_tile(mb >> 7, seq, it);
#pragma unroll
    for (int ti = 0; ti < 2; ++ti) {
      const int g = mb + ti * 32 + r, rr = g & 127;
      if (nb < 640) {
        float ss = 0.f;
#pragma unroll
        for (int fi = 0; fi < 2; ++fi)
#pragma unroll
          for (int i = 0; i < 16; ++i) ss += acc[fi][ti][i] * acc[fi][ti][i];
        ss += xhalf(ss);
        if (h == 0) unsafeAtomicAdd((nb < 384 ? ssq_q : ssq_kv) + g, ss);
      } else if (nb < 1280) {
        const bool isq = nb < 1152;
        const float* gg = isq ? gq_g : gk_g;
        float ss = 0.f;
#pragma unroll
        for (int fi = 0; fi < 2; ++fi)
#pragma unroll
          for (int i = 0; i < 16; ++i) ss += acc[fi][ti][i] * acc[fi][ti][i];
        ss += xhalf(ss);
        const float rstd = rsqrtf(ss * (1.0f / 64.0f) + EPS);
        const float osc = isq ? QSCALE_G : 1.0f;
        int prow = 0, pcol = 0;
        if (it > 0) { const int j = (it - 1) * 128 + rr; prow = j >> 6; pcol = j & 63; }
        u16* dst = isq ? QG + (size_t)g * 512 + (nb - 640) : KG + (size_t)g * 128 + (nb - 1152);
#pragma unroll
        for (int fi = 0; fi < 2; ++fi) {
          const int pos = fi == 0 ? prow : pcol;
          float v[16];
#pragma unroll
          for (int i = 0; i < 16; ++i) v[i] = acc[fi][ti][i] * rstd * gg[fi * 32 + crow(i, h)];
          rope16(v, tab + pos * 16, h);
#pragma unroll
          for (int g4 = 0; g4 < 4; ++g4)
            store4(dst + fi * 32 + 8 * g4 + 4 * h, v[4 * g4] * osc, v[4 * g4 + 1] * osc, v[4 * g4 + 2] * osc, v[4 * g4 + 3] * osc);
        }
      } else if (nb < 1408) {
#pragma unroll
        for (int fi = 0; fi < 2; ++fi)
#pragma unroll
          for (int i = 0; i < 16; ++i) VGT[(size_t)(nb - 1280 + fi * 32 + crow(i, h)) * MPAD + g] = f2bf(acc[fi][ti][i]);
      } else if (nb == 1408) {
        int pos = 128 * it + rr - 112; pos = pos < 0 ? 0 : pos;
        float v[16];
#pragma unroll
        for (int i = 0; i < 16; ++i) v[i] = acc[0][ti][i];
        rope16(v, tab + pos * 16, h);
#pragma unroll
        for (int g4 = 0; g4 < 4; ++g4) store4(KPE + (size_t)g * 32 + 8 * g4 + 4 * h, v[4 * g4], v[4 * g4 + 1], v[4 * g4 + 2], v[4 * g4 + 3]);
      }
    }
    if (nb < 384) stage_store(acc, wl, lane, CQ + (size_t)mb * 384 + nb, 384, ColId());
    else if (nb < 640) stage_store(acc, wl, lane, CKV + (size_t)mb * 256 + (nb - 384), 256, ColId());
  }
};

struct EpiQB {
  u16* QM; const float* ssq_q; const float2* tab;
  DI void operator()(f32x16 (&acc)[2][2], int nb, int mb, int lane, u16* wl) const {
    const int r = lane & 31, h = lane >> 5;
    int seq, it; decode_tile(mb >> 7, seq, it);
#pragma unroll
    for (int ti = 0; ti < 2; ++ti) {
      const int g = mb + ti * 32 + r, rr = g & 127;
      const float sc = rsqrtf(ssq_q[g] * (1.0f / 384.0f) + EPS) * QSCALE_M;
      if (nb < 512) {
#pragma unroll
        for (int fi = 0; fi < 2; ++fi)
#pragma unroll
          for (int i = 0; i < 16; ++i) acc[fi][ti][i] *= sc;
      } else {
        int pos = 128 * it + rr - 112; pos = pos < 0 ? 0 : pos;
#pragma unroll
        for (int fi = 0; fi < 2; ++fi) {
          float v[16];
#pragma unroll
          for (int i = 0; i < 16; ++i) v[i] = acc[fi][ti][i] * sc;
          rope16(v, tab + pos * 16, h);
#pragma unroll
          for (int i = 0; i < 16; ++i) acc[fi][ti][i] = v[i];
        }
      }
    }
    if (nb < 512) stage_store(acc, wl, lane, QM + (size_t)mb * 768 + (nb >> 6) * 96, 768, ColId());
    else stage_store(acc, wl, lane, QM + (size_t)mb * 768 + ((nb - 512) >> 5) * 96 + 64, 768, ColRope());
  }
};

struct EpiKVB {
  u16 *KN, *VMT; const float* ssq_kv;
  DI void operator()(f32x16 (&acc)[2][2], int nb, int mb, int lane, u16* wl) const {
    const int r = lane & 31, h = lane >> 5;
#pragma unroll
    for (int ti = 0; ti < 2; ++ti) {
      const int g = mb + ti * 32 + r;
      const float sc = rsqrtf(ssq_kv[g] * (1.0f / 256.0f) + EPS);
      if (nb < 512) {
#pragma unroll
        for (int fi = 0; fi < 2; ++fi)
#pragma unroll
          for (int i = 0; i < 16; ++i) acc[fi][ti][i] *= sc;
      } else {
#pragma unroll
        for (int fi = 0; fi < 2; ++fi)
#pragma unroll
          for (int i = 0; i < 16; ++i) VMT[(size_t)(nb - 512 + fi * 32 + crow(i, h)) * MPAD + g] = f2bf(acc[fi][ti][i] * sc);
      }
    }
    if (nb < 512) stage_store(acc, wl, lane, KN + (size_t)mb * 512 + nb, 512, ColId());
  }
};

DI void res_bases(const Params& p, int mt, bool from_input, const float*& sb, float*& db, int& minrow) {
  int seq, it; decode_tile(mt, seq, it);
  float* xm = (float*)(p.ws + OFF_XMETA);
  if (it == 0) {
    minrow = 112;
    db = xm + ((ptrdiff_t)seq * 16 - 112) * 1024;
    sb = from_input ? p.meta - 112 * 1024 : db;
  } else {
    minrow = 0;
    const size_t row = seq < 2 ? (size_t)seq * 16384 + (size_t)(it - 1) * 128 : 32768 + (size_t)(seq - 2) * 8192 + (size_t)(it - 1) * 128;
    db = p.out + row * 1024;
    sb = from_input ? (seq < 2 ? p.xp + row * 1024 : p.xs + (row - 32768) * 1024) : db;
  }
}

struct EpiRes {
  const float* sb; float* db; int minrow; float fin0, fin1;
  DI void operator()(f32x16 (&acc)[2][2], int nb, int mb, int lane, u16* wl) const {
    const int r = lane & 31, h = lane >> 5, mbl = mb & 127;
    float* wf = (float*)wl;
#pragma unroll
    for (int fi = 0; fi < 2; ++fi) {
#pragma unroll
      for (int ti = 0; ti < 2; ++ti) {
        const float sc = ti == 0 ? fin0 : fin1;
#pragma unroll
        for (int g4 = 0; g4 < 4; ++g4) {
          float4 o = make_float4(acc[fi][ti][4 * g4] * sc, acc[fi][ti][4 * g4 + 1] * sc, acc[fi][ti][4 * g4 + 2] * sc, acc[fi][ti][4 * g4 + 3] * sc);
          *(float4*)(wf + (ti * 32 + r) * 36 + 8 * g4 + 4 * h) = o;
        }
      }
      WAVE_LDS_FENCE();
#pragma unroll
      for (int it = 0; it < 8; ++it) {
        const int row = it * 8 + (lane >> 3), ch = lane & 7;
        const float4 a = *(const float4*)(wf + row * 36 + ch * 4);
        const int trow = mbl + row;
        if (trow >= minrow) {
          const size_t off = (size_t)trow * 1024 + nb + fi * 32 + ch * 4;
          float4 x = *(const float4*)(sb + off);
          x.x += a.x; x.y += a.y; x.z += a.z; x.w += a.w;
          *(float4*)(db + off) = x;
        }
      }
      WAVE_LDS_FENCE();
    }
  }
};

struct EpiUp {
  u16* U0;
  DI void operator()(f32x16 (&acc)[2][2], int nb, int mb, int lane, u16* wl) const {
#pragma unroll
    for (int ti = 0; ti < 2; ++ti)
#pragma unroll
      for (int fi = 0; fi < 2; ++fi)
#pragma unroll
        for (int i = 0; i < 16; ++i) { const float a = fmaxf(acc[fi][ti][i], 0.f); acc[fi][ti][i] = a * a; }
    stage_store(acc, wl, lane, U0 + (size_t)mb * 4096 + nb, 4096, ColId());
  }
};

constexpr float ATT_THR = 8.0f;

template <int DQK>
struct AttnCtx {
  static constexpr int KP = DQK + 8, NKS = DQK / 16, KCH = DQK / 8, NKL = 64 * KCH / 256, KBUF = 64 * KP, VBUF = 64 * GP;
  const u16 *Kb, *KPEb, *Vt; int kpitch, rowk0, nt, tid, r, h, sr;
  u16 *sK, *sV;
  bf16x8 qf[NKS], kone, qm;
  f32x16 o[2];
  float mref, l;
  u32x4 rk[NKL], rv[2];

  int koff[NKL], voff[2];
  DI void init_offs() {
#pragma unroll
    for (int q = 0; q < NKL; ++q) {
      const int c = tid + 256 * q, row = c / KCH, cc = c % KCH;
      koff[q] = (DQK == 96 && cc >= 8) ? row * 32 + (cc - 8) * 8 : row * kpitch + cc * 8;
    }
#pragma unroll
    for (int q = 0; q < 2; ++q) { const int c = tid + 256 * q, dv = c >> 3, kc = c & 7; voff[q] = dv * MPAD + kc * 8; }
  }
  DI void gload_k(int t) {
    const int row0 = rowk0 + t * 64;
    const u16* kt = Kb + (size_t)row0 * kpitch;
    const u16* pt = KPEb + (size_t)row0 * 32;
#pragma unroll
    for (int q = 0; q < NKL; ++q) {
      const int c = tid + 256 * q, cc = c % KCH;
      rk[q] = *(const u32x4*)(((DQK == 96 && cc >= 8) ? pt : kt) + koff[q]);
    }
  }
  DI void gload_v(int t) {
    const u16* vt = Vt + (rowk0 + t * 64);
#pragma unroll
    for (int q = 0; q < 2; ++q) rv[q] = *(const u32x4*)(vt + voff[q]);
  }
  DI void sstore_k(int buf) {
#pragma unroll
    for (int q = 0; q < NKL; ++q) {
      const int c = tid + 256 * q, row = c / KCH, cc = c % KCH;
      *(u32x4*)(sK + buf * KBUF + row * KP + cc * 8) = rk[q];
    }
  }
  DI void sstore_v(int buf) {
#pragma unroll
    for (int q = 0; q < 2; ++q) {
      const int c = tid + 256 * q, dv = c >> 3, kc = c & 7;
      *(u32x4*)(sV + buf * VBUF + dv * GP + kc * 8) = rv[q];
    }
  }
  DI void qk(int buf, f32x16 (&s)[2]) {
    const u16* kb = sK + buf * KBUF + sr * KP + h * 8;
#pragma unroll
    for (int kb2 = 0; kb2 < 2; ++kb2)
#pragma unroll
      for (int i = 0; i < 16; ++i) s[kb2][i] = 0.f;
#pragma unroll
    for (int ks = 0; ks < NKS; ++ks)
#pragma unroll
      for (int kb2 = 0; kb2 < 2; ++kb2) {
        const bf16x8 a = *(const bf16x8*)(kb + kb2 * 32 * KP + ks * 16);
        s[kb2] = MFMA(a, qf[ks], s[kb2]);
      }
    s[0] = MFMA(kone, qm, s[0]);
    s[1] = MFMA(kone, qm, s[1]);
  }
  template <int PAR>
  DI void step(int t, f32x16 (&cur)[2], f32x16 (&nxt)[2]) {
    if (t + 1 < nt) sstore_k(PAR ^ 1);
    if (t > 0) sstore_v(PAR);
    __syncthreads();
    if (t + 1 < nt) qk(PAR ^ 1, nxt);
    float mx = fmaxf(cur[0][0], cur[1][0]);
#pragma unroll
    for (int i = 1; i < 16; ++i) mx = fmaxf(fmaxf(cur[0][i], cur[1][i]), mx);
    if (__builtin_amdgcn_ballot_w64(mx > ATT_THR) != 0ull) {
      asm volatile("" ::: "memory");
      mx = fmaxf(mx, xhalf(mx));
      const float want = mref + fmaxf(mx, 0.f);
      const float mn = __uint_as_float(pack2(want, 0.f) << 16);
      const float d = mn - mref;
      const float alpha = __builtin_amdgcn_exp2f(-d);
      mref = mn;
      l *= alpha;
#pragma unroll
      for (int a = 0; a < 2; ++a)
#pragma unroll
        for (int i = 0; i < 16; ++i) { o[a][i] *= alpha; cur[a][i] -= d; nxt[a][i] -= d; }
      u32x4 q4 = {h == 0 ? (pack2(-mn, 0.f) & 0xffffu) : 0u, 0u, 0u, 0u};
      qm = __builtin_bit_cast(bf16x8, q4);
    }
    float psum = 0.f;
#pragma unroll
    for (int kb2 = 0; kb2 < 2; ++kb2)
#pragma unroll
      for (int i = 0; i < 16; ++i) { const float pv = __builtin_amdgcn_exp2f(cur[kb2][i]); cur[kb2][i] = pv; psum += pv; }
    l += psum;
    if (t + 2 < nt) gload_k(t + 2);
    if (t + 1 < nt) gload_v(t + 1);
    const u16* vb = sV + PAR * VBUF + r * GP + h * 8;
#pragma unroll
    for (int kb2 = 0; kb2 < 2; ++kb2)
#pragma unroll
      for (int s2 = 0; s2 < 2; ++s2) {
        u32x4 pk = {pack2(cur[kb2][8 * s2], cur[kb2][8 * s2 + 1]), pack2(cur[kb2][8 * s2 + 2], cur[kb2][8 * s2 + 3]),
                    pack2(cur[kb2][8 * s2 + 4], cur[kb2][8 * s2 + 5]), pack2(cur[kb2][8 * s2 + 6], cur[kb2][8 * s2 + 7])};
        const bf16x8 pf = __builtin_bit_cast(bf16x8, pk);
#pragma unroll
        for (int db = 0; db < 2; ++db) {
          const bf16x8 a = *(const bf16x8*)(vb + db * 32 * GP + kb2 * 32 + s2 * 16);
          o[db] = MFMA(a, pf, o[db]);
        }
      }
  }
};

template <int DQK>
DI void attn_item(const u16* __restrict__ Qb, int qpitch, const u16* __restrict__ Kb, int kpitch, const u16* __restrict__ KPEb,
                  const u16* __restrict__ Vt, float* __restrict__ ssq, int rowq0, int rowk0, int nt, char* smem, int tid, bool dry) {
  typedef AttnCtx<DQK> C;
  C c;
  const int lane = tid & 63, wave = tid >> 6, r = lane & 31, h = lane >> 5;
  c.Kb = Kb; c.KPEb = KPEb; c.Vt = Vt; c.kpitch = kpitch; c.rowk0 = rowk0; c.nt = nt; c.tid = tid; c.r = r; c.h = h; c.sr = swap23(r);
  c.sK = (u16*)smem; c.sV = c.sK + 2 * C::KBUF;
  c.init_offs();
  const int myrow = rowq0 + wave * 32 + r;
  {
    const u16* qrow = Qb + (size_t)myrow * qpitch + h * 8;
#pragma unroll
    for (int ks = 0; ks < C::NKS; ++ks) c.qf[ks] = *(const bf16x8*)(qrow + ks * 16);
  }
#pragma unroll
  for (int a = 0; a < 2; ++a)
#pragma unroll
    for (int i = 0; i < 16; ++i) c.o[a][i] = 0.f;
  c.mref = 0.f; c.l = 0.f;
  {
    u32x4 k1 = {h == 0 ? 0x3F80u : 0u, 0u, 0u, 0u}, z4 = {0u, 0u, 0u, 0u};
    c.kone = __builtin_bit_cast(bf16x8, k1); c.qm = __builtin_bit_cast(bf16x8, z4);
  }
  f32x16 sa[2], sb[2];
  c.gload_k(0); c.gload_v(0);
  __syncthreads();
  c.sstore_k(0); c.sstore_v(0);
  if (nt > 1) c.gload_k(1);
  __syncthreads();
  c.qk(0, sa);
#pragma unroll
  for (int i = 0; i < 16; ++i) {
    sa[0][i] = -1e30f;
    if (swap23(crow(i, h)) < 16) sa[1][i] = -1e30f;
  }
  int t = 0;
  for (; t + 1 < nt; t += 2) {
    c.template step<0>(t, sa, sb);
    c.template step<1>(t + 1, sb, sa);
  }
  if (t < nt) c.template step<0>(t, sa, sb);
  if (dry) return;
  float l = c.l;
  l += xhalf(l);
  const float inv = 1.0f / l;
  float ss = 0.f;
  u16* orow = (u16*)Qb + (size_t)myrow * qpitch;
#pragma unroll
  for (int db = 0; db < 2; ++db)
#pragma unroll
    for (int g4 = 0; g4 < 4; ++g4) {
      const float a0 = c.o[db][4 * g4] * inv, a1 = c.o[db][4 * g4 + 1] * inv, a2 = c.o[db][4 * g4 + 2] * inv, a3 = c.o[db][4 * g4 + 3] * inv;
      ss += a0 * a0 + a1 * a1 + a2 * a2 + a3 * a3;
      store4(orow + db * 32 + 8 * g4 + 4 * h, a0, a1, a2, a3);
    }
  ss += xhalf(ss);
  if (h == 0) unsafeAtomicAdd(ssq + myrow, ss);
}

constexpr int N_ITEMS = 8288;
DI void phase_attn(const Params& p, int layer, char* smem, int* s_item, int tid, bool dry) {
  int* cnt = (int*)(p.ws + OFF_CNT) + layer + (dry ? 2 : 0);
  u16* QM = (u16*)(p.ws + OFF_HN);
  const u16* KN = (const u16*)(p.ws + OFF_KN);
  const u16* KPE = (const u16*)(p.ws + OFF_KPE);
  const u16* VMT = (const u16*)(p.ws + OFF_VMT);
  u16* QG = (u16*)(p.ws + OFF_QG);
  const u16* KG = (const u16*)(p.ws + OFF_KG);
  const u16* VGT = (const u16*)(p.ws + OFF_VGT);
  float* ssq = (float*)(p.ws + OFF_SSQ);
  for (;;) {
    if (tid == 0) *s_item = atomicAdd(cnt, 1);
    __syncthreads();
    const int it = *s_item;
    __syncthreads();
    if (it >= N_ITEMS) break;
    int grp, seq, head, qi, nt;
    if (it < 4128) { grp = it / 2064; const int u = it - grp * 2064; const int sh = u / 129; qi = u - sh * 129; seq = sh >> 3; head = sh & 7; nt = 257; }
    else { const int u0 = it - 4128; grp = u0 / 2080; const int u = u0 - grp * 2080; const int sh = u / 65; qi = u - sh * 65; seq = 2 + (sh >> 3); head = sh & 7; nt = 129; }
    const int P = seq_base(seq);
    if (grp == 0)
      attn_item<96>(QM + head * 96, 768, KN + head * 64, 512, KPE, VMT + (size_t)head * 64 * MPAD, ssq + 2 * (size_t)MPAD, P + qi * 128, P + 64, nt, smem, tid, dry);
    else
      attn_item<64>(QG + head * 64, 512, KG + (head >> 2) * 64, 128, nullptr, VGT + (size_t)(head >> 2) * 64 * MPAD, ssq + 3 * (size_t)MPAD, P + qi * 128, P + 64, nt, smem, tid, dry);
  }
}

#define XB_TMO      128
#define XB_XCNT(j)  (256  + 64 * (j))
#define XB_XSUB(j)  (1280 + 64 * (j))
#define XB_XGEN(j)  (2304 + 64 * (j))
#define XB_TOP      3328
#define XB_TOPGEN   3392
#define XCD_BAR_WORDS 3456
#define XB_SPIN_CAP (1u << 18)
#define LAS __attribute__((address_space(3)))

__device__ __forceinline__ unsigned xb_ld(unsigned* p)              { return __hip_atomic_load(p, __ATOMIC_RELAXED, __HIP_MEMORY_SCOPE_AGENT); }
__device__ __forceinline__ unsigned xb_add(unsigned* p, unsigned v) { return __hip_atomic_fetch_add(p, v, __ATOMIC_RELAXED, __HIP_MEMORY_SCOPE_AGENT); }
__device__ __forceinline__ unsigned xb_xcc_id() { return (unsigned)__builtin_amdgcn_s_getreg((3 << 11) | 20) & 0xFu; }
#define XB_SPIN(cond, bar) do { unsigned _sp = 0; while (cond) { __builtin_amdgcn_s_sleep(1); \
    if ((++_sp & 255u) == 0u) { if (xb_ld(&(bar)[XB_TMO])) break; if (_sp > XB_SPIN_CAP) { atomicAdd(&(bar)[XB_TMO], 1u); break; } } } } while (0)

struct XcdBarrier {
    unsigned* bar; unsigned x;
    volatile LAS unsigned* st;
};

__device__ __forceinline__ XcdBarrier xcd_barrier_post(unsigned* bar, volatile LAS unsigned* st) {
    XcdBarrier b; b.bar = bar; b.x = xb_xcc_id(); b.st = st;
    if (threadIdx.x == 0) (void)xb_add(&bar[XB_XCNT(b.x)], 1u);
    return b;
}
__device__ __forceinline__ void xcd_barrier_complete(unsigned* bar, unsigned x, unsigned& nloc, unsigned& nx) {
    const unsigned G = gridDim.x * gridDim.y * gridDim.z;
    unsigned sum, cnt, mine, sp = 0u;
    for (;;) {
        sum = 0u; cnt = 0u; mine = 0u;
#pragma unroll
        for (unsigned j = 0; j < 16; ++j) { const unsigned c = xb_ld(&bar[XB_XCNT(j)]); sum += c; cnt += (c > 0u) ? 1u : 0u; mine = (j == x) ? c : mine; }
        if (sum == G) break;
        __builtin_amdgcn_s_sleep(1);
        if ((++sp & 255u) == 0u) { if (xb_ld(&bar[XB_TMO])) break; if (sp > XB_SPIN_CAP) { atomicAdd(&bar[XB_TMO], 1u); break; } }
    }
    nloc = mine > 0u ? mine : 1u; nx = cnt > 0u ? cnt : 1u;
}

__device__ __forceinline__ void xcd_barrier(const XcdBarrier& b) {
    asm volatile("s_waitcnt vmcnt(0)" ::: "memory");
    __syncthreads();
    if (threadIdx.x == 0) {
        unsigned* bar = b.bar;
        __builtin_amdgcn_s_waitcnt(0);
        unsigned nloc = b.st[0], nx = b.st[1];
        if (nloc == 0u) { xcd_barrier_complete(bar, b.x, nloc, nx); b.st[0] = nloc; b.st[1] = nx; }
        const unsigned old = xb_add(&bar[XB_XSUB(b.x)], 1u);
        const unsigned gen = old / nloc;
        if (old + 1u == (gen + 1u) * nloc) {
            __builtin_amdgcn_fence(__ATOMIC_RELEASE, "agent");
            asm volatile("s_waitcnt vmcnt(0)" ::: "memory");
            const unsigned og = xb_add(&bar[XB_TOP], 1u);
            const unsigned tg = og / nx;
            if (og + 1u == (tg + 1u) * nx) xb_add(&bar[XB_TOPGEN], 1u);
            else XB_SPIN(xb_ld(&bar[XB_TOPGEN]) == tg, bar);
            __builtin_amdgcn_fence(__ATOMIC_ACQUIRE, "agent");
            xb_add(&bar[XB_XGEN(b.x)], 1u);
            asm volatile("s_waitcnt vmcnt(0)" ::: "memory");
        } else {
            XB_SPIN(xb_ld(&bar[XB_XGEN(b.x)]) == gen, bar);
            __builtin_amdgcn_fence(__ATOMIC_ACQUIRE, "agent");
            asm volatile("s_waitcnt vmcnt(0)" ::: "memory");
        }
    }
    __syncthreads();
}


__global__ void __launch_bounds__(256, 2) mega(Params pin) {
  __shared__ __attribute__((aligned(16))) char smem[2 * 2 * 128 * GP * 2];
  __shared__ int s_item;
  __shared__ uint4 xb_words;
  if (threadIdx.x == 0) xb_words = make_uint4(0u, 0u, 0u, 0u);
  __syncthreads();
  XcdBarrier xb; xb.bar = nullptr; xb.x = 0u; xb.st = (volatile LAS unsigned*)&xb_words;
  bool xb_posted = false;
  const int G = gridDim.x, b = blockIdx.x;
  const int vb = ((G & 7) == 0) ? ((b & 7) * (G >> 3) + (b >> 3)) : b;
  for (int st = pin.phase_lo; st < pin.phase_hi; ++st) {
    int ph; bool dry = false;
    if (st == 0) ph = 0;
    else if (st == 41) ph = 21;
    else {
      const int u = st - 1, lay = u / 20, v = u - lay * 20, sb = v >> 1;
      dry = (v & 1) == 0;
      if (dry && !((pin.probe >> sb) & 1)) continue;
      if (lay == 0 && sb == 0) continue;
      ph = 1 + lay * 10 + sb;
    }
    if (st > pin.phase_lo) {
      if (!xb_posted) {
        cg::this_grid().sync();
        xb = xcd_barrier_post((unsigned*)(pin.ws + OFF_BAR), (volatile LAS unsigned*)&xb_words);
        xb_posted = true;
      } else xcd_barrier(xb);
    }
    Params p = pin;
    asm volatile("" : "+s"(p.xp), "+s"(p.xs), "+s"(p.meta), "+s"(p.attn_g), "+s"(p.w_in), "+s"(p.qa_g), "+s"(p.w_qb), "+s"(p.kva_g), "+s"(p.w_kvb), "+s"(p.gq_g));
    asm volatile("" : "+s"(p.gk_g), "+s"(p.mo_g), "+s"(p.go_g), "+s"(p.w_out), "+s"(p.mlp_g), "+s"(p.w_up), "+s"(p.w_dn), "+s"(p.fin_g), "+s"(p.out), "+s"(p.ws));
    int tid = threadIdx.x;
    asm volatile("" : "+v"(tid));
    const int lane = tid & 63, wave = tid >> 6, r = lane & 31;
    float* ssq = (float*)(p.ws + OFF_SSQ);
    const float2* tab = (const float2*)(p.ws + OFF_TAB);
    if (ph == 0) { phase_prep(p, tid); phase_norm(p, p.attn_g, true, true, tid); continue; }
    if (ph == 21) { phase_final(p, tid); continue; }
    const int layer = (ph - 1) / 10, sub = (ph - 1) % 10;
    const u16* Wl = (const u16*)(p.ws + OFF_W) + (size_t)layer * W_LAYER;
    if (sub == 0) {
      phase_norm(p, p.attn_g + layer * 1024, layer == 0, true, tid);
    } else if (sub == 1) {
      EpiIn e; e.CQ = (u16*)(p.ws + OFF_CQ); e.CKV = (u16*)(p.ws + OFF_CKV); e.QG = (u16*)(p.ws + OFF_QG); e.KG = (u16*)(p.ws + OFF_KG);
      e.VGT = (u16*)(p.ws + OFF_VGT); e.KPE = (u16*)(p.ws + OFF_KPE); e.ssq_q = ssq; e.ssq_kv = ssq + MPAD;
      e.gq_g = p.gq_g + layer * 64; e.gk_g = p.gk_g + layer * 64; e.tab = tab;
      APLin ap{(const u16*)(p.ws + OFF_HN), 1024};
      for (int t = vb; t < NTM * 12; t += G) { const int mt = t / 12, nt = t - mt * 12; gemm_tile<false>(ap, Wl + WO_IN, 1024, 1024, mt * 128, nt * 128, e, smem, 1.f, 1.f, tid, dry); }
    } else if (sub == 2) {
      EpiQB e2; e2.QM = (u16*)(p.ws + OFF_HN); e2.ssq_q = ssq; e2.tab = tab;
      EpiKVB e3; e3.KN = (u16*)(p.ws + OFF_KN); e3.VMT = (u16*)(p.ws + OFF_VMT); e3.ssq_kv = ssq + MPAD;
      APLin a2{(const u16*)(p.ws + OFF_CQ), 384};
      APLin a3{(const u16*)(p.ws + OFF_CKV), 256};
      for (int t = vb; t < NTM * 14; t += G) {
        if (t < NTM * 6) { const int mt = t / 6, nt = t - mt * 6; gemm_tile<false>(a2, Wl + WO_QB, 384, 384, mt * 128, nt * 128, e2, smem, 1.f, 1.f, tid, dry); }
        else { const int u = t - NTM * 6; const int mt = u >> 3, nt = u & 7; gemm_tile<false>(a3, Wl + WO_KVB, 256, 256, mt * 128, nt * 128, e3, smem, 1.f, 1.f, tid, dry); }
      }
    } else if (sub == 3) {
      phase_attn(p, layer, smem, &s_item, tid, dry);
    } else if (sub == 4) {
      APMix ap{(const u16*)(p.ws + OFF_HN), (const u16*)(p.ws + OFF_QG)};
      for (int t = vb; t < NTM * 8; t += G) {
        const int mt = t >> 3, nt = t & 7;
        const int g0 = mt * 128 + (wave >> 1) * 64 + r;
        const float ra0 = rsqrtf(ssq[2 * (size_t)MPAD + g0] * (1.0f / 512.0f) + EPS), rg0 = rsqrtf(ssq[3 * (size_t)MPAD + g0] * (1.0f / 512.0f) + EPS);
        const float ra1 = rsqrtf(ssq[2 * (size_t)MPAD + g0 + 32] * (1.0f / 512.0f) + EPS), rg1 = rsqrtf(ssq[3 * (size_t)MPAD + g0 + 32] * (1.0f / 512.0f) + EPS);
        EpiRes e; res_bases(p, mt, layer == 0, e.sb, e.db, e.minrow); e.fin0 = rg0; e.fin1 = rg1;
        gemm_tile<true>(ap, Wl + WO_OUT, 1024, 1024, mt * 128, nt * 128, e, smem, ra0 / rg0, ra1 / rg1, tid, dry);
      }
    } else if (sub == 5) {
      phase_norm(p, p.mlp_g + layer * 1024, false, false, tid);
    } else if (sub == 6 || sub == 8) {
      const int mh = (sub - 6) >> 1;
      EpiUp e; e.U0 = (u16*)(p.ws + OFF_U) - (size_t)mh * 259 * 128 * 4096;
      APLin ap{(const u16*)(p.ws + OFF_HN), 1024};
      for (int t = vb; t < 259 * 32; t += G) {
        int ml, nt;
        if (t < 256 * 32) { const int blk = t >> 6, w = t & 63; ml = (blk >> 2) * 8 + (w >> 3); nt = (blk & 3) * 8 + (w & 7); }
        else { ml = t >> 5; nt = t & 31; }
        gemm_tile<false>(ap, Wl + WO_UP, 1024, 1024, (mh * 259 + ml) * 128, nt * 128, e, smem, 1.f, 1.f, tid, dry);
      }
    } else {
      const int mh = (sub - 7) >> 1;
      APLin ap{(const u16*)(p.ws + OFF_U) - (size_t)mh * 259 * 128 * 4096, 4096};
      for (int t = vb; t < 259 * 8; t += G) {
        const int mt = mh * 259 + (t >> 3), nt = t & 7;
        EpiRes e; res_bases(p, mt, false, e.sb, e.db, e.minrow); e.fin0 = 1.f; e.fin1 = 1.f;
        gemm_tile<false>(ap, Wl + WO_DN, 4096, 4096, mt * 128, nt * 128, e, smem, 1.f, 1.f, tid, dry);
      }
    }
  }
}

extern "C" void kernel_launch(void* const* d_in, const int* in_sizes, int n_in, void* d_out, int out_size, void* d_ws, size_t ws_size,
                              hipStream_t stream) {
  static int grid_blocks = 0;
  if (!grid_blocks) {
    int dev = 0, cus = 0, per_cu = 0;
    hipGetDevice(&dev);
    hipDeviceGetAttribute(&cus, hipDeviceAttributeMultiprocessorCount, dev);
    hipOccupancyMaxActiveBlocksPerMultiprocessor(&per_cu, mega, 256, 0);
    if (per_cu > 2) per_cu = 2;
    if (per_cu < 1) per_cu = 1;
    grid_blocks = cus * per_cu;
  }
  Params p{};
  p.xp = (const float*)d_in[0]; p.xs = (const float*)d_in[1]; p.meta = (const float*)d_in[2];
  p.attn_g = (const float*)d_in[3]; p.w_in = (const float*)d_in[4]; p.qa_g = (const float*)d_in[5]; p.w_qb = (const float*)d_in[6];
  p.kva_g = (const float*)d_in[7]; p.w_kvb = (const float*)d_in[8]; p.gq_g = (const float*)d_in[9]; p.gk_g = (const float*)d_in[10];
  p.mo_g = (const float*)d_in[11]; p.go_g = (const float*)d_in[12]; p.w_out = (const float*)d_in[13]; p.mlp_g = (const float*)d_in[14];
  p.w_up = (const float*)d_in[15]; p.w_dn = (const float*)d_in[16]; p.fin_g = (const float*)d_in[17];
  p.out = (float*)d_out; p.ws = (char*)d_ws;
#if MK_MULTI
  for (int ph = 0; ph < 42; ++ph) {
    p.phase_lo = ph; p.phase_hi = ph + 1; p.probe = PROBE_MASK;
    if (ph > 0 && ph < 41 && ((ph - 1) & 1) == 0 && !((PROBE_MASK >> (((ph - 1) % 20) >> 1)) & 1)) continue;
    hipLaunchKernelGGL(mega, dim3(grid_blocks), dim3(256), 0, stream, p);
  }
#else
  p.phase_lo = 0; p.phase_hi = 42; p.probe = PROBE_MASK;
  void* args[] = {&p};
  hipError_t e = hipLaunchCooperativeKernel((void*)mega, dim3(grid_blocks), dim3(256), args, 0, stream);
  if (e != hipSuccess) fprintf(stderr, "cooperative launch failed: %s (grid %d)\n", hipGetErrorString(e), grid_blocks);
#endif
}
```

```cpp
#include <hip/hip_runtime.h>
#include <hip/hip_cooperative_groups.h>
#include <stdint.h>
#include <cstdio>
namespace cg = cooperative_groups;

#ifndef PROBE_MASK
#define PROBE_MASK 0
#endif
#ifndef MK_MULTI
#define MK_MULTI 0
#endif

typedef unsigned short u16;
typedef short bf16x8 __attribute__((ext_vector_type(8)));
typedef float f32x16 __attribute__((ext_vector_type(16)));
typedef unsigned u32x4 __attribute__((ext_vector_type(4)));
typedef unsigned u32x2 __attribute__((ext_vector_type(2)));
typedef float f32x2v __attribute__((ext_vector_type(2)));
typedef __bf16 bf16x2v __attribute__((ext_vector_type(2)));
#define DI __device__ __forceinline__
#define GAS __attribute__((address_space(1)))
#define WAVE_LDS_FENCE() asm volatile("s_waitcnt lgkmcnt(0)" ::: "memory")
#define MFMA(a, b, c) __builtin_amdgcn_mfma_f32_32x32x16_bf16((a), (b), (c), 0, 0, 0)

constexpr int MPAD = 66304;
constexpr int NTM = 518;
constexpr float EPS = 1e-6f;
constexpr float LOG2E = 1.4426950408889634f;
constexpr float QSCALE_M = 0.10206207261596575f * LOG2E;
constexpr float QSCALE_G = 0.125f * LOG2E;

constexpr size_t SZ_WIN = 1536ull * 1024, SZ_WQB = 768ull * 384, SZ_WKVB = 1024ull * 256, SZ_WOUT = 1024ull * 1024,
                 SZ_WUP = 4096ull * 1024, SZ_WDN = 1024ull * 4096;
constexpr size_t WO_IN = 0, WO_QB = WO_IN + SZ_WIN, WO_KVB = WO_QB + SZ_WQB, WO_OUT = WO_KVB + SZ_WKVB, WO_UP = WO_OUT + SZ_WOUT,
                 WO_DN = WO_UP + SZ_WUP, W_LAYER = WO_DN + SZ_WDN;
constexpr size_t OFF_W = 0;
constexpr size_t OFF_TAB = OFF_W + 2 * W_LAYER * 2;
constexpr size_t OFF_XMETA = OFF_TAB + 16400ull * 16 * 8;
constexpr size_t OFF_SSQ = OFF_XMETA + 96ull * 1024 * 4;
constexpr size_t OFF_CNT = OFF_SSQ + 4ull * MPAD * 4;
constexpr size_t OFF_BAR = OFF_CNT + 1024;
constexpr size_t OFF_HN = OFF_BAR + 16384;
constexpr size_t OFF_CQ = OFF_HN + (size_t)MPAD * 1024 * 2;
constexpr size_t OFF_CKV = OFF_CQ + (size_t)MPAD * 384 * 2;
constexpr size_t OFF_KN = OFF_CKV + (size_t)MPAD * 256 * 2;
constexpr size_t OFF_KPE = OFF_KN + (size_t)MPAD * 512 * 2;
constexpr size_t OFF_VMT = OFF_KPE + (size_t)MPAD * 32 * 2;
constexpr size_t OFF_QG = OFF_VMT + (size_t)MPAD * 512 * 2;
constexpr size_t OFF_KG = OFF_QG + (size_t)MPAD * 512 * 2;
constexpr size_t OFF_VGT = OFF_KG + (size_t)MPAD * 128 * 2;
constexpr size_t OFF_END = OFF_VGT + (size_t)MPAD * 128 * 2;
constexpr size_t OFF_U = OFF_CQ;
static_assert(OFF_U + (size_t)259 * 128 * 4096 * 2 <= OFF_END, "U fits");
static_assert(OFF_END <= 536870912ull, "workspace");

struct Params {
  const float* xp; const float* xs; const float* meta;
  const float* attn_g; const float* w_in; const float* qa_g; const float* w_qb; const float* kva_g; const float* w_kvb;
  const float* gq_g; const float* gk_g; const float* mo_g; const float* go_g; const float* w_out; const float* mlp_g;
  const float* w_up; const float* w_dn; const float* fin_g;
  float* out; char* ws;
  int phase_lo, phase_hi, probe, pad_;
};


DI u32x4 ldg16(const void* p) { return *(const GAS u32x4*)p; }
DI void stg16(void* p, u32x4 v) { *(GAS u32x4*)p = v; }
DI void stg8(void* p, u32x2 v) { *(GAS u32x2*)p = v; }
typedef float f32x4v __attribute__((ext_vector_type(4)));
DI float4 ldgf4(const void* p) { const f32x4v v = *(const GAS f32x4v*)p; return make_float4(v.x, v.y, v.z, v.w); }
DI void stgf4(void* p, float4 v) { f32x4v w = {v.x, v.y, v.z, v.w}; *(GAS f32x4v*)p = w; }
DI unsigned pack2(float a, float b) { f32x2v f = {a, b}; bf16x2v v = __builtin_convertvector(f, bf16x2v); return __builtin_bit_cast(unsigned, v); }
DI u16 f2bf(float a) { return (u16)(pack2(a, 0.f) & 0xffffu); }
DI void store4(u16* dst, float a, float b, float c, float d) { u32x2 v = {pack2(a, b), pack2(c, d)}; *(u32x2*)dst = v; }
DI void store4g(u16* dst, float a, float b, float c, float d) { u32x2 v = {pack2(a, b), pack2(c, d)}; stg8(dst, v); }
DI int crow(int i, int h) { return (i & 3) + 8 * (i >> 2) + 4 * h; }
DI int swap23(int r) { return (r & 0x13) | ((r & 4) << 1) | ((r & 8) >> 1); }
DI float xhalf(float v) { return __shfl_xor(v, 32); }

DI void decode_tile(int T, int& seq, int& i) {
  if (T < 258) { seq = (T >= 129) ? 1 : 0; i = T - seq * 129; }
  else { int u = T - 258; int q = u / 65; seq = 2 + q; i = u - q * 65; }
}
DI int seq_base(int seq) { return seq < 2 ? seq * 16512 : 33024 + (seq - 2) * 8320; }

DI const float* xrow_src(const Params& p, int g, bool from_input) {
  int T = g >> 7, r = g & 127, seq, i; decode_tile(T, seq, i);
  if (i == 0) {
    if (r < 112) return nullptr;
    return from_input ? p.meta + (size_t)(r - 112) * 1024 : (const float*)(p.ws + OFF_XMETA) + (size_t)(seq * 16 + r - 112) * 1024;
  }
  int j = (i - 1) * 128 + r;
  if (seq < 2) { size_t row = (size_t)seq * 16384 + j; return from_input ? p.xp + row * 1024 : p.out + row * 1024; }
  size_t row = (size_t)(seq - 2) * 8192 + j;
  return from_input ? p.xs + row * 1024 : p.out + (32768 + row) * 1024;
}
DI float* xrow_dst(const Params& p, int g) {
  int T = g >> 7, r = g & 127, seq, i; decode_tile(T, seq, i);
  if (i == 0) {
    if (r < 112) return nullptr;
    return (float*)(p.ws + OFF_XMETA) + (size_t)(seq * 16 + r - 112) * 1024;
  }
  int j = (i - 1) * 128 + r;
  if (seq < 2) { size_t row = (size_t)seq * 16384 + j; return p.out + row * 1024; }
  size_t row = (size_t)(seq - 2) * 8192 + j;
  return p.out + (32768 + row) * 1024;
}

DI int mapcol(int kind, int n) {
  if (kind == 1) { if (n < 640) return n; if (n < 1408) return n + 32; if (n < 1440) return 640 + (n - 1408); return -1; }
  if (kind == 2) { if (n < 512) return (n >> 6) * 96 + (n & 63); int m = n - 512; return (m >> 5) * 96 + 64 + (m & 31); }
  if (kind == 3) { if (n < 512) return (n >> 6) * 128 + (n & 63); int m = n - 512; return (m >> 6) * 128 + 64 + (m & 63); }
  return n;
}
DI void prep_weight(const float* __restrict__ src, int Nsrc, u16* __restrict__ dst, int Nout, int K, const float* gA, const float* gB,
                    int ksplit, int kind, int gtid, int gthreads) {
  const int total = Nout * (K >> 3);
  for (int u = gtid; u < total; u += gthreads) {
    const int n = u % Nout, kc = u / Nout;
    const int col = mapcol(kind, n);
    const int k = kc * 8;
    float v[8];
#pragma unroll
    for (int j = 0; j < 8; ++j) {
      float x = 0.f;
      if (col >= 0) {
        x = src[(size_t)(k + j) * Nsrc + col];
        if (gA) x *= (k + j < ksplit) ? gA[k + j] : gB[k + j - ksplit];
      }
      v[j] = x;
    }
    u32x4 o = {pack2(v[0], v[1]), pack2(v[2], v[3]), pack2(v[4], v[5]), pack2(v[6], v[7])};
    *(u32x4*)(dst + (size_t)n * K + k) = o;
  }
}

DI void phase_prep(const Params& p, int tid) {
  const int gtid = blockIdx.x * 256 + tid, gthreads = gridDim.x * 256;
  u16* W = (u16*)(p.ws + OFF_W);
  for (int l = 0; l < 2; ++l) {
    u16* Wl = W + (size_t)l * W_LAYER;
    prep_weight(p.w_in + (size_t)l * 1024 * 1440, 1440, Wl + WO_IN, 1536, 1024, nullptr, nullptr, 0, 1, gtid, gthreads);
    prep_weight(p.w_qb + (size_t)l * 384 * 768, 768, Wl + WO_QB, 768, 384, p.qa_g + l * 384, p.qa_g + l * 384, 384, 2, gtid, gthreads);
    prep_weight(p.w_kvb + (size_t)l * 256 * 1024, 1024, Wl + WO_KVB, 1024, 256, p.kva_g + l * 256, p.kva_g + l * 256, 256, 3, gtid, gthreads);
    prep_weight(p.w_out + (size_t)l * 1024 * 1024, 1024, Wl + WO_OUT, 1024, 1024, p.mo_g + l * 512, p.go_g + l * 512, 512, 0, gtid, gthreads);
    prep_weight(p.w_up + (size_t)l * 1024 * 4096, 4096, Wl + WO_UP, 4096, 1024, nullptr, nullptr, 0, 0, gtid, gthreads);
    prep_weight(p.w_dn + (size_t)l * 4096 * 1024, 1024, Wl + WO_DN, 1024, 4096, nullptr, nullptr, 0, 0, gtid, gthreads);
  }
  float2* tab = (float2*)(p.ws + OFF_TAB);
  for (int u = gtid; u < 16400 * 16; u += gthreads) {
    const int pos = u >> 4, f = u & 15;
    const float invf = 1.0f / powf(10000.0f, (float)(2 * f) / 32.0f);
    const float ang = (float)pos * invf;
    const double rev = (double)ang * 0.15915494309189535;
    const double fr = rev - rint(rev);
    const float x = (float)(2.0 * fr);
    tab[u] = make_float2(cospif(x), sinpif(x));
  }
  float* xm = (float*)(p.ws + OFF_XMETA);
  for (int u = gtid; u < 96 * 1024; u += gthreads) xm[u] = p.meta[u & 16383];
  int* cnt = (int*)(p.ws + OFF_CNT);
  if (gtid < 64) cnt[gtid] = 0;
  unsigned* bar = (unsigned*)(p.ws + OFF_BAR);
  if (gtid < 4096) bar[gtid] = 0u;
}

DI void phase_norm(const Params& p, const float* __restrict__ gain, bool from_input, bool zero_ssq, int tid) {
  const int lane = tid & 63;
  const int gw = blockIdx.x * 4 + (tid >> 6), nw = gridDim.x * 4;
  u16* HN = (u16*)(p.ws + OFF_HN);
  float* ssq = (float*)(p.ws + OFF_SSQ);
  for (int g = gw; g < MPAD; g += nw) {
    const float* xr = xrow_src(p, g, from_input);
    u16* hr = HN + (size_t)g * 1024;
    if (!xr) {
      u32x4 z = {0u, 0u, 0u, 0u};
      *(u32x4*)(hr + lane * 16) = z;
      *(u32x4*)(hr + lane * 16 + 8) = z;
    } else {
      float4 v[4];
#pragma unroll
      for (int q = 0; q < 4; ++q) v[q] = ((const float4*)xr)[lane + 64 * q];
      float ss = 0.f;
#pragma unroll
      for (int q = 0; q < 4; ++q) ss += v[q].x * v[q].x + v[q].y * v[q].y + v[q].z * v[q].z + v[q].w * v[q].w;
#pragma unroll
      for (int o = 32; o >= 1; o >>= 1) ss += __shfl_xor(ss, o);
      const float rstd = rsqrtf(ss * (1.0f / 1024.0f) + EPS);
#pragma unroll
      for (int q = 0; q < 4; ++q) {
        const float4 gg = ((const float4*)gain)[lane + 64 * q];
        store4(hr + 4 * (lane + 64 * q), v[q].x * rstd * gg.x, v[q].y * rstd * gg.y, v[q].z * rstd * gg.z, v[q].w * rstd * gg.w);
      }
    }
    if (zero_ssq && lane < 4) ssq[(size_t)lane * MPAD + g] = 0.f;
  }
}

DI void phase_final(const Params& p, int tid) {
  const int lane = tid & 63;
  const int gw = blockIdx.x * 4 + (tid >> 6), nw = gridDim.x * 4;
  for (int g = gw; g < MPAD; g += nw) {
    if (((g >> 7) == 0) || ((g >> 7) == 129) || ((g >> 7) >= 258 && ((g >> 7) - 258) % 65 == 0)) continue;
    float* xr = xrow_dst(p, g);
    float4 v[4];
#pragma unroll
    for (int q = 0; q < 4; ++q) v[q] = ((const float4*)xr)[lane + 64 * q];
    float ss = 0.f;
#pragma unroll
    for (int q = 0; q < 4; ++q) ss += v[q].x * v[q].x + v[q].y * v[q].y + v[q].z * v[q].z + v[q].w * v[q].w;
#pragma unroll
    for (int o = 32; o >= 1; o >>= 1) ss += __shfl_xor(ss, o);
    const float rstd = rsqrtf(ss * (1.0f / 1024.0f) + EPS);
#pragma unroll
    for (int q = 0; q < 4; ++q) {
      const float4 gg = ((const float4*)p.fin_g)[lane + 64 * q];
      float4 o = make_float4(v[q].x * rstd * gg.x, v[q].y * rstd * gg.y, v[q].z * rstd * gg.z, v[q].w * rstd * gg.w);
      ((float4*)xr)[lane + 64 * q] = o;
    }
  }
}

constexpr int GP = 72;
struct APLin { const u16* A; int lda; DI const u16* ptr(int row, int k0) const { return A + (size_t)row * lda + k0; } };
struct APMix { const u16* QM; const u16* QG;
  DI const u16* ptr(int row, int k0) const { return k0 < 512 ? QM + (size_t)row * 768 + (k0 >> 6) * 96 : QG + (size_t)row * 512 + (k0 - 512); } };

template <bool MIDK, class AP, class EPI>
DI void gemm_tile(const AP& ap, const u16* __restrict__ W, int ldw, int K, int m0, int n0, const EPI& epi, char* smem, float r0, float r1, int tid, bool dry) {
  constexpr int SBUF = 2 * 128 * GP;
  u16* sA = (u16*)smem;
  u16* sB = sA + 128 * GP;
  const int lane = tid & 63, wave = tid >> 6, r = lane & 31, h = lane >> 5, wm = wave >> 1, wn = wave & 1;
  const int lrow = tid >> 3, lkc = (tid & 7) * 8;
  u32x4 ra0[4], rb0[4], ra1[4], rb1[4];
  f32x16 acc[2][2];
#pragma unroll
  for (int a = 0; a < 2; ++a)
#pragma unroll
    for (int b = 0; b < 2; ++b)
#pragma unroll
      for (int i = 0; i < 16; ++i) acc[a][b][i] = 0.f;
  const int nk = K >> 6;
#define GLOADQ(RA, RB, KT, q) do { const int k0_ = (KT) << 6; \
    RA[q] = ldg16(ap.ptr(m0 + lrow + 32 * (q), k0_) + lkc); RB[q] = ldg16(W + (size_t)(n0 + lrow + 32 * (q)) * ldw + k0_ + lkc); } while (0)
#define GLOAD(RA, RB, KT) do { GLOADQ(RA, RB, KT, 0); GLOADQ(RA, RB, KT, 1); GLOADQ(RA, RB, KT, 2); GLOADQ(RA, RB, KT, 3); } while (0)
#define SSTOREQ(RA, RB, ST, q) do { \
    *(u32x4*)(sA + (ST) * SBUF + (lrow + 32 * (q)) * GP + lkc) = RA[q]; *(u32x4*)(sB + (ST) * SBUF + (lrow + 32 * (q)) * GP + lkc) = RB[q]; } while (0)
#define SSTORE(RA, RB, ST) do { SSTOREQ(RA, RB, ST, 0); SSTOREQ(RA, RB, ST, 1); SSTOREQ(RA, RB, ST, 2); SSTOREQ(RA, RB, ST, 3); } while (0)
#define FLOAD(F, ST, ks) do { _Pragma("unroll") for (int a = 0; a < 2; ++a) { \
    F[a] = *(const bf16x8*)(sB + (ST) * SBUF + (wn * 64 + a * 32 + r) * GP + (ks) * 16 + h * 8); \
    F[2 + a] = *(const bf16x8*)(sA + (ST) * SBUF + (wm * 64 + a * 32 + r) * GP + (ks) * 16 + h * 8); } } while (0)
#define FMMA(F) do { _Pragma("unroll") for (int a = 0; a < 2; ++a) _Pragma("unroll") for (int b = 0; b < 2; ++b) acc[a][b] = MFMA(F[a], F[2 + b], acc[a][b]); } while (0)
  bf16x8 f0[4], f1[4];
  GLOAD(ra0, rb0, 0);
  GLOAD(ra1, rb1, 1);
  __syncthreads();
  SSTORE(ra0, rb0, 0);
  if (nk > 2) GLOAD(ra0, rb0, 2);
  __syncthreads();
  for (int kt = 0; kt < nk; kt += 2) {
    const bool l3 = kt + 3 < nk, s2 = kt + 2 < nk, l4 = kt + 4 < nk;
    FLOAD(f0, 0, 0); FLOAD(f1, 0, 1);
    FMMA(f0); SSTOREQ(ra1, rb1, 1, 0); if (l3) GLOADQ(ra1, rb1, kt + 3, 0);
    FLOAD(f0, 0, 2);
    FMMA(f1); SSTOREQ(ra1, rb1, 1, 1); if (l3) GLOADQ(ra1, rb1, kt + 3, 1);
    FLOAD(f1, 0, 3);
    FMMA(f0); SSTOREQ(ra1, rb1, 1, 2); if (l3) GLOADQ(ra1, rb1, kt + 3, 2);
    FMMA(f1); SSTOREQ(ra1, rb1, 1, 3); if (l3) GLOADQ(ra1, rb1, kt + 3, 3);
    __syncthreads();
    FLOAD(f0, 1, 0); FLOAD(f1, 1, 1);
    FMMA(f0); if (s2) SSTOREQ(ra0, rb0, 0, 0); if (l4) GLOADQ(ra0, rb0, kt + 4, 0);
    FLOAD(f0, 1, 2);
    FMMA(f1); if (s2) SSTOREQ(ra0, rb0, 0, 1); if (l4) GLOADQ(ra0, rb0, kt + 4, 1);
    FLOAD(f1, 1, 3);
    FMMA(f0); if (s2) SSTOREQ(ra0, rb0, 0, 2); if (l4) GLOADQ(ra0, rb0, kt + 4, 2);
    FMMA(f1); if (s2) SSTOREQ(ra0, rb0, 0, 3); if (l4) GLOADQ(ra0, rb0, kt + 4, 3);
    if (MIDK && kt == 6) {
#pragma unroll
      for (int a = 0; a < 2; ++a)
#pragma unroll
        for (int i = 0; i < 16; ++i) { acc[a][0][i] *= r0; acc[a][1][i] *= r1; }
    }
    __syncthreads();
  }
#undef GLOADQ
#undef SSTOREQ
#undef FLOAD
#undef FMMA
#undef GLOAD
#undef SSTORE
  if (!dry) epi(acc, n0 + wn * 64, m0 + wm * 64, lane, (u16*)smem + wave * 64 * GP);
}

struct ColId { DI int operator()(int ch) const { return ch * 8; } };
struct ColRope { DI int operator()(int ch) const { return (ch >> 2) * 96 + (ch & 3) * 8; } };

template <class COLF>
DI void stage_store(f32x16 (&acc)[2][2], u16* wl, int lane, u16* dst0, size_t pitch, const COLF& colf) {
  const int r = lane & 31, h = lane >> 5;
#pragma unroll
  for (int rb = 0; rb < 2; ++rb)
#pragma unroll
    for (int lb = 0; lb < 2; ++lb)
#pragma unroll
      for (int g4 = 0; g4 < 4; ++g4)
        store4(wl + (lb * 32 + r) * GP + rb * 32 + 8 * g4 + 4 * h, acc[rb][lb][4 * g4], acc[rb][lb][4 * g4 + 1], acc[rb][lb][4 * g4 + 2], acc[rb][lb][4 * g4 + 3]);
  WAVE_LDS_FENCE();
#pragma unroll
  for (int it = 0; it < 8; ++it) {
    const int row = it * 8 + (lane >> 3), ch = lane & 7;
    const u32x4 v = *(const u32x4*)(wl + row * GP + ch * 8);
    stg16(dst0 + (size_t)row * pitch + colf(ch), v);
  }
  WAVE_LDS_FENCE();
}

DI void rope16(float (&v)[16], const float2* __restrict__ tabrow, int h) {
#pragma unroll
  for (int i = 0; i < 8; ++i) {
    const int f = (i & 3) + 8 * (i >> 2) + 4 * h;
    const float2 cs = tabrow[f];
    const float x1 = v[i], x2 = v[i + 8];
    v[i] = x1 * cs.x - x2 * cs.y;
    v[i + 8] = x2 * cs.x + x1 * cs.y;
  }
}

struct EpiIn {
  u16 *CQ, *CKV, *QG, *KG, *VGT, *KPE; float *ssq_q, *ssq_kv; const float *gq_g, *gk_g; const float2* tab;
  DI void operator()(f32x16 (&acc)[2][2], int nb, int mb, int lane, u16* wl) const {
    const int r = lane & 31, h = lane >> 5;
    int seq, it; decode_tile(mb >> 7, seq, it);
#pragma unroll
    for (int ti = 0; ti < 2; ++ti) {
      const int g = mb + ti * 32 + r, rr = g & 127;
      if (nb < 640) {
        float ss = 0.f;
#pragma unroll
        for (int fi = 0; fi < 2; ++fi)
#pragma unroll
          for (int i = 0; i < 16; ++i) ss += acc[fi][ti][i] * acc[fi][ti][i];
        ss += xhalf(ss);
        if (h == 0) unsafeAtomicAdd((nb < 384 ? ssq_q : ssq_kv) + g, ss);
      } else if (nb < 1280) {
        const bool isq = nb < 1152;
        const float* gg = isq ? gq_g : gk_g;
        float ss = 0.f;
#pragma unroll
        for (int fi = 0; fi < 2; ++fi)
#pragma unroll
          for (int i = 0; i < 16; ++i) ss += acc[fi][ti][i] * acc[fi][ti][i];
        ss += xhalf(ss);
        const float rstd = rsqrtf(ss * (1.0f / 64.0f) + EPS);
        const float osc = isq ? QSCALE_G : 1.0f;
        int prow = 0, pcol = 0;
        if (it > 0) { const int j = (it - 1) * 128 + rr; prow = j >> 6; pcol = j & 63; }
        u16* dst = isq ? QG + (size_t)g * 512 + (nb - 640) : KG + (size_t)g * 128 + (nb - 1152);
#pragma unroll
        for (int fi = 0; fi < 2; ++fi) {
          const int pos = fi == 0 ? prow : pcol;
          float v[16];
#pragma unroll
          for (int i = 0; i < 16; ++i) v[i] = acc[fi][ti][i] * rstd * gg[fi * 32 + crow(i, h)];
          rope16(v, tab + pos * 16, h);
#pragma unroll
          for (int g4 = 0; g4 < 4; ++g4)
            store4(dst + fi * 32 + 8 * g4 + 4 * h, v[4 * g4] * osc, v[4 * g4 + 1] * osc, v[4 * g4 + 2] * osc, v[4 * g4 + 3] * osc);
        }
      } else if (nb < 1408) {
#pragma unroll
        for (int fi = 0; fi < 2; ++fi)
#pragma unroll
          for (int i = 0; i < 16; ++i) VGT[(size_t)(nb - 1280 + fi * 32 + crow(i, h)) * MPAD + g] = f2bf(acc[fi][ti][i]);
      } else if (nb == 1408) {
        int pos = 128 * it + rr - 112; pos = pos < 0 ? 0 : pos;
        float v[16];
#pragma unroll
        for (int i = 0; i < 16; ++i) v[i] = acc[0][ti][i];
        rope16(v, tab + pos * 16, h);
#pragma unroll
        for (int g4 = 0; g4 < 4; ++g4) store4g(KPE + (size_t)g * 32 + 8 * g4 + 4 * h, v[4 * g4], v[4 * g4 + 1], v[4 * g4 + 2], v[4 * g4 + 3]);
      }
    }
    if (nb < 384) stage_store(acc, wl, lane, CQ + (size_t)mb * 384 + nb, 384, ColId());
    else if (nb < 640) stage_store(acc, wl, lane, CKV + (size_t)mb * 256 + (nb - 384), 256, ColId());
  }
};

struct EpiQB {
  u16* QM; const float* ssq_q; const float2* tab;
  DI void operator()(f32x16 (&acc)[2][2], int nb, int mb, int lane, u16* wl) const {
    const int r = lane & 31, h = lane >> 5;
    int seq, it; decode_tile(mb >> 7, seq, it);
#pragma unroll
    for (int ti = 0; ti < 2; ++ti) {
      const int g = mb + ti * 32 + r, rr = g & 127;
      const float sc = rsqrtf(ssq_q[g] * (1.0f / 384.0f) + EPS) * QSCALE_M;
      if (nb < 512) {
#pragma unroll
        for (int fi = 0; fi < 2; ++fi)
#pragma unroll
          for (int i = 0; i < 16; ++i) acc[fi][ti][i] *= sc;
      } else {
        int pos = 128 * it + rr - 112; pos = pos < 0 ? 0 : pos;
#pragma unroll
        for (int fi = 0; fi < 2; ++fi) {
          float v[16];
#pragma unroll
          for (int i = 0; i < 16; ++i) v[i] = acc[fi][ti][i] * sc;
          rope16(v, tab + pos * 16, h);
#pragma unroll
          for (int i = 0; i < 16; ++i) acc[fi][ti][i] = v[i];
        }
      }
    }
    if (nb < 512) stage_store(acc, wl, lane, QM + (size_t)mb * 768 + (nb >> 6) * 96, 768, ColId());
    else stage_store(acc, wl, lane, QM + (size_t)mb * 768 + ((nb - 512) >> 5) * 96 + 64, 768, ColRope());
  }
};

struct EpiKVB {
  u16 *KN, *VMT; const float* ssq_kv;
  DI void operator()(f32x16 (&acc)[2][2], int nb, int mb, int lane, u16* wl) const {
    const int r = lane & 31, h = lane >> 5;
#pragma unroll
    for (int ti = 0; ti < 2; ++ti) {
      const int g = mb + ti * 32 + r;
      const float sc = rsqrtf(ssq_kv[g] * (1.0f / 256.0f) + EPS);
      if (nb < 512) {
#pragma unroll
        for (int fi = 0; fi < 2; ++fi)
#pragma unroll
          for (int i = 0; i < 16; ++i) acc[fi][ti][i] *= sc;
      } else {
#pragma unroll
        for (int fi = 0; fi < 2; ++fi)
#pragma unroll
          for (int i = 0; i < 16; ++i) VMT[(size_t)(nb - 512 + fi * 32 + crow(i, h)) * MPAD + g] = f2bf(acc[fi][ti][i] * sc);
      }
    }
    if (nb < 512) stage_store(acc, wl, lane, KN + (size_t)mb * 512 + nb, 512, ColId());
  }
};

DI void res_bases(const Params& p, int mt, bool from_input, const float*& sb, float*& db, int& minrow) {
  int seq, it; decode_tile(mt, seq, it);
  float* xm = (float*)(p.ws + OFF_XMETA);
  if (it == 0) {
    minrow = 112;
    db = xm + ((ptrdiff_t)seq * 16 - 112) * 1024;
    sb = from_input ? p.meta - 112 * 1024 : db;
  } else {
    minrow = 0;
    const size_t row = seq < 2 ? (size_t)seq * 16384 + (size_t)(it - 1) * 128 : 32768 + (size_t)(seq - 2) * 8192 + (size_t)(it - 1) * 128;
    db = p.out + row * 1024;
    sb = from_input ? (seq < 2 ? p.xp + row * 1024 : p.xs + (row - 32768) * 1024) : db;
  }
}

struct EpiRes {
  const float* sb; float* db; int minrow; float fin0, fin1;
  DI void operator()(f32x16 (&acc)[2][2], int nb, int mb, int lane, u16* wl) const {
    const int r = lane & 31, h = lane >> 5, mbl = mb & 127;
    float* wf = (float*)wl;
#pragma unroll
    for (int fi = 0; fi < 2; ++fi) {
#pragma unroll
      for (int ti = 0; ti < 2; ++ti) {
        const float sc = ti == 0 ? fin0 : fin1;
#pragma unroll
        for (int g4 = 0; g4 < 4; ++g4) {
          float4 o = make_float4(acc[fi][ti][4 * g4] * sc, acc[fi][ti][4 * g4 + 1] * sc, acc[fi][ti][4 * g4 + 2] * sc, acc[fi][ti][4 * g4 + 3] * sc);
          *(float4*)(wf + (ti * 32 + r) * 36 + 8 * g4 + 4 * h) = o;
        }
      }
      WAVE_LDS_FENCE();
#pragma unroll
      for (int it = 0; it < 8; ++it) {
        const int row = it * 8 + (lane >> 3), ch = lane & 7;
        const float4 a = *(const float4*)(wf + row * 36 + ch * 4);
        const int trow = mbl + row;
        if (trow >= minrow) {
          const size_t off = (size_t)trow * 1024 + nb + fi * 32 + ch * 4;
          float4 x = ldgf4(sb + off);
          x.x += a.x; x.y += a.y; x.z += a.z; x.w += a.w;
          stgf4(db + off, x);
        }
      }
      WAVE_LDS_FENCE();
    }
  }
};

struct EpiUp {
  u16* U0;
  DI void operator()(f32x16 (&acc)[2][2], int nb, int mb, int lane, u16* wl) const {
#pragma unroll
    for (int ti = 0; ti < 2; ++ti)
#pragma unroll
      for (int fi = 0; fi < 2; ++fi)
#pragma unroll
        for (int i = 0; i < 16; ++i) { const float a = fmaxf(acc[fi][ti][i], 0.f); acc[fi][ti][i] = a * a; }
    stage_store(acc, wl, lane, U0 + (size_t)mb * 4096 + nb, 4096, ColId());
  }
};

constexpr float ATT_THR = 8.0f;

template <int DQK>
struct AttnCtx {
  static constexpr int KP = DQK + 8, NKS = DQK / 16, KCH = DQK / 8, NKL = 64 * KCH / 256, KBUF = 64 * KP, VBUF = 64 * GP;
  const u16 *Kb, *KPEb, *Vt; int kpitch, rowk0, nt, tid, r, h, sr;
  u16 *sK, *sV;
  bf16x8 qf[NKS], kone, qm;
  f32x16 o[2];
  float mref, l;
  u32x4 rk[NKL], rv[2];

  int koff[NKL], voff[2];
  DI void init_offs() {
#pragma unroll
    for (int q = 0; q < NKL; ++q) {
      const int c = tid + 256 * q, row = c / KCH, cc = c % KCH;
      koff[q] = (DQK == 96 && cc >= 8) ? row * 32 + (cc - 8) * 8 : row * kpitch + cc * 8;
    }
#pragma unroll
    for (int q = 0; q < 2; ++q) { const int c = tid + 256 * q, dv = c >> 3, kc = c & 7; voff[q] = dv * MPAD + kc * 8; }
  }
  DI void gload_k(int t) {
    const int row0 = rowk0 + t * 64;
    const u16* kt = Kb + (size_t)row0 * kpitch;
    const u16* pt = KPEb + (size_t)row0 * 32;
#pragma unroll
    for (int q = 0; q < NKL; ++q) {
      const int c = tid + 256 * q, cc = c % KCH;
      rk[q] = ldg16(((DQK == 96 && cc >= 8) ? pt : kt) + koff[q]);
    }
  }
  DI void gload_v(int t) {
    const u16* vt = Vt + (rowk0 + t * 64);
#pragma unroll
    for (int q = 0; q < 2; ++q) rv[q] = ldg16(vt + voff[q]);
  }
  DI void sstore_k(int buf) {
#pragma unroll
    for (int q = 0; q < NKL; ++q) {
      const int c = tid + 256 * q, row = c / KCH, cc = c % KCH;
      *(u32x4*)(sK + buf * KBUF + row * KP + cc * 8) = rk[q];
    }
  }
  DI void sstore_v(int buf) {
#pragma unroll
    for (int q = 0; q < 2; ++q) {
      const int c = tid + 256 * q, dv = c >> 3, kc = c & 7;
      *(u32x4*)(sV + buf * VBUF + dv * GP + kc * 8) = rv[q];
    }
  }
  DI void qk(int buf, f32x16 (&s)[2]) {
    const u16* kb = sK + buf * KBUF + sr * KP + h * 8;
#pragma unroll
    for (int kb2 = 0; kb2 < 2; ++kb2)
#pragma unroll
      for (int i = 0; i < 16; ++i) s[kb2][i] = 0.f;
#pragma unroll
    for (int ks = 0; ks < NKS; ++ks)
#pragma unroll
      for (int kb2 = 0; kb2 < 2; ++kb2) {
        const bf16x8 a = *(const bf16x8*)(kb + kb2 * 32 * KP + ks * 16);
        s[kb2] = MFMA(a, qf[ks], s[kb2]);
      }
    s[0] = MFMA(kone, qm, s[0]);
    s[1] = MFMA(kone, qm, s[1]);
  }
  template <int PAR>
  DI void step(int t, f32x16 (&cur)[2], f32x16 (&nxt)[2]) {
    if (t + 1 < nt) sstore_k(PAR ^ 1);
    if (t > 0) sstore_v(PAR);
    __syncthreads();
    if (t + 1 < nt) qk(PAR ^ 1, nxt);
    float mx = fmaxf(cur[0][0], cur[1][0]);
#pragma unroll
    for (int i = 1; i < 16; ++i) mx = fmaxf(fmaxf(cur[0][i], cur[1][i]), mx);
    if (__builtin_amdgcn_ballot_w64(mx > ATT_THR) != 0ull) {
      asm volatile("" ::: "memory");
      mx = fmaxf(mx, xhalf(mx));
      const float want = mref + fmaxf(mx, 0.f);
      const float mn = __uint_as_float(pack2(want, 0.f) << 16);
      const float d = mn - mref;
      const float alpha = __builtin_amdgcn_exp2f(-d);
      mref = mn;
      l *= alpha;
#pragma unroll
      for (int a = 0; a < 2; ++a)
#pragma unroll
        for (int i = 0; i < 16; ++i) { o[a][i] *= alpha; cur[a][i] -= d; nxt[a][i] -= d; }
      u32x4 q4 = {h == 0 ? (pack2(-mn, 0.f) & 0xffffu) : 0u, 0u, 0u, 0u};
      qm = __builtin_bit_cast(bf16x8, q4);
    }
    float psum = 0.f;
#pragma unroll
    for (int kb2 = 0; kb2 < 2; ++kb2)
#pragma unroll
      for (int i = 0; i < 16; ++i) { const float pv = __builtin_amdgcn_exp2f(cur[kb2][i]); cur[kb2][i] = pv; psum += pv; }
    l += psum;
    if (t + 2 < nt) gload_k(t + 2);
    if (t + 1 < nt) gload_v(t + 1);
    const u16* vb = sV + PAR * VBUF + r * GP + h * 8;
#pragma unroll
    for (int kb2 = 0; kb2 < 2; ++kb2)
#pragma unroll
      for (int s2 = 0; s2 < 2; ++s2) {
        u32x4 pk = {pack2(cur[kb2][8 * s2], cur[kb2][8 * s2 + 1]), pack2(cur[kb2][8 * s2 + 2], cur[kb2][8 * s2 + 3]),
                    pack2(cur[kb2][8 * s2 + 4], cur[kb2][8 * s2 + 5]), pack2(cur[kb2][8 * s2 + 6], cur[kb2][8 * s2 + 7])};
        const bf16x8 pf = __builtin_bit_cast(bf16x8, pk);
#pragma unroll
        for (int db = 0; db < 2; ++db) {
          const bf16x8 a = *(const bf16x8*)(vb + db * 32 * GP + kb2 * 32 + s2 * 16);
          o[db] = MFMA(a, pf, o[db]);
        }
      }
  }
};

template <int DQK>
DI void attn_item(const u16* __restrict__ Qb, int qpitch, const u16* __restrict__ Kb, int kpitch, const u16* __restrict__ KPEb,
                  const u16* __restrict__ Vt, float* __restrict__ ssq, int rowq0, int rowk0, int nt, char* smem, int tid, bool dry) {
  typedef AttnCtx<DQK> C;
  C c;
  const int lane = tid & 63, wave = tid >> 6, r = lane & 31, h = lane >> 5;
  c.Kb = Kb; c.KPEb = KPEb; c.Vt = Vt; c.kpitch = kpitch; c.rowk0 = rowk0; c.nt = nt; c.tid = tid; c.r = r; c.h = h; c.sr = swap23(r);
  c.sK = (u16*)smem; c.sV = c.sK + 2 * C::KBUF;
  c.init_offs();
  const int myrow = rowq0 + wave * 32 + r;
  {
    const u16* qrow = Qb + (size_t)myrow * qpitch + h * 8;
#pragma unroll
    for (int ks = 0; ks < C::NKS; ++ks) c.qf[ks] = __builtin_bit_cast(bf16x8, ldg16(qrow + ks * 16));
  }
#pragma unroll
  for (int a = 0; a < 2; ++a)
#pragma unroll
    for (int i = 0; i < 16; ++i) c.o[a][i] = 0.f;
  c.mref = 0.f; c.l = 0.f;
  {
    u32x4 k1 = {h == 0 ? 0x3F80u : 0u, 0u, 0u, 0u}, z4 = {0u, 0u, 0u, 0u};
    c.kone = __builtin_bit_cast(bf16x8, k1); c.qm = __builtin_bit_cast(bf16x8, z4);
  }
  f32x16 sa[2], sb[2];
  c.gload_k(0); c.gload_v(0);
  __syncthreads();
  c.sstore_k(0); c.sstore_v(0);
  if (nt > 1) c.gload_k(1);
  __syncthreads();
  c.qk(0, sa);
#pragma unroll
  for (int i = 0; i < 16; ++i) {
    sa[0][i] = -1e30f;
    if (swap23(crow(i, h)) < 16) sa[1][i] = -1e30f;
  }
  int t = 0;
  for (; t + 1 < nt; t += 2) {
    c.template step<0>(t, sa, sb);
    c.template step<1>(t + 1, sb, sa);
  }
  if (t < nt) c.template step<0>(t, sa, sb);
  if (dry) return;
  float l = c.l;
  l += xhalf(l);
  const float inv = 1.0f / l;
  float ss = 0.f;
  u16* orow = (u16*)Qb + (size_t)myrow * qpitch;
#pragma unroll
  for (int db = 0; db < 2; ++db)
#pragma unroll
    for (int g4 = 0; g4 < 4; ++g4) {
      const float a0 = c.o[db][4 * g4] * inv, a1 = c.o[db][4 * g4 + 1] * inv, a2 = c.o[db][4 * g4 + 2] * inv, a3 = c.o[db][4 * g4 + 3] * inv;
      ss += a0 * a0 + a1 * a1 + a2 * a2 + a3 * a3;
      store4g(orow + db * 32 + 8 * g4 + 4 * h, a0, a1, a2, a3);
    }
  ss += xhalf(ss);
  if (h == 0) unsafeAtomicAdd(ssq + myrow, ss);
}

constexpr int N_ITEMS = 8288;
DI void phase_attn(const Params& p, int layer, char* smem, int* s_item, int tid, bool dry) {
  int* cnt = (int*)(p.ws + OFF_CNT) + layer + (dry ? 2 : 0);
  u16* QM = (u16*)(p.ws + OFF_HN);
  const u16* KN = (const u16*)(p.ws + OFF_KN);
  const u16* KPE = (const u16*)(p.ws + OFF_KPE);
  const u16* VMT = (const u16*)(p.ws + OFF_VMT);
  u16* QG = (u16*)(p.ws + OFF_QG);
  const u16* KG = (const u16*)(p.ws + OFF_KG);
  const u16* VGT = (const u16*)(p.ws + OFF_VGT);
  float* ssq = (float*)(p.ws + OFF_SSQ);
  for (;;) {
    if (tid == 0) *s_item = atomicAdd(cnt, 1);
    __syncthreads();
    const int it = *s_item;
    __syncthreads();
    if (it >= N_ITEMS) break;
    int grp, seq, head, qi, nt;
    if (it < 4128) { grp = it / 2064; const int u = it - grp * 2064; const int sh = u / 129; qi = u - sh * 129; seq = sh >> 3; head = sh & 7; nt = 257; }
    else { const int u0 = it - 4128; grp = u0 / 2080; const int u = u0 - grp * 2080; const int sh = u / 65; qi = u - sh * 65; seq = 2 + (sh >> 3); head = sh & 7; nt = 129; }
    const int P = seq_base(seq);
    if (grp == 0)
      attn_item<96>(QM + head * 96, 768, KN + head * 64, 512, KPE, VMT + (size_t)head * 64 * MPAD, ssq + 2 * (size_t)MPAD, P + qi * 128, P + 64, nt, smem, tid, dry);
    else
      attn_item<64>(QG + head * 64, 512, KG + (head >> 2) * 64, 128, nullptr, VGT + (size_t)(head >> 2) * 64 * MPAD, ssq + 3 * (size_t)MPAD, P + qi * 128, P + 64, nt, smem, tid, dry);
  }
}

#define XB_TMO      128
#define XB_XCNT(j)  (256  + 64 * (j))
#define XB_XSUB(j)  (1280 + 64 * (j))
#define XB_XGEN(j)  (2304 + 64 * (j))
#define XB_TOP      3328
#define XB_TOPGEN   3392
#define XCD_BAR_WORDS 3456
#define XB_SPIN_CAP (1u << 18)
#define LAS __attribute__((address_space(3)))

__device__ __forceinline__ unsigned xb_ld(unsigned* p)              { return __hip_atomic_load(p, __ATOMIC_RELAXED, __HIP_MEMORY_SCOPE_AGENT); }
__device__ __forceinline__ unsigned xb_add(unsigned* p, unsigned v) { return __hip_atomic_fetch_add(p, v, __ATOMIC_RELAXED, __HIP_MEMORY_SCOPE_AGENT); }
__device__ __forceinline__ unsigned xb_xcc_id() { return (unsigned)__builtin_amdgcn_s_getreg((3 << 11) | 20) & 0xFu; }
#define XB_SPIN(cond, bar) do { unsigned _sp = 0; while (cond) { __builtin_amdgcn_s_sleep(1); \
    if ((++_sp & 255u) == 0u) { if (xb_ld(&(bar)[XB_TMO])) break; if (_sp > XB_SPIN_CAP) { atomicAdd(&(bar)[XB_TMO], 1u); break; } } } } while (0)

struct XcdBarrier {
    unsigned* bar; unsigned x;
    volatile LAS unsigned* st;
};

__device__ __forceinline__ XcdBarrier xcd_barrier_post(unsigned* bar, volatile LAS unsigned* st) {
    XcdBarrier b; b.bar = bar; b.x = xb_xcc_id(); b.st = st;
    if (threadIdx.x == 0) (void)xb_add(&bar[XB_XCNT(b.x)], 1u);
    return b;
}
__device__ __forceinline__ void xcd_barrier_complete(unsigned* bar, unsigned x, unsigned& nloc, unsigned& nx) {
    const unsigned G = gridDim.x * gridDim.y * gridDim.z;
    unsigned sum, cnt, mine, sp = 0u;
    for (;;) {
        sum = 0u; cnt = 0u; mine = 0u;
#pragma unroll
        for (unsigned j = 0; j < 16; ++j) { const unsigned c = xb_ld(&bar[XB_XCNT(j)]); sum += c; cnt += (c > 0u) ? 1u : 0u; mine = (j == x) ? c : mine; }
        if (sum == G) break;
        __builtin_amdgcn_s_sleep(1);
        if ((++sp & 255u) == 0u) { if (xb_ld(&bar[XB_TMO])) break; if (sp > XB_SPIN_CAP) { atomicAdd(&bar[XB_TMO], 1u); break; } }
    }
    nloc = mine > 0u ? mine : 1u; nx = cnt > 0u ? cnt : 1u;
}

__device__ __forceinline__ void xcd_barrier(const XcdBarrier& b) {
    asm volatile("s_waitcnt vmcnt(0)" ::: "memory");
    __syncthreads();
    if (threadIdx.x == 0) {
        unsigned* bar = b.bar;
        __builtin_amdgcn_s_waitcnt(0);
        unsigned nloc = b.st[0], nx = b.st[1];
        if (nloc == 0u) { xcd_barrier_complete(bar, b.x, nloc, nx); b.st[0] = nloc; b.st[1] = nx; }
        const unsigned old = xb_add(&bar[XB_XSUB(b.x)], 1u);
        const unsigned gen = old / nloc;
        if (old + 1u == (gen + 1u) * nloc) {
            __builtin_amdgcn_fence(__ATOMIC_RELEASE, "agent");
            asm volatile("s_waitcnt vmcnt(0)" ::: "memory");
            const unsigned og = xb_add(&bar[XB_TOP], 1u);
            const unsigned tg = og / nx;
            if (og + 1u == (tg + 1u) * nx) xb_add(&bar[XB_TOPGEN], 1u);
            else XB_SPIN(xb_ld(&bar[XB_TOPGEN]) == tg, bar);
            __builtin_amdgcn_fence(__ATOMIC_ACQUIRE, "agent");
            xb_add(&bar[XB_XGEN(b.x)], 1u);
            asm volatile("s_waitcnt vmcnt(0)" ::: "memory");
        } else {
            XB_SPIN(xb_ld(&bar[XB_XGEN(b.x)]) == gen, bar);
            __builtin_amdgcn_fence(__ATOMIC_ACQUIRE, "agent");
            asm volatile("s_waitcnt vmcnt(0)" ::: "memory");
        }
    }
    __syncthreads();
}


__global__ void __launch_bounds__(256, 2) mega(Params pin) {
  __shared__ __attribute__((aligned(16))) char smem[2 * 2 * 128 * GP * 2];
  __shared__ int s_item;
  __shared__ uint4 xb_words;
  if (threadIdx.x == 0) xb_words = make_uint4(0u, 0u, 0u, 0u);
  __syncthreads();
  XcdBarrier xb; xb.bar = nullptr; xb.x = 0u; xb.st = (volatile LAS unsigned*)&xb_words;
  bool xb_posted = false;
  const int G = gridDim.x, b = blockIdx.x;
  const int vb = ((G & 7) == 0) ? ((b & 7) * (G >> 3) + (b >> 3)) : b;
  for (int st = pin.phase_lo; st < pin.phase_hi; ++st) {
    int ph; bool dry = false;
    if (st == 0) ph = 0;
    else if (st == 41) ph = 21;
    else {
      const int u = st - 1, lay = u / 20, v = u - lay * 20, sb = v >> 1;
      dry = (v & 1) == 0;
      if (dry && !((pin.probe >> sb) & 1)) continue;
      if (lay == 0 && sb == 0) continue;
      ph = 1 + lay * 10 + sb;
    }
    if (st > pin.phase_lo) {
      if (!xb_posted) {
        cg::this_grid().sync();
        xb = xcd_barrier_post((unsigned*)(pin.ws + OFF_BAR), (volatile LAS unsigned*)&xb_words);
        xb_posted = true;
      } else xcd_barrier(xb);
    }
    Params p = pin;
    asm volatile("" : "+s"(p.xp), "+s"(p.xs), "+s"(p.meta), "+s"(p.attn_g), "+s"(p.w_in), "+s"(p.qa_g), "+s"(p.w_qb), "+s"(p.kva_g), "+s"(p.w_kvb), "+s"(p.gq_g));
    asm volatile("" : "+s"(p.gk_g), "+s"(p.mo_g), "+s"(p.go_g), "+s"(p.w_out), "+s"(p.mlp_g), "+s"(p.w_up), "+s"(p.w_dn), "+s"(p.fin_g), "+s"(p.out), "+s"(p.ws));
    int tid = threadIdx.x;
    asm volatile("" : "+v"(tid));
    const int lane = tid & 63, wave = tid >> 6, r = lane & 31;
    float* ssq = (float*)(p.ws + OFF_SSQ);
    const float2* tab = (const float2*)(p.ws + OFF_TAB);
    if (ph == 0) { phase_prep(p, tid); phase_norm(p, p.attn_g, true, true, tid); continue; }
    if (ph == 21) { phase_final(p, tid); continue; }
    const int layer = (ph - 1) / 10, sub = (ph - 1) % 10;
    const u16* Wl = (const u16*)(p.ws + OFF_W) + (size_t)layer * W_LAYER;
    if (sub == 0) {
      phase_norm(p, p.attn_g + layer * 1024, layer == 0, true, tid);
    } else if (sub == 1) {
      EpiIn e; e.CQ = (u16*)(p.ws + OFF_CQ); e.CKV = (u16*)(p.ws + OFF_CKV); e.QG = (u16*)(p.ws + OFF_QG); e.KG = (u16*)(p.ws + OFF_KG);
      e.VGT = (u16*)(p.ws + OFF_VGT); e.KPE = (u16*)(p.ws + OFF_KPE); e.ssq_q = ssq; e.ssq_kv = ssq + MPAD;
      e.gq_g = p.gq_g + layer * 64; e.gk_g = p.gk_g + layer * 64; e.tab = tab;
      APLin ap{(const u16*)(p.ws + OFF_HN), 1024};
      for (int t = vb; t < NTM * 12; t += G) { const int mt = t / 12, nt = t - mt * 12; gemm_tile<false>(ap, Wl + WO_IN, 1024, 1024, mt * 128, nt * 128, e, smem, 1.f, 1.f, tid, dry); }
    } else if (sub == 2) {
      EpiQB e2; e2.QM = (u16*)(p.ws + OFF_HN); e2.ssq_q = ssq; e2.tab = tab;
      EpiKVB e3; e3.KN = (u16*)(p.ws + OFF_KN); e3.VMT = (u16*)(p.ws + OFF_VMT); e3.ssq_kv = ssq + MPAD;
      APLin a2{(const u16*)(p.ws + OFF_CQ), 384};
      APLin a3{(const u16*)(p.ws + OFF_CKV), 256};
      for (int t = vb; t < NTM * 14; t += G) {
        if (t < NTM * 6) { const int mt = t / 6, nt = t - mt * 6; gemm_tile<false>(a2, Wl + WO_QB, 384, 384, mt * 128, nt * 128, e2, smem, 1.f, 1.f, tid, dry); }
        else { const int u = t - NTM * 6; const int mt = u >> 3, nt = u & 7; gemm_tile<false>(a3, Wl + WO_KVB, 256, 256, mt * 128, nt * 128, e3, smem, 1.f, 1.f, tid, dry); }
      }
    } else if (sub == 3) {
      phase_attn(p, layer, smem, &s_item, tid, dry);
    } else if (sub == 4) {
      APMix ap{(const u16*)(p.ws + OFF_HN), (const u16*)(p.ws + OFF_QG)};
      for (int t = vb; t < NTM * 8; t += G) {
        const int mt = t >> 3, nt = t & 7;
        const int g0 = mt * 128 + (wave >> 1) * 64 + r;
        const float ra0 = rsqrtf(ssq[2 * (size_t)MPAD + g0] * (1.0f / 512.0f) + EPS), rg0 = rsqrtf(ssq[3 * (size_t)MPAD + g0] * (1.0f / 512.0f) + EPS);
        const float ra1 = rsqrtf(ssq[2 * (size_t)MPAD + g0 + 32] * (1.0f / 512.0f) + EPS), rg1 = rsqrtf(ssq[3 * (size_t)MPAD + g0 + 32] * (1.0f / 512.0f) + EPS);
        EpiRes e; res_bases(p, mt, layer == 0, e.sb, e.db, e.minrow); e.fin0 = rg0; e.fin1 = rg1;
        gemm_tile<true>(ap, Wl + WO_OUT, 1024, 1024, mt * 128, nt * 128, e, smem, ra0 / rg0, ra1 / rg1, tid, dry);
      }
    } else if (sub == 5) {
      phase_norm(p, p.mlp_g + layer * 1024, false, false, tid);
    } else if (sub == 6 || sub == 8) {
      const int mh = (sub - 6) >> 1;
      EpiUp e; e.U0 = (u16*)(p.ws + OFF_U) - (size_t)mh * 259 * 128 * 4096;
      APLin ap{(const u16*)(p.ws + OFF_HN), 1024};
      for (int t = vb; t < 259 * 32; t += G) {
        int ml, nt;
        if (t < 256 * 32) { const int blk = t >> 6, w = t & 63; ml = (blk >> 2) * 8 + (w >> 3); nt = (blk & 3) * 8 + (w & 7); }
        else { ml = t >> 5; nt = t & 31; }
        gemm_tile<false>(ap, Wl + WO_UP, 1024, 1024, (mh * 259 + ml) * 128, nt * 128, e, smem, 1.f, 1.f, tid, dry);
      }
    } else {
      const int mh = (sub - 7) >> 1;
      APLin ap{(const u16*)(p.ws + OFF_U) - (size_t)mh * 259 * 128 * 4096, 4096};
      for (int t = vb; t < 259 * 8; t += G) {
        const int mt = mh * 259 + (t >> 3), nt = t & 7;
        EpiRes e; res_bases(p, mt, false, e.sb, e.db, e.minrow); e.fin0 = 1.f; e.fin1 = 1.f;
        gemm_tile<false>(ap, Wl + WO_DN, 4096, 4096, mt * 128, nt * 128, e, smem, 1.f, 1.f, tid, dry);
      }
    }
  }
}

extern "C" void kernel_launch(void* const* d_in, const int* in_sizes, int n_in, void* d_out, int out_size, void* d_ws, size_t ws_size,
                              hipStream_t stream) {
  static int grid_blocks = 0;
  if (!grid_blocks) {
    int dev = 0, cus = 0, per_cu = 0;
    hipGetDevice(&dev);
    hipDeviceGetAttribute(&cus, hipDeviceAttributeMultiprocessorCount, dev);
    hipOccupancyMaxActiveBlocksPerMultiprocessor(&per_cu, mega, 256, 0);
    if (per_cu > 2) per_cu = 2;
    if (per_cu < 1) per_cu = 1;
    grid_blocks = cus * per_cu;
  }
  Params p{};
  p.xp = (const float*)d_in[0]; p.xs = (const float*)d_in[1]; p.meta = (const float*)d_in[2];
  p.attn_g = (const float*)d_in[3]; p.w_in = (const float*)d_in[4]; p.qa_g = (const float*)d_in[5]; p.w_qb = (const float*)d_in[6];
  p.kva_g = (const float*)d_in[7]; p.w_kvb = (const float*)d_in[8]; p.gq_g = (const float*)d_in[9]; p.gk_g = (const float*)d_in[10];
  p.mo_g = (const float*)d_in[11]; p.go_g = (const float*)d_in[12]; p.w_out = (const float*)d_in[13]; p.mlp_g = (const float*)d_in[14];
  p.w_up = (const float*)d_in[15]; p.w_dn = (const float*)d_in[16]; p.fin_g = (const float*)d_in[17];
  p.out = (float*)d_out; p.ws = (char*)d_ws;
#if MK_MULTI
  for (int ph = 0; ph < 42; ++ph) {
    p.phase_lo = ph; p.phase_hi = ph + 1; p.probe = PROBE_MASK;
    if (ph > 0 && ph < 41 && ((ph - 1) & 1) == 0 && !((PROBE_MASK >> (((ph - 1) % 20) >> 1)) & 1)) continue;
    hipLaunchKernelGGL(mega, dim3(grid_blocks), dim3(256), 0, stream, p);
  }
#else
  p.phase_lo = 0; p.phase_hi = 42; p.probe = PROBE_MASK;
  void* args[] = {&p};
  hipError_t e = hipLaunchCooperativeKernel((void*)mega, dim3(grid_blocks), dim3(256), args, 0, stream);
  if (e != hipSuccess) fprintf(stderr, "cooperative launch failed: %s (grid %d)\n", hipGetErrorString(e), grid_blocks);
#endif
}
```

```cpp
#include <hip/hip_runtime.h>
#include <hip/hip_cooperative_groups.h>
#include <stdint.h>
#include <cstdio>
namespace cg = cooperative_groups;

#ifndef PROBE_MASK
#define PROBE_MASK 0
#endif
#ifndef MK_MULTI
#define MK_MULTI 0
#endif

typedef unsigned short u16;
typedef short bf16x8 __attribute__((ext_vector_type(8)));
typedef float f32x16 __attribute__((ext_vector_type(16)));
typedef unsigned u32x4 __attribute__((ext_vector_type(4)));
typedef unsigned u32x2 __attribute__((ext_vector_type(2)));
typedef float f32x2v __attribute__((ext_vector_type(2)));
typedef __bf16 bf16x2v __attribute__((ext_vector_type(2)));
#define DI __device__ __forceinline__
#define GAS __attribute__((address_space(1)))
#define WAVE_LDS_FENCE() asm volatile("s_waitcnt lgkmcnt(0)" ::: "memory")
#define MFMA(a, b, c) __builtin_amdgcn_mfma_f32_32x32x16_bf16((a), (b), (c), 0, 0, 0)

constexpr int MPAD = 66304;
constexpr int NTM = 518;
constexpr float EPS = 1e-6f;
constexpr float LOG2E = 1.4426950408889634f;
constexpr float QSCALE_M = 0.10206207261596575f * LOG2E;
constexpr float QSCALE_G = 0.125f * LOG2E;

constexpr size_t SZ_WIN = 1536ull * 1024, SZ_WQB = 768ull * 384, SZ_WKVB = 1024ull * 256, SZ_WOUT = 1024ull * 1024,
                 SZ_WUP = 4096ull * 1024, SZ_WDN = 1024ull * 4096;
constexpr size_t WO_IN = 0, WO_QB = WO_IN + SZ_WIN, WO_KVB = WO_QB + SZ_WQB, WO_OUT = WO_KVB + SZ_WKVB, WO_UP = WO_OUT + SZ_WOUT,
                 WO_DN = WO_UP + SZ_WUP, W_LAYER = WO_DN + SZ_WDN;
constexpr size_t OFF_W = 0;
constexpr size_t OFF_TAB = OFF_W + 2 * W_LAYER * 2;
constexpr size_t OFF_XMETA = OFF_TAB + 16400ull * 16 * 8;
constexpr size_t OFF_SSQ = OFF_XMETA + 96ull * 1024 * 4;
constexpr size_t OFF_CNT = OFF_SSQ + 4ull * MPAD * 4;
constexpr size_t OFF_BAR = OFF_CNT + 1024;
constexpr size_t OFF_HN = OFF_BAR + 16384;
constexpr size_t OFF_CQ = OFF_HN + (size_t)MPAD * 1024 * 2;
constexpr size_t OFF_CKV = OFF_CQ + (size_t)MPAD * 384 * 2;
constexpr size_t OFF_KN = OFF_CKV + (size_t)MPAD * 256 * 2;
constexpr size_t OFF_KPE = OFF_KN + (size_t)MPAD * 512 * 2;
constexpr size_t OFF_VMT = OFF_KPE + (size_t)MPAD * 32 * 2;
constexpr size_t OFF_QG = OFF_VMT + (size_t)MPAD * 512 * 2;
constexpr size_t OFF_KG = OFF_QG + (size_t)MPAD * 512 * 2;
constexpr size_t OFF_VGT = OFF_KG + (size_t)MPAD * 128 * 2;
constexpr size_t OFF_END = OFF_VGT + (size_t)MPAD * 128 * 2;
constexpr size_t OFF_U = OFF_CQ;
static_assert(OFF_U + (size_t)259 * 128 * 4096 * 2 <= OFF_END, "U fits");
static_assert(OFF_END <= 536870912ull, "workspace");

struct Params {
  const float* xp; const float* xs; const float* meta;
  const float* attn_g; const float* w_in; const float* qa_g; const float* w_qb; const float* kva_g; const float* w_kvb;
  const float* gq_g; const float* gk_g; const float* mo_g; const float* go_g; const float* w_out; const float* mlp_g;
  const float* w_up; const float* w_dn; const float* fin_g;
  float* out; char* ws;
  int phase_lo, phase_hi, probe, pad_;
};


DI u32x4 ldg16(const void* p) { return *(const GAS u32x4*)p; }
DI void stg16(void* p, u32x4 v) { *(GAS u32x4*)p = v; }
DI void stg8(void* p, u32x2 v) { *(GAS u32x2*)p = v; }
typedef float f32x4v __attribute__((ext_vector_type(4)));
DI float4 ldgf4(const void* p) { const f32x4v v = *(const GAS f32x4v*)p; return make_float4(v.x, v.y, v.z, v.w); }
DI float ldgf(const float* p) { return *(const GAS float*)p; }
DI float2 ldgf2(const float2* p) { typedef float f32x2g __attribute__((ext_vector_type(2))); const f32x2g v = *(const GAS f32x2g*)p; return make_float2(v.x, v.y); }
DI void stgh(u16* p, u16 v) { *(GAS u16*)p = v; }
DI void stgf4(void* p, float4 v) { f32x4v w = {v.x, v.y, v.z, v.w}; *(GAS f32x4v*)p = w; }
DI unsigned pack2(float a, float b) { f32x2v f = {a, b}; bf16x2v v = __builtin_convertvector(f, bf16x2v); return __builtin_bit_cast(unsigned, v); }
DI u16 f2bf(float a) { return (u16)(pack2(a, 0.f) & 0xffffu); }
DI void store4(u16* dst, float a, float b, float c, float d) { u32x2 v = {pack2(a, b), pack2(c, d)}; *(u32x2*)dst = v; }
DI void store4g(u16* dst, float a, float b, float c, float d) { u32x2 v = {pack2(a, b), pack2(c, d)}; stg8(dst, v); }
DI int crow(int i, int h) { return (i & 3) + 8 * (i >> 2) + 4 * h; }
DI int swap23(int r) { return (r & 0x13) | ((r & 4) << 1) | ((r & 8) >> 1); }
DI float xhalf(float v) { return __shfl_xor(v, 32); }

DI void decode_tile(int T, int& seq, int& i) {
  if (T < 258) { seq = (T >= 129) ? 1 : 0; i = T - seq * 129; }
  else { int u = T - 258; int q = u / 65; seq = 2 + q; i = u - q * 65; }
}
DI int seq_base(int seq) { return seq < 2 ? seq * 16512 : 33024 + (seq - 2) * 8320; }

DI const float* xrow_src(const Params& p, int g, bool from_input) {
  int T = g >> 7, r = g & 127, seq, i; decode_tile(T, seq, i);
  if (i == 0) {
    if (r < 112) return nullptr;
    return from_input ? p.meta + (size_t)(r - 112) * 1024 : (const float*)(p.ws + OFF_XMETA) + (size_t)(seq * 16 + r - 112) * 1024;
  }
  int j = (i - 1) * 128 + r;
  if (seq < 2) { size_t row = (size_t)seq * 16384 + j; return from_input ? p.xp + row * 1024 : p.out + row * 1024; }
  size_t row = (size_t)(seq - 2) * 8192 + j;
  return from_input ? p.xs + row * 1024 : p.out + (32768 + row) * 1024;
}
DI float* xrow_dst(const Params& p, int g) {
  int T = g >> 7, r = g & 127, seq, i; decode_tile(T, seq, i);
  if (i == 0) {
    if (r < 112) return nullptr;
    return (float*)(p.ws + OFF_XMETA) + (size_t)(seq * 16 + r - 112) * 1024;
  }
  int j = (i - 1) * 128 + r;
  if (seq < 2) { size_t row = (size_t)seq * 16384 + j; return p.out + row * 1024; }
  size_t row = (size_t)(seq - 2) * 8192 + j;
  return p.out + (32768 + row) * 1024;
}

DI int mapcol(int kind, int n) {
  if (kind == 1) { if (n < 640) return n; if (n < 1408) return n + 32; if (n < 1440) return 640 + (n - 1408); return -1; }
  if (kind == 2) { if (n < 512) return (n >> 6) * 96 + (n & 63); int m = n - 512; return (m >> 5) * 96 + 64 + (m & 31); }
  if (kind == 3) { if (n < 512) return (n >> 6) * 128 + (n & 63); int m = n - 512; return (m >> 6) * 128 + 64 + (m & 63); }
  return n;
}
DI void prep_weight(const float* __restrict__ src, int Nsrc, u16* __restrict__ dst, int Nout, int K, const float* gA, const float* gB,
                    int ksplit, int kind, int gtid, int gthreads) {
  const int total = Nout * (K >> 3);
  for (int u = gtid; u < total; u += gthreads) {
    const int n = u % Nout, kc = u / Nout;
    const int col = mapcol(kind, n);
    const int k = kc * 8;
    float v[8];
#pragma unroll
    for (int j = 0; j < 8; ++j) {
      float x = 0.f;
      if (col >= 0) {
        x = src[(size_t)(k + j) * Nsrc + col];
        if (gA) x *= (k + j < ksplit) ? gA[k + j] : gB[k + j - ksplit];
      }
      v[j] = x;
    }
    u32x4 o = {pack2(v[0], v[1]), pack2(v[2], v[3]), pack2(v[4], v[5]), pack2(v[6], v[7])};
    *(u32x4*)(dst + (size_t)n * K + k) = o;
  }
}

DI void phase_prep(const Params& p, int tid) {
  const int gtid = blockIdx.x * 256 + tid, gthreads = gridDim.x * 256;
  u16* W = (u16*)(p.ws + OFF_W);
  for (int l = 0; l < 2; ++l) {
    u16* Wl = W + (size_t)l * W_LAYER;
    prep_weight(p.w_in + (size_t)l * 1024 * 1440, 1440, Wl + WO_IN, 1536, 1024, nullptr, nullptr, 0, 1, gtid, gthreads);
    prep_weight(p.w_qb + (size_t)l * 384 * 768, 768, Wl + WO_QB, 768, 384, p.qa_g + l * 384, p.qa_g + l * 384, 384, 2, gtid, gthreads);
    prep_weight(p.w_kvb + (size_t)l * 256 * 1024, 1024, Wl + WO_KVB, 1024, 256, p.kva_g + l * 256, p.kva_g + l * 256, 256, 3, gtid, gthreads);
    prep_weight(p.w_out + (size_t)l * 1024 * 1024, 1024, Wl + WO_OUT, 1024, 1024, p.mo_g + l * 512, p.go_g + l * 512, 512, 0, gtid, gthreads);
    prep_weight(p.w_up + (size_t)l * 1024 * 4096, 4096, Wl + WO_UP, 4096, 1024, nullptr, nullptr, 0, 0, gtid, gthreads);
    prep_weight(p.w_dn + (size_t)l * 4096 * 1024, 1024, Wl + WO_DN, 1024, 4096, nullptr, nullptr, 0, 0, gtid, gthreads);
  }
  float2* tab = (float2*)(p.ws + OFF_TAB);
  for (int u = gtid; u < 16400 * 16; u += gthreads) {
    const int pos = u >> 4, f = u & 15;
    const float invf = 1.0f / powf(10000.0f, (float)(2 * f) / 32.0f);
    const float ang = (float)pos * invf;
    const double rev = (double)ang * 0.15915494309189535;
    const double fr = rev - rint(rev);
    const float x = (float)(2.0 * fr);
    tab[u] = make_float2(cospif(x), sinpif(x));
  }
  float* xm = (float*)(p.ws + OFF_XMETA);
  for (int u = gtid; u < 96 * 1024; u += gthreads) xm[u] = p.meta[u & 16383];
  int* cnt = (int*)(p.ws + OFF_CNT);
  if (gtid < 64) cnt[gtid] = 0;
  unsigned* bar = (unsigned*)(p.ws + OFF_BAR);
  if (gtid < 4096) bar[gtid] = 0u;
}

DI void phase_norm(const Params& p, const float* __restrict__ gain, bool from_input, bool zero_ssq, int tid) {
  const int lane = tid & 63;
  const int gw = blockIdx.x * 4 + (tid >> 6), nw = gridDim.x * 4;
  u16* HN = (u16*)(p.ws + OFF_HN);
  float* ssq = (float*)(p.ws + OFF_SSQ);
  for (int g = gw; g < MPAD; g += nw) {
    const float* xr = xrow_src(p, g, from_input);
    u16* hr = HN + (size_t)g * 1024;
    if (!xr) {
      u32x4 z = {0u, 0u, 0u, 0u};
      *(u32x4*)(hr + lane * 16) = z;
      *(u32x4*)(hr + lane * 16 + 8) = z;
    } else {
      float4 v[4];
#pragma unroll
      for (int q = 0; q < 4; ++q) v[q] = ldgf4((const float4*)xr + lane + 64 * q);
      float ss = 0.f;
#pragma unroll
      for (int q = 0; q < 4; ++q) ss += v[q].x * v[q].x + v[q].y * v[q].y + v[q].z * v[q].z + v[q].w * v[q].w;
#pragma unroll
      for (int o = 32; o >= 1; o >>= 1) ss += __shfl_xor(ss, o);
      const float rstd = rsqrtf(ss * (1.0f / 1024.0f) + EPS);
#pragma unroll
      for (int q = 0; q < 4; ++q) {
        const float4 gg = ldgf4((const float4*)gain + lane + 64 * q);
        store4g(hr + 4 * (lane + 64 * q), v[q].x * rstd * gg.x, v[q].y * rstd * gg.y, v[q].z * rstd * gg.z, v[q].w * rstd * gg.w);
      }
    }
    if (zero_ssq && lane < 4) ssq[(size_t)lane * MPAD + g] = 0.f;
  }
}

DI void phase_final(const Params& p, int tid) {
  const int lane = tid & 63;
  const int gw = blockIdx.x * 4 + (tid >> 6), nw = gridDim.x * 4;
  for (int g = gw; g < MPAD; g += nw) {
    if (((g >> 7) == 0) || ((g >> 7) == 129) || ((g >> 7) >= 258 && ((g >> 7) - 258) % 65 == 0)) continue;
    float* xr = xrow_dst(p, g);
    float4 v[4];
#pragma unroll
    for (int q = 0; q < 4; ++q) v[q] = ldgf4((const float4*)xr + lane + 64 * q);
    float ss = 0.f;
#pragma unroll
    for (int q = 0; q < 4; ++q) ss += v[q].x * v[q].x + v[q].y * v[q].y + v[q].z * v[q].z + v[q].w * v[q].w;
#pragma unroll
    for (int o = 32; o >= 1; o >>= 1) ss += __shfl_xor(ss, o);
    const float rstd = rsqrtf(ss * (1.0f / 1024.0f) + EPS);
#pragma unroll
    for (int q = 0; q < 4; ++q) {
      const float4 gg = ldgf4((const float4*)p.fin_g + lane + 64 * q);
      float4 o = make_float4(v[q].x * rstd * gg.x, v[q].y * rstd * gg.y, v[q].z * rstd * gg.z, v[q].w * rstd * gg.w);
      stgf4((float4*)xr + lane + 64 * q, o);
    }
  }
}

constexpr int GP = 72;
struct APLin { const u16* A; int lda; DI const u16* ptr(int row, int k0) const { return A + (size_t)row * lda + k0; } };
struct APMix { const u16* QM; const u16* QG;
  DI const u16* ptr(int row, int k0) const { return k0 < 512 ? QM + (size_t)row * 768 + (k0 >> 6) * 96 : QG + (size_t)row * 512 + (k0 - 512); } };

template <bool MIDK, class AP, class EPI>
DI void gemm_tile(const AP& ap, const u16* __restrict__ W, int ldw, int K, int m0, int n0, const EPI& epi, char* smem, float r0, float r1, int tid, bool dry) {
  constexpr int SBUF = 2 * 128 * GP;
  u16* sA = (u16*)smem;
  u16* sB = sA + 128 * GP;
  const int lane = tid & 63, wave = tid >> 6, r = lane & 31, h = lane >> 5, wm = wave >> 1, wn = wave & 1;
  const int lrow = tid >> 3, lkc = (tid & 7) * 8;
  u32x4 ra0[4], rb0[4], ra1[4], rb1[4];
  f32x16 acc[2][2];
#pragma unroll
  for (int a = 0; a < 2; ++a)
#pragma unroll
    for (int b = 0; b < 2; ++b)
#pragma unroll
      for (int i = 0; i < 16; ++i) acc[a][b][i] = 0.f;
  const int nk = K >> 6;
#define GLOADQ(RA, RB, KT, q) do { const int k0_ = (KT) << 6; \
    RA[q] = ldg16(ap.ptr(m0 + lrow + 32 * (q), k0_) + lkc); RB[q] = ldg16(W + (size_t)(n0 + lrow + 32 * (q)) * ldw + k0_ + lkc); } while (0)
#define GLOAD(RA, RB, KT) do { GLOADQ(RA, RB, KT, 0); GLOADQ(RA, RB, KT, 1); GLOADQ(RA, RB, KT, 2); GLOADQ(RA, RB, KT, 3); } while (0)
#define SSTOREQ(RA, RB, ST, q) do { \
    *(u32x4*)(sA + (ST) * SBUF + (lrow + 32 * (q)) * GP + lkc) = RA[q]; *(u32x4*)(sB + (ST) * SBUF + (lrow + 32 * (q)) * GP + lkc) = RB[q]; } while (0)
#define SSTORE(RA, RB, ST) do { SSTOREQ(RA, RB, ST, 0); SSTOREQ(RA, RB, ST, 1); SSTOREQ(RA, RB, ST, 2); SSTOREQ(RA, RB, ST, 3); } while (0)
#define FLOAD(F, ST, ks) do { _Pragma("unroll") for (int a = 0; a < 2; ++a) { \
    F[a] = *(const bf16x8*)(sB + (ST) * SBUF + (wn * 64 + a * 32 + r) * GP + (ks) * 16 + h * 8); \
    F[2 + a] = *(const bf16x8*)(sA + (ST) * SBUF + (wm * 64 + a * 32 + r) * GP + (ks) * 16 + h * 8); } } while (0)
#define FMMA(F) do { _Pragma("unroll") for (int a = 0; a < 2; ++a) _Pragma("unroll") for (int b = 0; b < 2; ++b) acc[a][b] = MFMA(F[a], F[2 + b], acc[a][b]); } while (0)
  bf16x8 f0[4], f1[4];
  GLOAD(ra0, rb0, 0);
  GLOAD(ra1, rb1, 1);
  __syncthreads();
  SSTORE(ra0, rb0, 0);
  if (nk > 2) GLOAD(ra0, rb0, 2);
  __syncthreads();
  for (int kt = 0; kt < nk; kt += 2) {
    const bool l3 = kt + 3 < nk, s2 = kt + 2 < nk, l4 = kt + 4 < nk;
    FLOAD(f0, 0, 0); FLOAD(f1, 0, 1);
    FMMA(f0); SSTOREQ(ra1, rb1, 1, 0); if (l3) GLOADQ(ra1, rb1, kt + 3, 0);
    FLOAD(f0, 0, 2);
    FMMA(f1); SSTOREQ(ra1, rb1, 1, 1); if (l3) GLOADQ(ra1, rb1, kt + 3, 1);
    FLOAD(f1, 0, 3);
    FMMA(f0); SSTOREQ(ra1, rb1, 1, 2); if (l3) GLOADQ(ra1, rb1, kt + 3, 2);
    FMMA(f1); SSTOREQ(ra1, rb1, 1, 3); if (l3) GLOADQ(ra1, rb1, kt + 3, 3);
    __syncthreads();
    FLOAD(f0, 1, 0); FLOAD(f1, 1, 1);
    FMMA(f0); if (s2) SSTOREQ(ra0, rb0, 0, 0); if (l4) GLOADQ(ra0, rb0, kt + 4, 0);
    FLOAD(f0, 1, 2);
    FMMA(f1); if (s2) SSTOREQ(ra0, rb0, 0, 1); if (l4) GLOADQ(ra0, rb0, kt + 4, 1);
    FLOAD(f1, 1, 3);
    FMMA(f0); if (s2) SSTOREQ(ra0, rb0, 0, 2); if (l4) GLOADQ(ra0, rb0, kt + 4, 2);
    FMMA(f1); if (s2) SSTOREQ(ra0, rb0, 0, 3); if (l4) GLOADQ(ra0, rb0, kt + 4, 3);
    if (MIDK && kt == 6) {
#pragma unroll
      for (int a = 0; a < 2; ++a)
#pragma unroll
        for (int i = 0; i < 16; ++i) { acc[a][0][i] *= r0; acc[a][1][i] *= r1; }
    }
    __syncthreads();
  }
#undef GLOADQ
#undef SSTOREQ
#undef FLOAD
#undef FMMA
#undef GLOAD
#undef SSTORE
  if (!dry) epi(acc, n0 + wn * 64, m0 + wm * 64, lane, (u16*)smem + wave * 64 * GP);
}

struct ColId { DI int operator()(int ch) const { return ch * 8; } };
struct ColRope { DI int operator()(int ch) const { return (ch >> 2) * 96 + (ch & 3) * 8; } };

template <class COLF>
DI void stage_store(f32x16 (&acc)[2][2], u16* wl, int lane, u16* dst0, size_t pitch, const COLF& colf) {
  const int r = lane & 31, h = lane >> 5;
#pragma unroll
  for (int rb = 0; rb < 2; ++rb)
#pragma unroll
    for (int lb = 0; lb < 2; ++lb)
#pragma unroll
      for (int g4 = 0; g4 < 4; ++g4)
        store4(wl + (lb * 32 + r) * GP + rb * 32 + 8 * g4 + 4 * h, acc[rb][lb][4 * g4], acc[rb][lb][4 * g4 + 1], acc[rb][lb][4 * g4 + 2], acc[rb][lb][4 * g4 + 3]);
  WAVE_LDS_FENCE();
#pragma unroll
  for (int it = 0; it < 8; ++it) {
    const int row = it * 8 + (lane >> 3), ch = lane & 7;
    const u32x4 v = *(const u32x4*)(wl + row * GP + ch * 8);
    stg16(dst0 + (size_t)row * pitch + colf(ch), v);
  }
  WAVE_LDS_FENCE();
}

DI void rope16(float (&v)[16], const float2* __restrict__ tabrow, int h) {
#pragma unroll
  for (int i = 0; i < 8; ++i) {
    const int f = (i & 3) + 8 * (i >> 2) + 4 * h;
    const float2 cs = ldgf2(tabrow + f);
    const float x1 = v[i], x2 = v[i + 8];
    v[i] = x1 * cs.x - x2 * cs.y;
    v[i + 8] = x2 * cs.x + x1 * cs.y;
  }
}

struct EpiIn {
  u16 *CQ, *CKV, *QG, *KG, *VGT, *KPE; float *ssq_q, *ssq_kv; const float *gq_g, *gk_g; const float2* tab;
  DI void operator()(f32x16 (&acc)[2][2], int nb, int mb, int lane, u16* wl) const {
    const int r = lane & 31, h = lane >> 5;
    int seq, it; decode_tile(mb >> 7, seq, it);
#pragma unroll
    for (int ti = 0; ti < 2; ++ti) {
      const int g = mb + ti * 32 + r, rr = g & 127;
      if (nb < 640) {
        float ss = 0.f;
#pragma unroll
        for (int fi = 0; fi < 2; ++fi)
#pragma unroll
          for (int i = 0; i < 16; ++i) ss += acc[fi][ti][i] * acc[fi][ti][i];
        ss += xhalf(ss);
        if (h == 0) unsafeAtomicAdd((nb < 384 ? ssq_q : ssq_kv) + g, ss);
      } else if (nb < 1280) {
        const bool isq = nb < 1152;
        const float* gg = isq ? gq_g : gk_g;
        float ss = 0.f;
#pragma unroll
        for (int fi = 0; fi < 2; ++fi)
#pragma unroll
          for (int i = 0; i < 16; ++i) ss += acc[fi][ti][i] * acc[fi][ti][i];
        ss += xhalf(ss);
        const float rstd = rsqrtf(ss * (1.0f / 64.0f) + EPS);
        const float osc = isq ? QSCALE_G : 1.0f;
        int prow = 0, pcol = 0;
        if (it > 0) { const int j = (it - 1) * 128 + rr; prow = j >> 6; pcol = j & 63; }
        u16* dst = isq ? QG + (size_t)g * 512 + (nb - 640) : KG + (size_t)g * 128 + (nb - 1152);
#pragma unroll
        for (int fi = 0; fi < 2; ++fi) {
          const int pos = fi == 0 ? prow : pcol;
          float v[16];
#pragma unroll
          for (int i = 0; i < 16; ++i) v[i] = acc[fi][ti][i] * rstd * ldgf(gg + fi * 32 + crow(i, h));
          rope16(v, tab + pos * 16, h);
#pragma unroll
          for (int g4 = 0; g4 < 4; ++g4)
            store4g(dst + fi * 32 + 8 * g4 + 4 * h, v[4 * g4] * osc, v[4 * g4 + 1] * osc, v[4 * g4 + 2] * osc, v[4 * g4 + 3] * osc);
        }
      } else if (nb < 1408) {
#pragma unroll
        for (int fi = 0; fi < 2; ++fi)
#pragma unroll
          for (int i = 0; i < 16; ++i) stgh(VGT + (size_t)(nb - 1280 + fi * 32 + crow(i, h)) * MPAD + g, f2bf(acc[fi][ti][i]));
      } else if (nb == 1408) {
        int pos = 128 * it + rr - 112; pos = pos < 0 ? 0 : pos;
        float v[16];
#pragma unroll
        for (int i = 0; i < 16; ++i) v[i] = acc[0][ti][i];
        rope16(v, tab + pos * 16, h);
#pragma unroll
        for (int g4 = 0; g4 < 4; ++g4) store4g(KPE + (size_t)g * 32 + 8 * g4 + 4 * h, v[4 * g4], v[4 * g4 + 1], v[4 * g4 + 2], v[4 * g4 + 3]);
      }
    }
    if (nb < 384) stage_store(acc, wl, lane, CQ + (size_t)mb * 384 + nb, 384, ColId());
    else if (nb < 640) stage_store(acc, wl, lane, CKV + (size_t)mb * 256 + (nb - 384), 256, ColId());
  }
};

struct EpiQB {
  u16* QM; const float* ssq_q; const float2* tab;
  DI void operator()(f32x16 (&acc)[2][2], int nb, int mb, int lane, u16* wl) const {
    const int r = lane & 31, h = lane >> 5;
    int seq, it; decode_tile(mb >> 7, seq, it);
#pragma unroll
    for (int ti = 0; ti < 2; ++ti) {
      const int g = mb + ti * 32 + r, rr = g & 127;
      const float sc = rsqrtf(ldgf(ssq_q + g) * (1.0f / 384.0f) + EPS) * QSCALE_M;
      if (nb < 512) {
#pragma unroll
        for (int fi = 0; fi < 2; ++fi)
#pragma unroll
          for (int i = 0; i < 16; ++i) acc[fi][ti][i] *= sc;
      } else {
        int pos = 128 * it + rr - 112; pos = pos < 0 ? 0 : pos;
#pragma unroll
        for (int fi = 0; fi < 2; ++fi) {
          float v[16];
#pragma unroll
          for (int i = 0; i < 16; ++i) v[i] = acc[fi][ti][i] * sc;
          rope16(v, tab + pos * 16, h);
#pragma unroll
          for (int i = 0; i < 16; ++i) acc[fi][ti][i] = v[i];
        }
      }
    }
    if (nb < 512) stage_store(acc, wl, lane, QM + (size_t)mb * 768 + (nb >> 6) * 96, 768, ColId());
    else stage_store(acc, wl, lane, QM + (size_t)mb * 768 + ((nb - 512) >> 5) * 96 + 64, 768, ColRope());
  }
};

struct EpiKVB {
  u16 *KN, *VMT; const float* ssq_kv;
  DI void operator()(f32x16 (&acc)[2][2], int nb, int mb, int lane, u16* wl) const {
    const int r = lane & 31, h = lane >> 5;
#pragma unroll
    for (int ti = 0; ti < 2; ++ti) {
      const int g = mb + ti * 32 + r;
      const float sc = rsqrtf(ldgf(ssq_kv + g) * (1.0f / 256.0f) + EPS);
      if (nb < 512) {
#pragma unroll
        for (int fi = 0; fi < 2; ++fi)
#pragma unroll
          for (int i = 0; i < 16; ++i) acc[fi][ti][i] *= sc;
      } else {
#pragma unroll
        for (int fi = 0; fi < 2; ++fi)
#pragma unroll
          for (int i = 0; i < 16; ++i) stgh(VMT + (size_t)(nb - 512 + fi * 32 + crow(i, h)) * MPAD + g, f2bf(acc[fi][ti][i] * sc));
      }
    }
    if (nb < 512) stage_store(acc, wl, lane, KN + (size_t)mb * 512 + nb, 512, ColId());
  }
};

DI void res_bases(const Params& p, int mt, bool from_input, const float*& sb, float*& db, int& minrow) {
  int seq, it; decode_tile(mt, seq, it);
  float* xm = (float*)(p.ws + OFF_XMETA);
  if (it == 0) {
    minrow = 112;
    db = xm + ((ptrdiff_t)seq * 16 - 112) * 1024;
    sb = from_input ? p.meta - 112 * 1024 : db;
  } else {
    minrow = 0;
    const size_t row = seq < 2 ? (size_t)seq * 16384 + (size_t)(it - 1) * 128 : 32768 + (size_t)(seq - 2) * 8192 + (size_t)(it - 1) * 128;
    db = p.out + row * 1024;
    sb = from_input ? (seq < 2 ? p.xp + row * 1024 : p.xs + (row - 32768) * 1024) : db;
  }
}

struct EpiRes {
  const float* sb; float* db; int minrow; float fin0, fin1;
  DI void operator()(f32x16 (&acc)[2][2], int nb, int mb, int lane, u16* wl) const {
    const int r = lane & 31, h = lane >> 5, mbl = mb & 127;
    float* wf = (float*)wl;
#pragma unroll
    for (int fi = 0; fi < 2; ++fi) {
#pragma unroll
      for (int ti = 0; ti < 2; ++ti) {
        const float sc = ti == 0 ? fin0 : fin1;
#pragma unroll
        for (int g4 = 0; g4 < 4; ++g4) {
          float4 o = make_float4(acc[fi][ti][4 * g4] * sc, acc[fi][ti][4 * g4 + 1] * sc, acc[fi][ti][4 * g4 + 2] * sc, acc[fi][ti][4 * g4 + 3] * sc);
          *(float4*)(wf + (ti * 32 + r) * 36 + 8 * g4 + 4 * h) = o;
        }
      }
      WAVE_LDS_FENCE();
#pragma unroll
      for (int it = 0; it < 8; ++it) {
        const int row = it * 8 + (lane >> 3), ch = lane & 7;
        const float4 a = *(const float4*)(wf + row * 36 + ch * 4);
        const int trow = mbl + row;
        if (trow >= minrow) {
          const size_t off = (size_t)trow * 1024 + nb + fi * 32 + ch * 4;
          float4 x = ldgf4(sb + off);
          x.x += a.x; x.y += a.y; x.z += a.z; x.w += a.w;
          stgf4(db + off, x);
        }
      }
      WAVE_LDS_FENCE();
    }
  }
};

struct EpiUp {
  u16* U0;
  DI void operator()(f32x16 (&acc)[2][2], int nb, int mb, int lane, u16* wl) const {
#pragma unroll
    for (int ti = 0; ti < 2; ++ti)
#pragma unroll
      for (int fi = 0; fi < 2; ++fi)
#pragma unroll
        for (int i = 0; i < 16; ++i) { const float a = fmaxf(acc[fi][ti][i], 0.f); acc[fi][ti][i] = a * a; }
    stage_store(acc, wl, lane, U0 + (size_t)mb * 4096 + nb, 4096, ColId());
  }
};

constexpr float ATT_THR = 8.0f;

template <int DQK>
struct AttnCtx {
  static constexpr int KP = DQK + 8, NKS = DQK / 16, KCH = DQK / 8, NKL = 64 * KCH / 256, KBUF = 64 * KP, VBUF = 64 * GP;
  const u16 *Kb, *KPEb, *Vt; int kpitch, rowk0, nt, tid, r, h, sr;
  u16 *sK, *sV;
  bf16x8 qf[NKS], kone, qm;
  f32x16 o[2];
  float mref, l;
  u32x4 rk[NKL], rv[2];

  int koff[NKL], voff[2];
  DI void init_offs() {
#pragma unroll
    for (int q = 0; q < NKL; ++q) {
      const int c = tid + 256 * q, row = c / KCH, cc = c % KCH;
      koff[q] = (DQK == 96 && cc >= 8) ? row * 32 + (cc - 8) * 8 : row * kpitch + cc * 8;
    }
#pragma unroll
    for (int q = 0; q < 2; ++q) { const int c = tid + 256 * q, dv = c >> 3, kc = c & 7; voff[q] = dv * MPAD + kc * 8; }
  }
  DI void gload_k(int t) {
    const int row0 = rowk0 + t * 64;
    const u16* kt = Kb + (size_t)row0 * kpitch;
    const u16* pt = KPEb + (size_t)row0 * 32;
#pragma unroll
    for (int q = 0; q < NKL; ++q) {
      const int c = tid + 256 * q, cc = c % KCH;
      rk[q] = ldg16(((DQK == 96 && cc >= 8) ? pt : kt) + koff[q]);
    }
  }
  DI void gload_v(int t) {
    const u16* vt = Vt + (rowk0 + t * 64);
#pragma unroll
    for (int q = 0; q < 2; ++q) rv[q] = ldg16(vt + voff[q]);
  }
  DI void sstore_k(int buf) {
#pragma unroll
    for (int q = 0; q < NKL; ++q) {
      const int c = tid + 256 * q, row = c / KCH, cc = c % KCH;
      *(u32x4*)(sK + buf * KBUF + row * KP + cc * 8) = rk[q];
    }
  }
  DI void sstore_v(int buf) {
#pragma unroll
    for (int q = 0; q < 2; ++q) {
      const int c = tid + 256 * q, dv = c >> 3, kc = c & 7;
      *(u32x4*)(sV + buf * VBUF + dv * GP + kc * 8) = rv[q];
    }
  }
  DI void qk(int buf, f32x16 (&s)[2]) {
    const u16* kb = sK + buf * KBUF + sr * KP + h * 8;
#pragma unroll
    for (int kb2 = 0; kb2 < 2; ++kb2)
#pragma unroll
      for (int i = 0; i < 16; ++i) s[kb2][i] = 0.f;
#pragma unroll
    for (int ks = 0; ks < NKS; ++ks)
#pragma unroll
      for (int kb2 = 0; kb2 < 2; ++kb2) {
        const bf16x8 a = *(const bf16x8*)(kb + kb2 * 32 * KP + ks * 16);
        s[kb2] = MFMA(a, qf[ks], s[kb2]);
      }
    s[0] = MFMA(kone, qm, s[0]);
    s[1] = MFMA(kone, qm, s[1]);
  }
  template <int PAR>
  DI void step(int t, f32x16 (&cur)[2], f32x16 (&nxt)[2]) {
    if (t + 1 < nt) sstore_k(PAR ^ 1);
    if (t > 0) sstore_v(PAR);
    __syncthreads();
    if (t + 1 < nt) qk(PAR ^ 1, nxt);
    float mx = fmaxf(cur[0][0], cur[1][0]);
#pragma unroll
    for (int i = 1; i < 16; ++i) mx = fmaxf(fmaxf(cur[0][i], cur[1][i]), mx);
    if (__builtin_amdgcn_ballot_w64(mx > ATT_THR) != 0ull) {
      asm volatile("" ::: "memory");
      mx = fmaxf(mx, xhalf(mx));
      const float want = mref + fmaxf(mx, 0.f);
      const float mn = __uint_as_float(pack2(want, 0.f) << 16);
      const float d = mn - mref;
      const float alpha = __builtin_amdgcn_exp2f(-d);
      mref = mn;
      l *= alpha;
#pragma unroll
      for (int a = 0; a < 2; ++a)
#pragma unroll
        for (int i = 0; i < 16; ++i) { o[a][i] *= alpha; cur[a][i] -= d; nxt[a][i] -= d; }
      u32x4 q4 = {h == 0 ? (pack2(-mn, 0.f) & 0xffffu) : 0u, 0u, 0u, 0u};
      qm = __builtin_bit_cast(bf16x8, q4);
    }
    float psum = 0.f;
#pragma unroll
    for (int kb2 = 0; kb2 < 2; ++kb2)
#pragma unroll
      for (int i = 0; i < 16; ++i) { const float pv = __builtin_amdgcn_exp2f(cur[kb2][i]); cur[kb2][i] = pv; psum += pv; }
    l += psum;
    if (t + 2 < nt) gload_k(t + 2);
    if (t + 1 < nt) gload_v(t + 1);
    const u16* vb = sV + PAR * VBUF + r * GP + h * 8;
#pragma unroll
    for (int kb2 = 0; kb2 < 2; ++kb2)
#pragma unroll
      for (int s2 = 0; s2 < 2; ++s2) {
        u32x4 pk = {pack2(cur[kb2][8 * s2], cur[kb2][8 * s2 + 1]), pack2(cur[kb2][8 * s2 + 2], cur[kb2][8 * s2 + 3]),
                    pack2(cur[kb2][8 * s2 + 4], cur[kb2][8 * s2 + 5]), pack2(cur[kb2][8 * s2 + 6], cur[kb2][8 * s2 + 7])};
        const bf16x8 pf = __builtin_bit_cast(bf16x8, pk);
#pragma unroll
        for (int db = 0; db < 2; ++db) {
          const bf16x8 a = *(const bf16x8*)(vb + db * 32 * GP + kb2 * 32 + s2 * 16);
          o[db] = MFMA(a, pf, o[db]);
        }
      }
  }
};

template <int DQK>
DI void attn_item(const u16* __restrict__ Qb, int qpitch, const u16* __restrict__ Kb, int kpitch, const u16* __restrict__ KPEb,
                  const u16* __restrict__ Vt, float* __restrict__ ssq, int rowq0, int rowk0, int nt, char* smem, int tid, bool dry) {
  typedef AttnCtx<DQK> C;
  C c;
  const int lane = tid & 63, wave = tid >> 6, r = lane & 31, h = lane >> 5;
  c.Kb = Kb; c.KPEb = KPEb; c.Vt = Vt; c.kpitch = kpitch; c.rowk0 = rowk0; c.nt = nt; c.tid = tid; c.r = r; c.h = h; c.sr = swap23(r);
  c.sK = (u16*)smem; c.sV = c.sK + 2 * C::KBUF;
  c.init_offs();
  const int myrow = rowq0 + wave * 32 + r;
  {
    const u16* qrow = Qb + (size_t)myrow * qpitch + h * 8;
#pragma unroll
    for (int ks = 0; ks < C::NKS; ++ks) c.qf[ks] = __builtin_bit_cast(bf16x8, ldg16(qrow + ks * 16));
  }
#pragma unroll
  for (int a = 0; a < 2; ++a)
#pragma unroll
    for (int i = 0; i < 16; ++i) c.o[a][i] = 0.f;
  c.mref = 0.f; c.l = 0.f;
  {
    u32x4 k1 = {h == 0 ? 0x3F80u : 0u, 0u, 0u, 0u}, z4 = {0u, 0u, 0u, 0u};
    c.kone = __builtin_bit_cast(bf16x8, k1); c.qm = __builtin_bit_cast(bf16x8, z4);
  }
  f32x16 sa[2], sb[2];
  c.gload_k(0); c.gload_v(0);
  __syncthreads();
  c.sstore_k(0); c.sstore_v(0);
  if (nt > 1) c.gload_k(1);
  __syncthreads();
  c.qk(0, sa);
#pragma unroll
  for (int i = 0; i < 16; ++i) {
    sa[0][i] = -1e30f;
    if (swap23(crow(i, h)) < 16) sa[1][i] = -1e30f;
  }
  int t = 0;
  for (; t + 1 < nt; t += 2) {
    c.template step<0>(t, sa, sb);
    c.template step<1>(t + 1, sb, sa);
  }
  if (t < nt) c.template step<0>(t, sa, sb);
  if (dry) return;
  float l = c.l;
  l += xhalf(l);
  const float inv = 1.0f / l;
  float ss = 0.f;
  u16* orow = (u16*)Qb + (size_t)myrow * qpitch;
#pragma unroll
  for (int db = 0; db < 2; ++db)
#pragma unroll
    for (int g4 = 0; g4 < 4; ++g4) {
      const float a0 = c.o[db][4 * g4] * inv, a1 = c.o[db][4 * g4 + 1] * inv, a2 = c.o[db][4 * g4 + 2] * inv, a3 = c.o[db][4 * g4 + 3] * inv;
      ss += a0 * a0 + a1 * a1 + a2 * a2 + a3 * a3;
      store4g(orow + db * 32 + 8 * g4 + 4 * h, a0, a1, a2, a3);
    }
  ss += xhalf(ss);
  if (h == 0) unsafeAtomicAdd(ssq + myrow, ss);
}

constexpr int N_ITEMS = 8288;
DI void phase_attn(const Params& p, int layer, char* smem, int* s_item, int tid, bool dry) {
  int* cnt = (int*)(p.ws + OFF_CNT) + layer + (dry ? 2 : 0);
  u16* QM = (u16*)(p.ws + OFF_HN);
  const u16* KN = (const u16*)(p.ws + OFF_KN);
  const u16* KPE = (const u16*)(p.ws + OFF_KPE);
  const u16* VMT = (const u16*)(p.ws + OFF_VMT);
  u16* QG = (u16*)(p.ws + OFF_QG);
  const u16* KG = (const u16*)(p.ws + OFF_KG);
  const u16* VGT = (const u16*)(p.ws + OFF_VGT);
  float* ssq = (float*)(p.ws + OFF_SSQ);
  for (;;) {
    if (tid == 0) *s_item = atomicAdd(cnt, 1);
    __syncthreads();
    const int it = *s_item;
    __syncthreads();
    if (it >= N_ITEMS) break;
    int grp, seq, head, qi, nt;
    if (it < 4128) { grp = it / 2064; const int u = it - grp * 2064; const int sh = u / 129; qi = u - sh * 129; seq = sh >> 3; head = sh & 7; nt = 257; }
    else { const int u0 = it - 4128; grp = u0 / 2080; const int u = u0 - grp * 2080; const int sh = u / 65; qi = u - sh * 65; seq = 2 + (sh >> 3); head = sh & 7; nt = 129; }
    const int P = seq_base(seq);
    if (grp == 0)
      attn_item<96>(QM + head * 96, 768, KN + head * 64, 512, KPE, VMT + (size_t)head * 64 * MPAD, ssq + 2 * (size_t)MPAD, P + qi * 128, P + 64, nt, smem, tid, dry);
    else
      attn_item<64>(QG + head * 64, 512, KG + (head >> 2) * 64, 128, nullptr, VGT + (size_t)(head >> 2) * 64 * MPAD, ssq + 3 * (size_t)MPAD, P + qi * 128, P + 64, nt, smem, tid, dry);
  }
}

#define XB_TMO      128
#define XB_XCNT(j)  (256  + 64 * (j))
#define XB_XSUB(j)  (1280 + 64 * (j))
#define XB_XGEN(j)  (2304 + 64 * (j))
#define XB_TOP      3328
#define XB_TOPGEN   3392
#define XCD_BAR_WORDS 3456
#define XB_SPIN_CAP (1u << 18)
#define LAS __attribute__((address_space(3)))

__device__ __forceinline__ unsigned xb_ld(unsigned* p)              { return __hip_atomic_load(p, __ATOMIC_RELAXED, __HIP_MEMORY_SCOPE_AGENT); }
__device__ __forceinline__ unsigned xb_add(unsigned* p, unsigned v) { return __hip_atomic_fetch_add(p, v, __ATOMIC_RELAXED, __HIP_MEMORY_SCOPE_AGENT); }
__device__ __forceinline__ unsigned xb_xcc_id() { return (unsigned)__builtin_amdgcn_s_getreg((3 << 11) | 20) & 0xFu; }
#define XB_SPIN(cond, bar) do { unsigned _sp = 0; while (cond) { __builtin_amdgcn_s_sleep(1); \
    if ((++_sp & 255u) == 0u) { if (xb_ld(&(bar)[XB_TMO])) break; if (_sp > XB_SPIN_CAP) { atomicAdd(&(bar)[XB_TMO], 1u); break; } } } } while (0)

struct XcdBarrier {
    unsigned* bar; unsigned x;
    volatile LAS unsigned* st;
};

__device__ __forceinline__ XcdBarrier xcd_barrier_post(unsigned* bar, volatile LAS unsigned* st) {
    XcdBarrier b; b.bar = bar; b.x = xb_xcc_id(); b.st = st;
    if (threadIdx.x == 0) (void)xb_add(&bar[XB_XCNT(b.x)], 1u);
    return b;
}
__device__ __forceinline__ void xcd_barrier_complete(unsigned* bar, unsigned x, unsigned& nloc, unsigned& nx) {
    const unsigned G = gridDim.x * gridDim.y * gridDim.z;
    unsigned sum, cnt, mine, sp = 0u;
    for (;;) {
        sum = 0u; cnt = 0u; mine = 0u;
#pragma unroll
        for (unsigned j = 0; j < 16; ++j) { const unsigned c = xb_ld(&bar[XB_XCNT(j)]); sum += c; cnt += (c > 0u) ? 1u : 0u; mine = (j == x) ? c : mine; }
        if (sum == G) break;
        __builtin_amdgcn_s_sleep(1);
        if ((++sp & 255u) == 0u) { if (xb_ld(&bar[XB_TMO])) break; if (sp > XB_SPIN_CAP) { atomicAdd(&bar[XB_TMO], 1u); break; } }
    }
    nloc = mine > 0u ? mine : 1u; nx = cnt > 0u ? cnt : 1u;
}

__device__ __forceinline__ void xcd_barrier(const XcdBarrier& b) {
    asm volatile("s_waitcnt vmcnt(0)" ::: "memory");
    __syncthreads();
    if (threadIdx.x == 0) {
        unsigned* bar = b.bar;
        __builtin_amdgcn_s_waitcnt(0);
        unsigned nloc = b.st[0], nx = b.st[1];
        if (nloc == 0u) { xcd_barrier_complete(bar, b.x, nloc, nx); b.st[0] = nloc; b.st[1] = nx; }
        const unsigned old = xb_add(&bar[XB_XSUB(b.x)], 1u);
        const unsigned gen = old / nloc;
        if (old + 1u == (gen + 1u) * nloc) {
            __builtin_amdgcn_fence(__ATOMIC_RELEASE, "agent");
            asm volatile("s_waitcnt vmcnt(0)" ::: "memory");
            const unsigned og = xb_add(&bar[XB_TOP], 1u);
            const unsigned tg = og / nx;
            if (og + 1u == (tg + 1u) * nx) xb_add(&bar[XB_TOPGEN], 1u);
            else XB_SPIN(xb_ld(&bar[XB_TOPGEN]) == tg, bar);
            __builtin_amdgcn_fence(__ATOMIC_ACQUIRE, "agent");
            xb_add(&bar[XB_XGEN(b.x)], 1u);
            asm volatile("s_waitcnt vmcnt(0)" ::: "memory");
        } else {
            XB_SPIN(xb_ld(&bar[XB_XGEN(b.x)]) == gen, bar);
            __builtin_amdgcn_fence(__ATOMIC_ACQUIRE, "agent");
            asm volatile("s_waitcnt vmcnt(0)" ::: "memory");
        }
    }
    __syncthreads();
}


__global__ void __launch_bounds__(256, 2) mega(Params pin) {
  __shared__ __attribute__((aligned(16))) char smem[2 * 2 * 128 * GP * 2];
  __shared__ int s_item;
  __shared__ uint4 xb_words;
  if (threadIdx.x == 0) xb_words = make_uint4(0u, 0u, 0u, 0u);
  __syncthreads();
  XcdBarrier xb; xb.bar = nullptr; xb.x = 0u; xb.st = (volatile LAS unsigned*)&xb_words;
  bool xb_posted = false;
  const int G = gridDim.x, b = blockIdx.x;
  const int vb = ((G & 7) == 0) ? ((b & 7) * (G >> 3) + (b >> 3)) : b;
  for (int st = pin.phase_lo; st < pin.phase_hi; ++st) {
    int ph; bool dry = false;
    if (st == 0) ph = 0;
    else if (st == 41) ph = 21;
    else {
      const int u = st - 1, lay = u / 20, v = u - lay * 20, sb = v >> 1;
      dry = (v & 1) == 0;
      if (dry && !((pin.probe >> sb) & 1)) continue;
      if (lay == 0 && sb == 0) continue;
      ph = 1 + lay * 10 + sb;
    }
    if (st > pin.phase_lo) {
      if (!xb_posted) {
        cg::this_grid().sync();
        xb = xcd_barrier_post((unsigned*)(pin.ws + OFF_BAR), (volatile LAS unsigned*)&xb_words);
        xb_posted = true;
      } else xcd_barrier(xb);
    }
    Params p = pin;
    asm volatile("" : "+s"(p.xp), "+s"(p.xs), "+s"(p.meta), "+s"(p.attn_g), "+s"(p.w_in), "+s"(p.qa_g), "+s"(p.w_qb), "+s"(p.kva_g), "+s"(p.w_kvb), "+s"(p.gq_g));
    asm volatile("" : "+s"(p.gk_g), "+s"(p.mo_g), "+s"(p.go_g), "+s"(p.w_out), "+s"(p.mlp_g), "+s"(p.w_up), "+s"(p.w_dn), "+s"(p.fin_g), "+s"(p.out), "+s"(p.ws));
    int tid = threadIdx.x;
    asm volatile("" : "+v"(tid));
    const int lane = tid & 63, wave = tid >> 6, r = lane & 31;
    float* ssq = (float*)(p.ws + OFF_SSQ);
    const float2* tab = (const float2*)(p.ws + OFF_TAB);
    if (ph == 0) { phase_prep(p, tid); phase_norm(p, p.attn_g, true, true, tid); continue; }
    if (ph == 21) { phase_final(p, tid); continue; }
    const int layer = (ph - 1) / 10, sub = (ph - 1) % 10;
    const u16* Wl = (const u16*)(p.ws + OFF_W) + (size_t)layer * W_LAYER;
    if (sub == 0) {
      phase_norm(p, p.attn_g + layer * 1024, layer == 0, true, tid);
    } else if (sub == 1) {
      EpiIn e; e.CQ = (u16*)(p.ws + OFF_CQ); e.CKV = (u16*)(p.ws + OFF_CKV); e.QG = (u16*)(p.ws + OFF_QG); e.KG = (u16*)(p.ws + OFF_KG);
      e.VGT = (u16*)(p.ws + OFF_VGT); e.KPE = (u16*)(p.ws + OFF_KPE); e.ssq_q = ssq; e.ssq_kv = ssq + MPAD;
      e.gq_g = p.gq_g + layer * 64; e.gk_g = p.gk_g + layer * 64; e.tab = tab;
      APLin ap{(const u16*)(p.ws + OFF_HN), 1024};
      for (int t = vb; t < NTM * 12; t += G) { const int mt = t / 12, nt = t - mt * 12; gemm_tile<false>(ap, Wl + WO_IN, 1024, 1024, mt * 128, nt * 128, e, smem, 1.f, 1.f, tid, dry); }
    } else if (sub == 2) {
      EpiQB e2; e2.QM = (u16*)(p.ws + OFF_HN); e2.ssq_q = ssq; e2.tab = tab;
      EpiKVB e3; e3.KN = (u16*)(p.ws + OFF_KN); e3.VMT = (u16*)(p.ws + OFF_VMT); e3.ssq_kv = ssq + MPAD;
      APLin a2{(const u16*)(p.ws + OFF_CQ), 384};
      APLin a3{(const u16*)(p.ws + OFF_CKV), 256};
      for (int t = vb; t < NTM * 14; t += G) {
        if (t < NTM * 6) { const int mt = t / 6, nt = t - mt * 6; gemm_tile<false>(a2, Wl + WO_QB, 384, 384, mt * 128, nt * 128, e2, smem, 1.f, 1.f, tid, dry); }
        else { const int u = t - NTM * 6; const int mt = u >> 3, nt = u & 7; gemm_tile<false>(a3, Wl + WO_KVB, 256, 256, mt * 128, nt * 128, e3, smem, 1.f, 1.f, tid, dry); }
      }
    } else if (sub == 3) {
      phase_attn(p, layer, smem, &s_item, tid, dry);
    } else if (sub == 4) {
      APMix ap{(const u16*)(p.ws + OFF_HN), (const u16*)(p.ws + OFF_QG)};
      for (int t = vb; t < NTM * 8; t += G) {
        const int mt = t >> 3, nt = t & 7;
        const int g0 = mt * 128 + (wave >> 1) * 64 + r;
        const float ra0 = rsqrtf(ldgf(ssq + 2 * (size_t)MPAD + g0) * (1.0f / 512.0f) + EPS), rg0 = rsqrtf(ldgf(ssq + 3 * (size_t)MPAD + g0) * (1.0f / 512.0f) + EPS);
        const float ra1 = rsqrtf(ldgf(ssq + 2 * (size_t)MPAD + g0 + 32) * (1.0f / 512.0f) + EPS), rg1 = rsqrtf(ldgf(ssq + 3 * (size_t)MPAD + g0 + 32) * (1.0f / 512.0f) + EPS);
        EpiRes e; res_bases(p, mt, layer == 0, e.sb, e.db, e.minrow); e.fin0 = rg0; e.fin1 = rg1;
        gemm_tile<true>(ap, Wl + WO_OUT, 1024, 1024, mt * 128, nt * 128, e, smem, ra0 / rg0, ra1 / rg1, tid, dry);
      }
    } else if (sub == 5) {
      phase_norm(p, p.mlp_g + layer * 1024, false, false, tid);
    } else if (sub == 6 || sub == 8) {
      const int mh = (sub - 6) >> 1;
      EpiUp e; e.U0 = (u16*)(p.ws + OFF_U) - (size_t)mh * 259 * 128 * 4096;
      APLin ap{(const u16*)(p.ws + OFF_HN), 1024};
      for (int t = vb; t < 259 * 32; t += G) {
        int ml, nt;
        if (t < 256 * 32) { const int blk = t >> 6, w = t & 63; ml = (blk >> 2) * 8 + (w >> 3); nt = (blk & 3) * 8 + (w & 7); }
        else { ml = t >> 5; nt = t & 31; }
        gemm_tile<false>(ap, Wl + WO_UP, 1024, 1024, (mh * 259 + ml) * 128, nt * 128, e, smem, 1.f, 1.f, tid, dry);
      }
    } else {
      const int mh = (sub - 7) >> 1;
      APLin ap{(const u16*)(p.ws + OFF_U) - (size_t)mh * 259 * 128 * 4096, 4096};
      for (int t = vb; t < 259 * 8; t += G) {
        const int mt = mh * 259 + (t >> 3), nt = t & 7;
        EpiRes e; res_bases(p, mt, false, e.sb, e.db, e.minrow); e.fin0 = 1.f; e.fin1 = 1.f;
        gemm_tile<false>(ap, Wl + WO_DN, 4096, 4096, mt * 128, nt * 128, e, smem, 1.f, 1.f, tid, dry);
      }
    }
  }
}

extern "C" void kernel_launch(void* const* d_in, const int* in_sizes, int n_in, void* d_out, int out_size, void* d_ws, size_t ws_size,
                              hipStream_t stream) {
  static int grid_blocks = 0;
  if (!grid_blocks) {
    int dev = 0, cus = 0, per_cu = 0;
    hipGetDevice(&dev);
    hipDeviceGetAttribute(&cus, hipDeviceAttributeMultiprocessorCount, dev);
    hipOccupancyMaxActiveBlocksPerMultiprocessor(&per_cu, mega, 256, 0);
    if (per_cu > 2) per_cu = 2;
    if (per_cu < 1) per_cu = 1;
    grid_blocks = cus * per_cu;
  }
  Params p{};
  p.xp = (const float*)d_in[0]; p.xs = (const float*)d_in[1]; p.meta = (const float*)d_in[2];
  p.attn_g = (const float*)d_in[3]; p.w_in = (const float*)d_in[4]; p.qa_g = (const float*)d_in[5]; p.w_qb = (const float*)d_in[6];
  p.kva_g = (const float*)d_in[7]; p.w_kvb = (const float*)d_in[8]; p.gq_g = (const float*)d_in[9]; p.gk_g = (const float*)d_in[10];
  p.mo_g = (const float*)d_in[11]; p.go_g = (const float*)d_in[12]; p.w_out = (const float*)d_in[13]; p.mlp_g = (const float*)d_in[14];
  p.w_up = (const float*)d_in[15]; p.w_dn = (const float*)d_in[16]; p.fin_g = (const float*)d_in[17];
  p.out = (float*)d_out; p.ws = (char*)d_ws;
#if MK_MULTI
  for (int ph = 0; ph < 42; ++ph) {
    p.phase_lo = ph; p.phase_hi = ph + 1; p.probe = PROBE_MASK;
    if (ph > 0 && ph < 41 && ((ph - 1) & 1) == 0 && !((PROBE_MASK >> (((ph - 1) % 20) >> 1)) & 1)) continue;
    hipLaunchKernelGGL(mega, dim3(grid_blocks), dim3(256), 0, stream, p);
  }
#else
  p.phase_lo = 0; p.phase_hi = 42; p.probe = PROBE_MASK;
  void* args[] = {&p};
  hipError_t e = hipLaunchCooperativeKernel((void*)mega, dim3(grid_blocks), dim3(256), args, 0, stream);
  if (e != hipSuccess) fprintf(stderr, "cooperative launch failed: %s (grid %d)\n", hipGetErrorString(e), grid_blocks);
#endif
}
```

```cpp
#include <hip/hip_runtime.h>
#include <hip/hip_cooperative_groups.h>
#include <stdint.h>
#include <cstdio>
namespace cg = cooperative_groups;

#ifndef PROBE_MASK
#define PROBE_MASK 0
#endif
#ifndef MK_MULTI
#define MK_MULTI 0
#endif

typedef unsigned short u16;
typedef short bf16x8 __attribute__((ext_vector_type(8)));
typedef float f32x16 __attribute__((ext_vector_type(16)));
typedef unsigned u32x4 __attribute__((ext_vector_type(4)));
typedef unsigned u32x2 __attribute__((ext_vector_type(2)));
typedef float f32x2v __attribute__((ext_vector_type(2)));
typedef __bf16 bf16x2v __attribute__((ext_vector_type(2)));
#define DI __device__ __forceinline__
#define GAS __attribute__((address_space(1)))
#define WAVE_LDS_FENCE() asm volatile("s_waitcnt lgkmcnt(0)" ::: "memory")
#define MFMA(a, b, c) __builtin_amdgcn_mfma_f32_32x32x16_bf16((a), (b), (c), 0, 0, 0)

constexpr int MPAD = 66304;
constexpr int NTM = 518;
constexpr float EPS = 1e-6f;
constexpr float LOG2E = 1.4426950408889634f;
constexpr float QSCALE_M = 0.10206207261596575f * LOG2E;
constexpr float QSCALE_G = 0.125f * LOG2E;

constexpr size_t SZ_WIN = 1536ull * 1024, SZ_WQB = 768ull * 384, SZ_WKVB = 1024ull * 256, SZ_WOUT = 1024ull * 1024,
                 SZ_WUP = 4096ull * 1024, SZ_WDN = 1024ull * 4096;
constexpr size_t WO_IN = 0, WO_QB = WO_IN + SZ_WIN, WO_KVB = WO_QB + SZ_WQB, WO_OUT = WO_KVB + SZ_WKVB, WO_UP = WO_OUT + SZ_WOUT,
                 WO_DN = WO_UP + SZ_WUP, W_LAYER = WO_DN + SZ_WDN;
constexpr size_t OFF_W = 0;
constexpr size_t OFF_TAB = OFF_W + 2 * W_LAYER * 2;
constexpr size_t OFF_XMETA = OFF_TAB + 16400ull * 16 * 8;
constexpr size_t OFF_SSQ = OFF_XMETA + 96ull * 1024 * 4;
constexpr size_t OFF_CNT = OFF_SSQ + 4ull * MPAD * 4;
constexpr size_t OFF_BAR = OFF_CNT + 1024;
constexpr size_t OFF_HN = OFF_BAR + 16384;
constexpr size_t OFF_CQ = OFF_HN + (size_t)MPAD * 1024 * 2;
constexpr size_t OFF_CKV = OFF_CQ + (size_t)MPAD * 384 * 2;
constexpr size_t OFF_KN = OFF_CKV + (size_t)MPAD * 256 * 2;
constexpr size_t OFF_KPE = OFF_KN + (size_t)MPAD * 512 * 2;
constexpr size_t OFF_VMT = OFF_KPE + (size_t)MPAD * 32 * 2;
constexpr size_t OFF_QG = OFF_VMT + (size_t)MPAD * 512 * 2;
constexpr size_t OFF_KG = OFF_QG + (size_t)MPAD * 512 * 2;
constexpr size_t OFF_VGT = OFF_KG + (size_t)MPAD * 128 * 2;
constexpr size_t OFF_END = OFF_VGT + (size_t)MPAD * 128 * 2;
constexpr size_t OFF_U = OFF_CQ;
static_assert(OFF_U + (size_t)259 * 128 * 4096 * 2 <= OFF_END, "U fits");
static_assert(OFF_END <= 536870912ull, "workspace");

struct Params {
  const float* xp; const float* xs; const float* meta;
  const float* attn_g; const float* w_in; const float* qa_g; const float* w_qb; const float* kva_g; const float* w_kvb;
  const float* gq_g; const float* gk_g; const float* mo_g; const float* go_g; const float* w_out; const float* mlp_g;
  const float* w_up; const float* w_dn; const float* fin_g;
  float* out; char* ws;
  int phase_lo, phase_hi, probe, pad_;
};


DI u32x4 ldg16(const void* p) { return *(const GAS u32x4*)p; }
DI void stg16(void* p, u32x4 v) { *(GAS u32x4*)p = v; }
DI void stg8(void* p, u32x2 v) { *(GAS u32x2*)p = v; }
typedef float f32x4v __attribute__((ext_vector_type(4)));
DI float4 ldgf4(const void* p) { const f32x4v v = *(const GAS f32x4v*)p; return make_float4(v.x, v.y, v.z, v.w); }
DI float ldgf(const float* p) { return *(const GAS float*)p; }
DI float2 ldgf2(const float2* p) { typedef float f32x2g __attribute__((ext_vector_type(2))); const f32x2g v = *(const GAS f32x2g*)p; return make_float2(v.x, v.y); }
DI void stgh(u16* p, u16 v) { *(GAS u16*)p = v; }
DI void stgf4(void* p, float4 v) { f32x4v w = {v.x, v.y, v.z, v.w}; *(GAS f32x4v*)p = w; }
DI unsigned pack2(float a, float b) { f32x2v f = {a, b}; bf16x2v v = __builtin_convertvector(f, bf16x2v); return __builtin_bit_cast(unsigned, v); }
DI u16 f2bf(float a) { return (u16)(pack2(a, 0.f) & 0xffffu); }
DI void store4(u16* dst, float a, float b, float c, float d) { u32x2 v = {pack2(a, b), pack2(c, d)}; *(u32x2*)dst = v; }
DI void store4g(u16* dst, float a, float b, float c, float d) { u32x2 v = {pack2(a, b), pack2(c, d)}; stg8(dst, v); }
DI int crow(int i, int h) { return (i & 3) + 8 * (i >> 2) + 4 * h; }
DI int swap23(int r) { return (r & 0x13) | ((r & 4) << 1) | ((r & 8) >> 1); }
DI float xhalf(float v) { return __shfl_xor(v, 32); }

DI void decode_tile(int T, int& seq, int& i) {
  if (T < 258) { seq = (T >= 129) ? 1 : 0; i = T - seq * 129; }
  else { int u = T - 258; int q = u / 65; seq = 2 + q; i = u - q * 65; }
}
DI int seq_base(int seq) { return seq < 2 ? seq * 16512 : 33024 + (seq - 2) * 8320; }

DI const float* xrow_src(const Params& p, int g, bool from_input) {
  int T = g >> 7, r = g & 127, seq, i; decode_tile(T, seq, i);
  if (i == 0) {
    if (r < 112) return nullptr;
    return from_input ? p.meta + (size_t)(r - 112) * 1024 : (const float*)(p.ws + OFF_XMETA) + (size_t)(seq * 16 + r - 112) * 1024;
  }
  int j = (i - 1) * 128 + r;
  if (seq < 2) { size_t row = (size_t)seq * 16384 + j; return from_input ? p.xp + row * 1024 : p.out + row * 1024; }
  size_t row = (size_t)(seq - 2) * 8192 + j;
  return from_input ? p.xs + row * 1024 : p.out + (32768 + row) * 1024;
}
DI float* xrow_dst(const Params& p, int g) {
  int T = g >> 7, r = g & 127, seq, i; decode_tile(T, seq, i);
  if (i == 0) {
    if (r < 112) return nullptr;
    return (float*)(p.ws + OFF_XMETA) + (size_t)(seq * 16 + r - 112) * 1024;
  }
  int j = (i - 1) * 128 + r;
  if (seq < 2) { size_t row = (size_t)seq * 16384 + j; return p.out + row * 1024; }
  size_t row = (size_t)(seq - 2) * 8192 + j;
  return p.out + (32768 + row) * 1024;
}

DI int mapcol(int kind, int n) {
  if (kind == 1) { if (n < 640) return n; if (n < 1408) return n + 32; if (n < 1440) return 640 + (n - 1408); return -1; }
  if (kind == 2) { if (n < 512) return (n >> 6) * 96 + (n & 63); int m = n - 512; return (m >> 5) * 96 + 64 + (m & 31); }
  if (kind == 3) { if (n < 512) return (n >> 6) * 128 + (n & 63); int m = n - 512; return (m >> 6) * 128 + 64 + (m & 63); }
  return n;
}
DI void prep_weight(const float* __restrict__ src, int Nsrc, u16* __restrict__ dst, int Nout, int K, const float* gA, const float* gB,
                    int ksplit, int kind, int gtid, int gthreads) {
  const int total = Nout * (K >> 3);
  for (int u = gtid; u < total; u += gthreads) {
    const int n = u % Nout, kc = u / Nout;
    const int col = mapcol(kind, n);
    const int k = kc * 8;
    float v[8];
#pragma unroll
    for (int j = 0; j < 8; ++j) {
      float x = 0.f;
      if (col >= 0) {
        x = src[(size_t)(k + j) * Nsrc + col];
        if (gA) x *= (k + j < ksplit) ? gA[k + j] : gB[k + j - ksplit];
      }
      v[j] = x;
    }
    u32x4 o = {pack2(v[0], v[1]), pack2(v[2], v[3]), pack2(v[4], v[5]), pack2(v[6], v[7])};
    *(u32x4*)(dst + (size_t)n * K + k) = o;
  }
}

DI void phase_prep(const Params& p, int tid) {
  const int gtid = blockIdx.x * 256 + tid, gthreads = gridDim.x * 256;
  u16* W = (u16*)(p.ws + OFF_W);
  for (int l = 0; l < 2; ++l) {
    u16* Wl = W + (size_t)l * W_LAYER;
    prep_weight(p.w_in + (size_t)l * 1024 * 1440, 1440, Wl + WO_IN, 1536, 1024, nullptr, nullptr, 0, 1, gtid, gthreads);
    prep_weight(p.w_qb + (size_t)l * 384 * 768, 768, Wl + WO_QB, 768, 384, p.qa_g + l * 384, p.qa_g + l * 384, 384, 2, gtid, gthreads);
    prep_weight(p.w_kvb + (size_t)l * 256 * 1024, 1024, Wl + WO_KVB, 1024, 256, p.kva_g + l * 256, p.kva_g + l * 256, 256, 3, gtid, gthreads);
    prep_weight(p.w_out + (size_t)l * 1024 * 1024, 1024, Wl + WO_OUT, 1024, 1024, p.mo_g + l * 512, p.go_g + l * 512, 512, 0, gtid, gthreads);
    prep_weight(p.w_up + (size_t)l * 1024 * 4096, 4096, Wl + WO_UP, 4096, 1024, nullptr, nullptr, 0, 0, gtid, gthreads);
    prep_weight(p.w_dn + (size_t)l * 4096 * 1024, 1024, Wl + WO_DN, 1024, 4096, nullptr, nullptr, 0, 0, gtid, gthreads);
  }
  float2* tab = (float2*)(p.ws + OFF_TAB);
  for (int u = gtid; u < 16400 * 16; u += gthreads) {
    const int pos = u >> 4, f = u & 15;
    const float invf = 1.0f / powf(10000.0f, (float)(2 * f) / 32.0f);
    const float ang = (float)pos * invf;
    const double rev = (double)ang * 0.15915494309189535;
    const double fr = rev - rint(rev);
    const float x = (float)(2.0 * fr);
    tab[u] = make_float2(cospif(x), sinpif(x));
  }
  float* xm = (float*)(p.ws + OFF_XMETA);
  for (int u = gtid; u < 96 * 1024; u += gthreads) xm[u] = p.meta[u & 16383];
  int* cnt = (int*)(p.ws + OFF_CNT);
  if (gtid < 64) cnt[gtid] = 0;
  unsigned* bar = (unsigned*)(p.ws + OFF_BAR);
  if (gtid < 4096) bar[gtid] = 0u;
}

DI void phase_norm(const Params& p, const float* __restrict__ gain, bool from_input, bool zero_ssq, int tid) {
  const int lane = tid & 63;
  const int gw = blockIdx.x * 4 + (tid >> 6), nw = gridDim.x * 4;
  u16* HN = (u16*)(p.ws + OFF_HN);
  float* ssq = (float*)(p.ws + OFF_SSQ);
  for (int g = gw; g < MPAD; g += nw) {
    const float* xr = xrow_src(p, g, from_input);
    u16* hr = HN + (size_t)g * 1024;
    if (!xr) {
      u32x4 z = {0u, 0u, 0u, 0u};
      *(u32x4*)(hr + lane * 16) = z;
      *(u32x4*)(hr + lane * 16 + 8) = z;
    } else {
      float4 v[4];
#pragma unroll
      for (int q = 0; q < 4; ++q) v[q] = ldgf4((const float4*)xr + lane + 64 * q);
      float ss = 0.f;
#pragma unroll
      for (int q = 0; q < 4; ++q) ss += v[q].x * v[q].x + v[q].y * v[q].y + v[q].z * v[q].z + v[q].w * v[q].w;
#pragma unroll
      for (int o = 32; o >= 1; o >>= 1) ss += __shfl_xor(ss, o);
      const float rstd = rsqrtf(ss * (1.0f / 1024.0f) + EPS);
#pragma unroll
      for (int q = 0; q < 4; ++q) {
        const float4 gg = ldgf4((const float4*)gain + lane + 64 * q);
        store4g(hr + 4 * (lane + 64 * q), v[q].x * rstd * gg.x, v[q].y * rstd * gg.y, v[q].z * rstd * gg.z, v[q].w * rstd * gg.w);
      }
    }
    if (zero_ssq && lane < 4) ssq[(size_t)lane * MPAD + g] = 0.f;
  }
}

DI void phase_final(const Params& p, int tid) {
  const int lane = tid & 63;
  const int gw = blockIdx.x * 4 + (tid >> 6), nw = gridDim.x * 4;
  for (int g = gw; g < MPAD; g += nw) {
    if (((g >> 7) == 0) || ((g >> 7) == 129) || ((g >> 7) >= 258 && ((g >> 7) - 258) % 65 == 0)) continue;
    float* xr = xrow_dst(p, g);
    float4 v[4];
#pragma unroll
    for (int q = 0; q < 4; ++q) v[q] = ldgf4((const float4*)xr + lane + 64 * q);
    float ss = 0.f;
#pragma unroll
    for (int q = 0; q < 4; ++q) ss += v[q].x * v[q].x + v[q].y * v[q].y + v[q].z * v[q].z + v[q].w * v[q].w;
#pragma unroll
    for (int o = 32; o >= 1; o >>= 1) ss += __shfl_xor(ss, o);
    const float rstd = rsqrtf(ss * (1.0f / 1024.0f) + EPS);
#pragma unroll
    for (int q = 0; q < 4; ++q) {
      const float4 gg = ldgf4((const float4*)p.fin_g + lane + 64 * q);
      float4 o = make_float4(v[q].x * rstd * gg.x, v[q].y * rstd * gg.y, v[q].z * rstd * gg.z, v[q].w * rstd * gg.w);
      stgf4((float4*)xr + lane + 64 * q, o);
    }
  }
}

constexpr int GP = 72;
struct APLin { const u16* A; int lda; DI const u16* ptr(int row, int k0) const { return A + (size_t)row * lda + k0; } };
struct APMix { const u16* QM; const u16* QG;
  DI const u16* ptr(int row, int k0) const { return k0 < 512 ? QM + (size_t)row * 768 + (k0 >> 6) * 96 : QG + (size_t)row * 512 + (k0 - 512); } };

template <bool MIDK, class AP, class EPI>
DI void gemm_tile(const AP& ap, const u16* __restrict__ W, int ldw, int K, int m0, int n0, const EPI& epi, char* smem, float r0, float r1, int tid, bool dry) {
  constexpr int SBUF = 2 * 128 * GP;
  u16* sA = (u16*)smem;
  u16* sB = sA + 128 * GP;
  const int lane = tid & 63, wave = tid >> 6, r = lane & 31, h = lane >> 5, wm = wave >> 1, wn = wave & 1;
  const int lrow = tid >> 3, lkc = (tid & 7) * 8;
  u32x4 ra0[4], rb0[4], ra1[4], rb1[4];
  f32x16 acc[2][2];
#pragma unroll
  for (int a = 0; a < 2; ++a)
#pragma unroll
    for (int b = 0; b < 2; ++b)
#pragma unroll
      for (int i = 0; i < 16; ++i) acc[a][b][i] = 0.f;
  const int nk = K >> 6;
#define GLOADQ(RA, RB, KT, q) do { const int k0_ = (KT) << 6; \
    RA[q] = ldg16(ap.ptr(m0 + lrow + 32 * (q), k0_) + lkc); RB[q] = ldg16(W + (size_t)(n0 + lrow + 32 * (q)) * ldw + k0_ + lkc); } while (0)
#define GLOAD(RA, RB, KT) do { GLOADQ(RA, RB, KT, 0); GLOADQ(RA, RB, KT, 1); GLOADQ(RA, RB, KT, 2); GLOADQ(RA, RB, KT, 3); } while (0)
#define SSTOREQ(RA, RB, ST, q) do { \
    *(u32x4*)(sA + (ST) * SBUF + (lrow + 32 * (q)) * GP + lkc) = RA[q]; *(u32x4*)(sB + (ST) * SBUF + (lrow + 32 * (q)) * GP + lkc) = RB[q]; } while (0)
#define SSTORE(RA, RB, ST) do { SSTOREQ(RA, RB, ST, 0); SSTOREQ(RA, RB, ST, 1); SSTOREQ(RA, RB, ST, 2); SSTOREQ(RA, RB, ST, 3); } while (0)
#define FLOAD(F, ST, ks) do { _Pragma("unroll") for (int a = 0; a < 2; ++a) { \
    F[a] = *(const bf16x8*)(sB + (ST) * SBUF + (wn * 64 + a * 32 + r) * GP + (ks) * 16 + h * 8); \
    F[2 + a] = *(const bf16x8*)(sA + (ST) * SBUF + (wm * 64 + a * 32 + r) * GP + (ks) * 16 + h * 8); } } while (0)
#define FMMA(F) do { _Pragma("unroll") for (int a = 0; a < 2; ++a) _Pragma("unroll") for (int b = 0; b < 2; ++b) acc[a][b] = MFMA(F[a], F[2 + b], acc[a][b]); } while (0)
  bf16x8 f0[4], f1[4];
  GLOAD(ra0, rb0, 0);
  GLOAD(ra1, rb1, 1);
  __syncthreads();
  SSTORE(ra0, rb0, 0);
  if (nk > 2) GLOAD(ra0, rb0, 2);
  __syncthreads();
  for (int kt = 0; kt < nk; kt += 2) {
    const bool l3 = kt + 3 < nk, s2 = kt + 2 < nk, l4 = kt + 4 < nk;
    FLOAD(f0, 0, 0); FLOAD(f1, 0, 1);
    FMMA(f0); SSTOREQ(ra1, rb1, 1, 0); if (l3) GLOADQ(ra1, rb1, kt + 3, 0);
    FLOAD(f0, 0, 2);
    FMMA(f1); SSTOREQ(ra1, rb1, 1, 1); if (l3) GLOADQ(ra1, rb1, kt + 3, 1);
    FLOAD(f1, 0, 3);
    FMMA(f0); SSTOREQ(ra1, rb1, 1, 2); if (l3) GLOADQ(ra1, rb1, kt + 3, 2);
    FMMA(f1); SSTOREQ(ra1, rb1, 1, 3); if (l3) GLOADQ(ra1, rb1, kt + 3, 3);
    __syncthreads();
    FLOAD(f0, 1, 0); FLOAD(f1, 1, 1);
    FMMA(f0); if (s2) SSTOREQ(ra0, rb0, 0, 0); if (l4) GLOADQ(ra0, rb0, kt + 4, 0);
    FLOAD(f0, 1, 2);
    FMMA(f1); if (s2) SSTOREQ(ra0, rb0, 0, 1); if (l4) GLOADQ(ra0, rb0, kt + 4, 1);
    FLOAD(f1, 1, 3);
    FMMA(f0); if (s2) SSTOREQ(ra0, rb0, 0, 2); if (l4) GLOADQ(ra0, rb0, kt + 4, 2);
    FMMA(f1); if (s2) SSTOREQ(ra0, rb0, 0, 3); if (l4) GLOADQ(ra0, rb0, kt + 4, 3);
    if (MIDK && kt == 6) {
#pragma unroll
      for (int a = 0; a < 2; ++a)
#pragma unroll
        for (int i = 0; i < 16; ++i) { acc[a][0][i] *= r0; acc[a][1][i] *= r1; }
    }
    __syncthreads();
  }
#undef GLOADQ
#undef SSTOREQ
#undef FLOAD
#undef FMMA
#undef GLOAD
#undef SSTORE
  if (!dry) epi(acc, n0 + wn * 64, m0 + wm * 64, lane, (u16*)smem + wave * 64 * GP);
}

struct ColId { DI int operator()(int ch) const { return ch * 8; } };
struct ColRope { DI int operator()(int ch) const { return (ch >> 2) * 96 + (ch & 3) * 8; } };

template <class COLF>
DI void stage_store(f32x16 (&acc)[2][2], u16* wl, int lane, u16* dst0, size_t pitch, const COLF& colf) {
  const int r = lane & 31, h = lane >> 5;
#pragma unroll
  for (int rb = 0; rb < 2; ++rb)
#pragma unroll
    for (int lb = 0; lb < 2; ++lb)
#pragma unroll
      for (int g4 = 0; g4 < 4; ++g4)
        store4(wl + (lb * 32 + r) * GP + rb * 32 + 8 * g4 + 4 * h, acc[rb][lb][4 * g4], acc[rb][lb][4 * g4 + 1], acc[rb][lb][4 * g4 + 2], acc[rb][lb][4 * g4 + 3]);
  WAVE_LDS_FENCE();
#pragma unroll
  for (int it = 0; it < 8; ++it) {
    const int row = it * 8 + (lane >> 3), ch = lane & 7;
    const u32x4 v = *(const u32x4*)(wl + row * GP + ch * 8);
    stg16(dst0 + (size_t)row * pitch + colf(ch), v);
  }
  WAVE_LDS_FENCE();
}

DI void rope16(float (&v)[16], const float2* __restrict__ tabrow, int h) {
#pragma unroll
  for (int i = 0; i < 8; ++i) {
    const int f = (i & 3) + 8 * (i >> 2) + 4 * h;
    const float2 cs = ldgf2(tabrow + f);
    const float x1 = v[i], x2 = v[i + 8];
    v[i] = x1 * cs.x - x2 * cs.y;
    v[i + 8] = x2 * cs.x + x1 * cs.y;
  }
}

struct EpiIn {
  u16 *CQ, *CKV, *QG, *KG, *VGT, *KPE; float *ssq_q, *ssq_kv; const float *gq_g, *gk_g; const float2* tab;
  DI void operator()(f32x16 (&acc)[2][2], int nb, int mb, int lane, u16* wl) const {
    const int r = lane & 31, h = lane >> 5;
    int seq, it; decode_tile(mb >> 7, seq, it);
#pragma unroll
    for (int ti = 0; ti < 2; ++ti) {
      const int g = mb + ti * 32 + r, rr = g & 127;
      if (nb < 640) {
        float ss = 0.f;
#pragma unroll
        for (int fi = 0; fi < 2; ++fi)
#pragma unroll
          for (int i = 0; i < 16; ++i) ss += acc[fi][ti][i] * acc[fi][ti][i];
        ss += xhalf(ss);
        if (h == 0) unsafeAtomicAdd((nb < 384 ? ssq_q : ssq_kv) + g, ss);
      } else if (nb < 1280) {
        const bool isq = nb < 1152;
        const float* gg = isq ? gq_g : gk_g;
        float ss = 0.f;
#pragma unroll
        for (int fi = 0; fi < 2; ++fi)
#pragma unroll
          for (int i = 0; i < 16; ++i) ss += acc[fi][ti][i] * acc[fi][ti][i];
        ss += xhalf(ss);
        const float rstd = rsqrtf(ss * (1.0f / 64.0f) + EPS);
        const float osc = isq ? QSCALE_G : 1.0f;
        int prow = 0, pcol = 0;
        if (it > 0) { const int j = (it - 1) * 128 + rr; prow = j >> 6; pcol = j & 63; }
        u16* dst = isq ? QG + (size_t)g * 512 + (nb - 640) : KG + (size_t)g * 128 + (nb - 1152);
#pragma unroll
        for (int fi = 0; fi < 2; ++fi) {
          const int pos = fi == 0 ? prow : pcol;
          float v[16];
#pragma unroll
          for (int i = 0; i < 16; ++i) v[i] = acc[fi][ti][i] * rstd * ldgf(gg + fi * 32 + crow(i, h));
          rope16(v, tab + pos * 16, h);
#pragma unroll
          for (int g4 = 0; g4 < 4; ++g4)
            store4g(dst + fi * 32 + 8 * g4 + 4 * h, v[4 * g4] * osc, v[4 * g4 + 1] * osc, v[4 * g4 + 2] * osc, v[4 * g4 + 3] * osc);
        }
      } else if (nb < 1408) {
#pragma unroll
        for (int fi = 0; fi < 2; ++fi)
#pragma unroll
          for (int i = 0; i < 16; ++i) stgh(VGT + (size_t)(nb - 1280 + fi * 32 + crow(i, h)) * MPAD + g, f2bf(acc[fi][ti][i]));
      } else if (nb == 1408) {
        int pos = 128 * it + rr - 112; pos = pos < 0 ? 0 : pos;
        float v[16];
#pragma unroll
        for (int i = 0; i < 16; ++i) v[i] = acc[0][ti][i];
        rope16(v, tab + pos * 16, h);
#pragma unroll
        for (int g4 = 0; g4 < 4; ++g4) store4g(KPE + (size_t)g * 32 + 8 * g4 + 4 * h, v[4 * g4], v[4 * g4 + 1], v[4 * g4 + 2], v[4 * g4 + 3]);
      }
    }
    if (nb < 384) stage_store(acc, wl, lane, CQ + (size_t)mb * 384 + nb, 384, ColId());
    else if (nb < 640) stage_store(acc, wl, lane, CKV + (size_t)mb * 256 + (nb - 384), 256, ColId());
  }
};

struct EpiQB {
  u16* QM; const float* ssq_q; const float2* tab;
  DI void operator()(f32x16 (&acc)[2][2], int nb, int mb, int lane, u16* wl) const {
    const int r = lane & 31, h = lane >> 5;
    int seq, it; decode_tile(mb >> 7, seq, it);
#pragma unroll
    for (int ti = 0; ti < 2; ++ti) {
      const int g = mb + ti * 32 + r, rr = g & 127;
      const float sc = rsqrtf(ldgf(ssq_q + g) * (1.0f / 384.0f) + EPS) * QSCALE_M;
      if (nb < 512) {
#pragma unroll
        for (int fi = 0; fi < 2; ++fi)
#pragma unroll
          for (int i = 0; i < 16; ++i) acc[fi][ti][i] *= sc;
      } else {
        int pos = 128 * it + rr - 112; pos = pos < 0 ? 0 : pos;
#pragma unroll
        for (int fi = 0; fi < 2; ++fi) {
          float v[16];
#pragma unroll
          for (int i = 0; i < 16; ++i) v[i] = acc[fi][ti][i] * sc;
          rope16(v, tab + pos * 16, h);
#pragma unroll
          for (int i = 0; i < 16; ++i) acc[fi][ti][i] = v[i];
        }
      }
    }
    if (nb < 512) stage_store(acc, wl, lane, QM + (size_t)mb * 768 + (nb >> 6) * 96, 768, ColId());
    else stage_store(acc, wl, lane, QM + (size_t)mb * 768 + ((nb - 512) >> 5) * 96 + 64, 768, ColRope());
  }
};

struct EpiKVB {
  u16 *KN, *VMT; const float* ssq_kv;
  DI void operator()(f32x16 (&acc)[2][2], int nb, int mb, int lane, u16* wl) const {
    const int r = lane & 31, h = lane >> 5;
#pragma unroll
    for (int ti = 0; ti < 2; ++ti) {
      const int g = mb + ti * 32 + r;
      const float sc = rsqrtf(ldgf(ssq_kv + g) * (1.0f / 256.0f) + EPS);
      if (nb < 512) {
#pragma unroll
        for (int fi = 0; fi < 2; ++fi)
#pragma unroll
          for (int i = 0; i < 16; ++i) acc[fi][ti][i] *= sc;
      } else {
#pragma unroll
        for (int fi = 0; fi < 2; ++fi)
#pragma unroll
          for (int i = 0; i < 16; ++i) stgh(VMT + (size_t)(nb - 512 + fi * 32 + crow(i, h)) * MPAD + g, f2bf(acc[fi][ti][i] * sc));
      }
    }
    if (nb < 512) stage_store(acc, wl, lane, KN + (size_t)mb * 512 + nb, 512, ColId());
  }
};

DI void res_bases(const Params& p, int mt, bool from_input, const float*& sb, float*& db, int& minrow) {
  int seq, it; decode_tile(mt, seq, it);
  float* xm = (float*)(p.ws + OFF_XMETA);
  if (it == 0) {
    minrow = 112;
    db = xm + ((ptrdiff_t)seq * 16 - 112) * 1024;
    sb = from_input ? p.meta - 112 * 1024 : db;
  } else {
    minrow = 0;
    const size_t row = seq < 2 ? (size_t)seq * 16384 + (size_t)(it - 1) * 128 : 32768 + (size_t)(seq - 2) * 8192 + (size_t)(it - 1) * 128;
    db = p.out + row * 1024;
    sb = from_input ? (seq < 2 ? p.xp + row * 1024 : p.xs + (row - 32768) * 1024) : db;
  }
}

struct EpiRes {
  const float* sb; float* db; int minrow; float fin0, fin1;
  DI void operator()(f32x16 (&acc)[2][2], int nb, int mb, int lane, u16* wl) const {
    const int r = lane & 31, h = lane >> 5, mbl = mb & 127;
    float* wf = (float*)wl;
#pragma unroll
    for (int fi = 0; fi < 2; ++fi) {
#pragma unroll
      for (int ti = 0; ti < 2; ++ti) {
        const float sc = ti == 0 ? fin0 : fin1;
#pragma unroll
        for (int g4 = 0; g4 < 4; ++g4) {
          float4 o = make_float4(acc[fi][ti][4 * g4] * sc, acc[fi][ti][4 * g4 + 1] * sc, acc[fi][ti][4 * g4 + 2] * sc, acc[fi][ti][4 * g4 + 3] * sc);
          *(float4*)(wf + (ti * 32 + r) * 36 + 8 * g4 + 4 * h) = o;
        }
      }
      WAVE_LDS_FENCE();
#pragma unroll
      for (int it = 0; it < 8; ++it) {
        const int row = it * 8 + (lane >> 3), ch = lane & 7;
        const float4 a = *(const float4*)(wf + row * 36 + ch * 4);
        const int trow = mbl + row;
        if (trow >= minrow) {
          const size_t off = (size_t)trow * 1024 + nb + fi * 32 + ch * 4;
          float4 x = ldgf4(sb + off);
          x.x += a.x; x.y += a.y; x.z += a.z; x.w += a.w;
          stgf4(db + off, x);
        }
      }
      WAVE_LDS_FENCE();
    }
  }
};

struct EpiUp {
  u16* U0;
  DI void operator()(f32x16 (&acc)[2][2], int nb, int mb, int lane, u16* wl) const {
#pragma unroll
    for (int ti = 0; ti < 2; ++ti)
#pragma unroll
      for (int fi = 0; fi < 2; ++fi)
#pragma unroll
        for (int i = 0; i < 16; ++i) { const float a = fmaxf(acc[fi][ti][i], 0.f); acc[fi][ti][i] = a * a; }
    stage_store(acc, wl, lane, U0 + (size_t)mb * 4096 + nb, 4096, ColId());
  }
};

constexpr float ATT_THR = 8.0f;

template <int DQK>
struct AttnCtx {
  static constexpr int KP = DQK + 8, NKS = DQK / 16, KCH = DQK / 8, NKL = 64 * KCH / 256, KBUF = 64 * KP, VBUF = 64 * GP;
  const u16 *Kb, *KPEb, *Vt; int kpitch, rowk0, nt, tid, r, h, sr;
  u16 *sK, *sV;
  bf16x8 qf[NKS], kone, qm;
  f32x16 o[2];
  float mref, l;
  u32x4 rk[NKL], rv[2];

  int koff[NKL], voff[2];
  DI void init_offs() {
#pragma unroll
    for (int q = 0; q < NKL; ++q) {
      const int c = tid + 256 * q, row = c / KCH, cc = c % KCH;
      koff[q] = (DQK == 96 && cc >= 8) ? row * 32 + (cc - 8) * 8 : row * kpitch + cc * 8;
    }
#pragma unroll
    for (int q = 0; q < 2; ++q) { const int c = tid + 256 * q, dv = c >> 3, kc = c & 7; voff[q] = dv * MPAD + kc * 8; }
  }
  DI void gload_k(int t) {
    const int row0 = rowk0 + t * 64;
    const u16* kt = Kb + (size_t)row0 * kpitch;
    const u16* pt = KPEb + (size_t)row0 * 32;
#pragma unroll
    for (int q = 0; q < NKL; ++q) {
      const int c = tid + 256 * q, cc = c % KCH;
      rk[q] = ldg16(((DQK == 96 && cc >= 8) ? pt : kt) + koff[q]);
    }
  }
  DI void gload_v(int t) {
    const u16* vt = Vt + (rowk0 + t * 64);
#pragma unroll
    for (int q = 0; q < 2; ++q) rv[q] = ldg16(vt + voff[q]);
  }
  DI void sstore_k(int buf) {
#pragma unroll
    for (int q = 0; q < NKL; ++q) {
      const int c = tid + 256 * q, row = c / KCH, cc = c % KCH;
      *(u32x4*)(sK + buf * KBUF + row * KP + cc * 8) = rk[q];
    }
  }
  DI void sstore_v(int buf) {
#pragma unroll
    for (int q = 0; q < 2; ++q) {
      const int c = tid + 256 * q, dv = c >> 3, kc = c & 7;
      *(u32x4*)(sV + buf * VBUF + dv * GP + kc * 8) = rv[q];
    }
  }
  DI void qk(int buf, f32x16 (&s)[2]) {
    const u16* kb = sK + buf * KBUF + sr * KP + h * 8;
#pragma unroll
    for (int kb2 = 0; kb2 < 2; ++kb2)
#pragma unroll
      for (int i = 0; i < 16; ++i) s[kb2][i] = 0.f;
#pragma unroll
    for (int ks = 0; ks < NKS; ++ks)
#pragma unroll
      for (int kb2 = 0; kb2 < 2; ++kb2) {
        const bf16x8 a = *(const bf16x8*)(kb + kb2 * 32 * KP + ks * 16);
        s[kb2] = MFMA(a, qf[ks], s[kb2]);
      }
    s[0] = MFMA(kone, qm, s[0]);
    s[1] = MFMA(kone, qm, s[1]);
  }
  template <int PAR>
  DI void step(int t, f32x16 (&cur)[2], f32x16 (&nxt)[2]) {
    if (t + 1 < nt) sstore_k(PAR ^ 1);
    if (t > 0) sstore_v(PAR);
    __syncthreads();
    if (t + 1 < nt) qk(PAR ^ 1, nxt);
    float mx = fmaxf(cur[0][0], cur[1][0]);
#pragma unroll
    for (int i = 1; i < 16; ++i) mx = fmaxf(fmaxf(cur[0][i], cur[1][i]), mx);
    if (__builtin_amdgcn_ballot_w64(mx > ATT_THR) != 0ull) {
      asm volatile("" ::: "memory");
      mx = fmaxf(mx, xhalf(mx));
      const float want = mref + fmaxf(mx, 0.f);
      const float mn = __uint_as_float(pack2(want, 0.f) << 16);
      const float d = mn - mref;
      const float alpha = __builtin_amdgcn_exp2f(-d);
      mref = mn;
      l *= alpha;
#pragma unroll
      for (int a = 0; a < 2; ++a)
#pragma unroll
        for (int i = 0; i < 16; ++i) { o[a][i] *= alpha; cur[a][i] -= d; nxt[a][i] -= d; }
      u32x4 q4 = {h == 0 ? (pack2(-mn, 0.f) & 0xffffu) : 0u, 0u, 0u, 0u};
      qm = __builtin_bit_cast(bf16x8, q4);
    }
    float psum = 0.f;
#pragma unroll
    for (int kb2 = 0; kb2 < 2; ++kb2)
#pragma unroll
      for (int i = 0; i < 16; ++i) { const float pv = __builtin_amdgcn_exp2f(cur[kb2][i]); cur[kb2][i] = pv; psum += pv; }
    l += psum;
    if (t + 2 < nt) gload_k(t + 2);
    if (t + 1 < nt) gload_v(t + 1);
    const u16* vb = sV + PAR * VBUF + r * GP + h * 8;
#pragma unroll
    for (int kb2 = 0; kb2 < 2; ++kb2)
#pragma unroll
      for (int s2 = 0; s2 < 2; ++s2) {
        u32x4 pk = {pack2(cur[kb2][8 * s2], cur[kb2][8 * s2 + 1]), pack2(cur[kb2][8 * s2 + 2], cur[kb2][8 * s2 + 3]),
                    pack2(cur[kb2][8 * s2 + 4], cur[kb2][8 * s2 + 5]), pack2(cur[kb2][8 * s2 + 6], cur[kb2][8 * s2 + 7])};
        const bf16x8 pf = __builtin_bit_cast(bf16x8, pk);
#pragma unroll
        for (int db = 0; db < 2; ++db) {
          const bf16x8 a = *(const bf16x8*)(vb + db * 32 * GP + kb2 * 32 + s2 * 16);
          o[db] = MFMA(a, pf, o[db]);
        }
      }
  }
};

template <int DQK>
DI void attn_item(const u16* __restrict__ Qb, int qpitch, const u16* __restrict__ Kb, int kpitch, const u16* __restrict__ KPEb,
                  const u16* __restrict__ Vt, float* __restrict__ ssq, int rowq0, int rowk0, int nt, char* smem, int tid, bool dry) {
  typedef AttnCtx<DQK> C;
  C c;
  const int lane = tid & 63, wave = tid >> 6, r = lane & 31, h = lane >> 5;
  c.Kb = Kb; c.KPEb = KPEb; c.Vt = Vt; c.kpitch = kpitch; c.rowk0 = rowk0; c.nt = nt; c.tid = tid; c.r = r; c.h = h; c.sr = swap23(r);
  c.sK = (u16*)smem; c.sV = c.sK + 2 * C::KBUF;
  c.init_offs();
  const int myrow = rowq0 + wave * 32 + r;
  {
    const u16* qrow = Qb + (size_t)myrow * qpitch + h * 8;
#pragma unroll
    for (int ks = 0; ks < C::NKS; ++ks) c.qf[ks] = __builtin_bit_cast(bf16x8, ldg16(qrow + ks * 16));
  }
#pragma unroll
  for (int a = 0; a < 2; ++a)
#pragma unroll
    for (int i = 0; i < 16; ++i) c.o[a][i] = 0.f;
  c.mref = 0.f; c.l = 0.f;
  {
    u32x4 k1 = {h == 0 ? 0x3F80u : 0u, 0u, 0u, 0u}, z4 = {0u, 0u, 0u, 0u};
    c.kone = __builtin_bit_cast(bf16x8, k1); c.qm = __builtin_bit_cast(bf16x8, z4);
  }
  f32x16 sa[2], sb[2];
  c.gload_k(0); c.gload_v(0);
  __syncthreads();
  c.sstore_k(0); c.sstore_v(0);
  if (nt > 1) c.gload_k(1);
  __syncthreads();
  c.qk(0, sa);
#pragma unroll
  for (int i = 0; i < 16; ++i) {
    sa[0][i] = -1e30f;
    if (swap23(crow(i, h)) < 16) sa[1][i] = -1e30f;
  }
  int t = 0;
  for (; t + 1 < nt; t += 2) {
    c.template step<0>(t, sa, sb);
    c.template step<1>(t + 1, sb, sa);
  }
  if (t < nt) c.template step<0>(t, sa, sb);
  if (dry) return;
  float l = c.l;
  l += xhalf(l);
  const float inv = 1.0f / l;
  float ss = 0.f;
  u16* orow = (u16*)Qb + (size_t)myrow * qpitch;
#pragma unroll
  for (int db = 0; db < 2; ++db)
#pragma unroll
    for (int g4 = 0; g4 < 4; ++g4) {
      const float a0 = c.o[db][4 * g4] * inv, a1 = c.o[db][4 * g4 + 1] * inv, a2 = c.o[db][4 * g4 + 2] * inv, a3 = c.o[db][4 * g4 + 3] * inv;
      ss += a0 * a0 + a1 * a1 + a2 * a2 + a3 * a3;
      store4g(orow + db * 32 + 8 * g4 + 4 * h, a0, a1, a2, a3);
    }
  ss += xhalf(ss);
  if (h == 0) unsafeAtomicAdd(ssq + myrow, ss);
}

constexpr int N_ITEMS = 8288;
DI void phase_attn(const Params& p, int layer, char* smem, int* s_item, int tid, bool dry) {
  u16* QM = (u16*)(p.ws + OFF_HN);
  const u16* KN = (const u16*)(p.ws + OFF_KN);
  const u16* KPE = (const u16*)(p.ws + OFF_KPE);
  const u16* VMT = (const u16*)(p.ws + OFF_VMT);
  u16* QG = (u16*)(p.ws + OFF_QG);
  const u16* KG = (const u16*)(p.ws + OFF_KG);
  const u16* VGT = (const u16*)(p.ws + OFF_VGT);
  float* ssq = (float*)(p.ws + OFF_SSQ);
  const int myx = (int)((unsigned)__builtin_amdgcn_s_getreg((3 << 11) | 20) & 7u);
  int* cq = (int*)(p.ws + OFF_CNT) + 8 + layer * 16 + (dry ? 8 : 0);
  for (int xo = 0; xo < 8; ++xo) {
    const int x = (myx + xo) & 7;
    for (;;) {
      if (tid == 0) *s_item = atomicAdd(cq + x, 1);
      __syncthreads();
      const int j = *s_item;
      __syncthreads();
      if (j >= 516 + 520) break;
      int grp, seq, head, qi, nt;
      if (j < 516) {
        const int s4 = j / 129; qi = j - s4 * 129; nt = 257;
        if (s4 < 2) { const int sg = x + 8 * s4; grp = 0; seq = sg >> 3; head = sg & 7; }
        else { grp = 1; seq = x >> 2; head = ((x >> 1) & 1) * 4 + (x & 1) * 2 + (s4 - 2); }
      } else {
        const int jj = j - 516, s8 = jj / 65; qi = jj - s8 * 65; nt = 129;
        if (s8 < 4) { const int sg = x + 8 * s8; grp = 0; seq = 2 + (sg >> 3); head = sg & 7; }
        else { grp = 1; seq = 2 + (x >> 1); head = (x & 1) * 4 + (s8 - 4); }
      }
      const int P = seq_base(seq);
      if (grp == 0)
        attn_item<96>(QM + head * 96, 768, KN + head * 64, 512, KPE, VMT + (size_t)head * 64 * MPAD, ssq + 2 * (size_t)MPAD, P + qi * 128, P + 64, nt, smem, tid, dry);
      else
        attn_item<64>(QG + head * 64, 512, KG + (head >> 2) * 64, 128, nullptr, VGT + (size_t)(head >> 2) * 64 * MPAD, ssq + 3 * (size_t)MPAD, P + qi * 128, P + 64, nt, smem, tid, dry);
    }
  }
}

#define XB_TMO      128
#define XB_XCNT(j)  (256  + 64 * (j))
#define XB_XSUB(j)  (1280 + 64 * (j))
#define XB_XGEN(j)  (2304 + 64 * (j))
#define XB_TOP      3328
#define XB_TOPGEN   3392
#define XCD_BAR_WORDS 3456
#define XB_SPIN_CAP (1u << 18)
#define LAS __attribute__((address_space(3)))

__device__ __forceinline__ unsigned xb_ld(unsigned* p)              { return __hip_atomic_load(p, __ATOMIC_RELAXED, __HIP_MEMORY_SCOPE_AGENT); }
__device__ __forceinline__ unsigned xb_add(unsigned* p, unsigned v) { return __hip_atomic_fetch_add(p, v, __ATOMIC_RELAXED, __HIP_MEMORY_SCOPE_AGENT); }
__device__ __forceinline__ unsigned xb_xcc_id() { return (unsigned)__builtin_amdgcn_s_getreg((3 << 11) | 20) & 0xFu; }
#define XB_SPIN(cond, bar) do { unsigned _sp = 0; while (cond) { __builtin_amdgcn_s_sleep(1); \
    if ((++_sp & 255u) == 0u) { if (xb_ld(&(bar)[XB_TMO])) break; if (_sp > XB_SPIN_CAP) { atomicAdd(&(bar)[XB_TMO], 1u); break; } } } } while (0)

struct XcdBarrier {
    unsigned* bar; unsigned x;
    volatile LAS unsigned* st;
};

__device__ __forceinline__ XcdBarrier xcd_barrier_post(unsigned* bar, volatile LAS unsigned* st) {
    XcdBarrier b; b.bar = bar; b.x = xb_xcc_id(); b.st = st;
    if (threadIdx.x == 0) (void)xb_add(&bar[XB_XCNT(b.x)], 1u);
    return b;
}
__device__ __forceinline__ void xcd_barrier_complete(unsigned* bar, unsigned x, unsigned& nloc, unsigned& nx) {
    const unsigned G = gridDim.x * gridDim.y * gridDim.z;
    unsigned sum, cnt, mine, sp = 0u;
    for (;;) {
        sum = 0u; cnt = 0u; mine = 0u;
#pragma unroll
        for (unsigned j = 0; j < 16; ++j) { const unsigned c = xb_ld(&bar[XB_XCNT(j)]); sum += c; cnt += (c > 0u) ? 1u : 0u; mine = (j == x) ? c : mine; }
        if (sum == G) break;
        __builtin_amdgcn_s_sleep(1);
        if ((++sp & 255u) == 0u) { if (xb_ld(&bar[XB_TMO])) break; if (sp > XB_SPIN_CAP) { atomicAdd(&bar[XB_TMO], 1u); break; } }
    }
    nloc = mine > 0u ? mine : 1u; nx = cnt > 0u ? cnt : 1u;
}

__device__ __forceinline__ void xcd_barrier(const XcdBarrier& b) {
    asm volatile("s_waitcnt vmcnt(0)" ::: "memory");
    __syncthreads();
    if (threadIdx.x == 0) {
        unsigned* bar = b.bar;
        __builtin_amdgcn_s_waitcnt(0);
        unsigned nloc = b.st[0], nx = b.st[1];
        if (nloc == 0u) { xcd_barrier_complete(bar, b.x, nloc, nx); b.st[0] = nloc; b.st[1] = nx; }
        const unsigned old = xb_add(&bar[XB_XSUB(b.x)], 1u);
        const unsigned gen = old / nloc;
        if (old + 1u == (gen + 1u) * nloc) {
            __builtin_amdgcn_fence(__ATOMIC_RELEASE, "agent");
            asm volatile("s_waitcnt vmcnt(0)" ::: "memory");
            const unsigned og = xb_add(&bar[XB_TOP], 1u);
            const unsigned tg = og / nx;
            if (og + 1u == (tg + 1u) * nx) xb_add(&bar[XB_TOPGEN], 1u);
            else XB_SPIN(xb_ld(&bar[XB_TOPGEN]) == tg, bar);
            __builtin_amdgcn_fence(__ATOMIC_ACQUIRE, "agent");
            xb_add(&bar[XB_XGEN(b.x)], 1u);
            asm volatile("s_waitcnt vmcnt(0)" ::: "memory");
        } else {
            XB_SPIN(xb_ld(&bar[XB_XGEN(b.x)]) == gen, bar);
            __builtin_amdgcn_fence(__ATOMIC_ACQUIRE, "agent");
            asm volatile("s_waitcnt vmcnt(0)" ::: "memory");
        }
    }
    __syncthreads();
}


__global__ void __launch_bounds__(256, 2) mega(Params pin) {
  __shared__ __attribute__((aligned(16))) char smem[2 * 2 * 128 * GP * 2];
  __shared__ int s_item;
  __shared__ uint4 xb_words;
  if (threadIdx.x == 0) xb_words = make_uint4(0u, 0u, 0u, 0u);
  __syncthreads();
  XcdBarrier xb; xb.bar = nullptr; xb.x = 0u; xb.st = (volatile LAS unsigned*)&xb_words;
  bool xb_posted = false;
  const int G = gridDim.x, b = blockIdx.x;
  const int vb = ((G & 7) == 0) ? ((b & 7) * (G >> 3) + (b >> 3)) : b;
  for (int st = pin.phase_lo; st < pin.phase_hi; ++st) {
    int ph; bool dry = false;
    if (st == 0) ph = 0;
    else if (st == 41) ph = 21;
    else {
      const int u = st - 1, lay = u / 20, v = u - lay * 20, sb = v >> 1;
      dry = (v & 1) == 0;
      if (dry && !((pin.probe >> sb) & 1)) continue;
      if (lay == 0 && sb == 0) continue;
      ph = 1 + lay * 10 + sb;
    }
    if (st > pin.phase_lo) {
      if (!xb_posted) {
        cg::this_grid().sync();
        xb = xcd_barrier_post((unsigned*)(pin.ws + OFF_BAR), (volatile LAS unsigned*)&xb_words);
        xb_posted = true;
      } else xcd_barrier(xb);
    }
    Params p = pin;
    asm volatile("" : "+s"(p.xp), "+s"(p.xs), "+s"(p.meta), "+s"(p.attn_g), "+s"(p.w_in), "+s"(p.qa_g), "+s"(p.w_qb), "+s"(p.kva_g), "+s"(p.w_kvb), "+s"(p.gq_g));
    asm volatile("" : "+s"(p.gk_g), "+s"(p.mo_g), "+s"(p.go_g), "+s"(p.w_out), "+s"(p.mlp_g), "+s"(p.w_up), "+s"(p.w_dn), "+s"(p.fin_g), "+s"(p.out), "+s"(p.ws));
    int tid = threadIdx.x;
    asm volatile("" : "+v"(tid));
    const int lane = tid & 63, wave = tid >> 6, r = lane & 31;
    float* ssq = (float*)(p.ws + OFF_SSQ);
    const float2* tab = (const float2*)(p.ws + OFF_TAB);
    if (ph == 0) { phase_prep(p, tid); phase_norm(p, p.attn_g, true, true, tid); continue; }
    if (ph == 21) { phase_final(p, tid); continue; }
    const int layer = (ph - 1) / 10, sub = (ph - 1) % 10;
    const u16* Wl = (const u16*)(p.ws + OFF_W) + (size_t)layer * W_LAYER;
    if (sub == 0) {
      phase_norm(p, p.attn_g + layer * 1024, layer == 0, true, tid);
    } else if (sub == 1) {
      EpiIn e; e.CQ = (u16*)(p.ws + OFF_CQ); e.CKV = (u16*)(p.ws + OFF_CKV); e.QG = (u16*)(p.ws + OFF_QG); e.KG = (u16*)(p.ws + OFF_KG);
      e.VGT = (u16*)(p.ws + OFF_VGT); e.KPE = (u16*)(p.ws + OFF_KPE); e.ssq_q = ssq; e.ssq_kv = ssq + MPAD;
      e.gq_g = p.gq_g + layer * 64; e.gk_g = p.gk_g + layer * 64; e.tab = tab;
      APLin ap{(const u16*)(p.ws + OFF_HN), 1024};
      for (int t = vb; t < NTM * 12; t += G) { const int mt = t / 12, nt = t - mt * 12; gemm_tile<false>(ap, Wl + WO_IN, 1024, 1024, mt * 128, nt * 128, e, smem, 1.f, 1.f, tid, dry); }
    } else if (sub == 2) {
      EpiQB e2; e2.QM = (u16*)(p.ws + OFF_HN); e2.ssq_q = ssq; e2.tab = tab;
      EpiKVB e3; e3.KN = (u16*)(p.ws + OFF_KN); e3.VMT = (u16*)(p.ws + OFF_VMT); e3.ssq_kv = ssq + MPAD;
      APLin a2{(const u16*)(p.ws + OFF_CQ), 384};
      APLin a3{(const u16*)(p.ws + OFF_CKV), 256};
      for (int t = vb; t < NTM * 14; t += G) {
        if (t < NTM * 6) { const int mt = t / 6, nt = t - mt * 6; gemm_tile<false>(a2, Wl + WO_QB, 384, 384, mt * 128, nt * 128, e2, smem, 1.f, 1.f, tid, dry); }
        else { const int u = t - NTM * 6; const int mt = u >> 3, nt = u & 7; gemm_tile<false>(a3, Wl + WO_KVB, 256, 256, mt * 128, nt * 128, e3, smem, 1.f, 1.f, tid, dry); }
      }
    } else if (sub == 3) {
      phase_attn(p, layer, smem, &s_item, tid, dry);
    } else if (sub == 4) {
      APMix ap{(const u16*)(p.ws + OFF_HN), (const u16*)(p.ws + OFF_QG)};
      for (int t = vb; t < NTM * 8; t += G) {
        const int mt = t >> 3, nt = t & 7;
        const int g0 = mt * 128 + (wave >> 1) * 64 + r;
        const float ra0 = rsqrtf(ldgf(ssq + 2 * (size_t)MPAD + g0) * (1.0f / 512.0f) + EPS), rg0 = rsqrtf(ldgf(ssq + 3 * (size_t)MPAD + g0) * (1.0f / 512.0f) + EPS);
        const float ra1 = rsqrtf(ldgf(ssq + 2 * (size_t)MPAD + g0 + 32) * (1.0f / 512.0f) + EPS), rg1 = rsqrtf(ldgf(ssq + 3 * (size_t)MPAD + g0 + 32) * (1.0f / 512.0f) + EPS);
        EpiRes e; res_bases(p, mt, layer == 0, e.sb, e.db, e.minrow); e.fin0 = rg0; e.fin1 = rg1;
        gemm_tile<true>(ap, Wl + WO_OUT, 1024, 1024, mt * 128, nt * 128, e, smem, ra0 / rg0, ra1 / rg1, tid, dry);
      }
    } else if (sub == 5) {
      phase_norm(p, p.mlp_g + layer * 1024, false, false, tid);
    } else if (sub == 6 || sub == 8) {
      const int mh = (sub - 6) >> 1;
      EpiUp e; e.U0 = (u16*)(p.ws + OFF_U) - (size_t)mh * 259 * 128 * 4096;
      APLin ap{(const u16*)(p.ws + OFF_HN), 1024};
      for (int t = vb; t < 259 * 32; t += G) {
        int ml, nt;
        if (t < 256 * 32) { const int blk = t >> 6, w = t & 63; ml = (blk >> 2) * 8 + (w >> 3); nt = (blk & 3) * 8 + (w & 7); }
        else { ml = t >> 5; nt = t & 31; }
        gemm_tile<false>(ap, Wl + WO_UP, 1024, 1024, (mh * 259 + ml) * 128, nt * 128, e, smem, 1.f, 1.f, tid, dry);
      }
    } else {
      const int mh = (sub - 7) >> 1;
      APLin ap{(const u16*)(p.ws + OFF_U) - (size_t)mh * 259 * 128 * 4096, 4096};
      for (int t = vb; t < 259 * 8; t += G) {
        const int mt = mh * 259 + (t >> 3), nt = t & 7;
        EpiRes e; res_bases(p, mt, false, e.sb, e.db, e.minrow); e.fin0 = 1.f; e.fin1 = 1.f;
        gemm_tile<false>(ap, Wl + WO_DN, 4096, 4096, mt * 128, nt * 128, e, smem, 1.f, 1.f, tid, dry);
      }
    }
  }
}

extern "C" void kernel_launch(void* const* d_in, const int* in_sizes, int n_in, void* d_out, int out_size, void* d_ws, size_t ws_size,
                              hipStream_t stream) {
  static int grid_blocks = 0;
  if (!grid_blocks) {
    int dev = 0, cus = 0, per_cu = 0;
    hipGetDevice(&dev);
    hipDeviceGetAttribute(&cus, hipDeviceAttributeMultiprocessorCount, dev);
    hipOccupancyMaxActiveBlocksPerMultiprocessor(&per_cu, mega, 256, 0);
    if (per_cu > 2) per_cu = 2;
    if (per_cu < 1) per_cu = 1;
    grid_blocks = cus * per_cu;
  }
  Params p{};
  p.xp = (const float*)d_in[0]; p.xs = (const float*)d_in[1]; p.meta = (const float*)d_in[2];
  p.attn_g = (const float*)d_in[3]; p.w_in = (const float*)d_in[4]; p.qa_g = (const float*)d_in[5]; p.w_qb = (const float*)d_in[6];
  p.kva_g = (const float*)d_in[7]; p.w_kvb = (const float*)d_in[8]; p.gq_g = (const float*)d_in[9]; p.gk_g = (const float*)d_in[10];
  p.mo_g = (const float*)d_in[11]; p.go_g = (const float*)d_in[12]; p.w_out = (const float*)d_in[13]; p.mlp_g = (const float*)d_in[14];
  p.w_up = (const float*)d_in[15]; p.w_dn = (const float*)d_in[16]; p.fin_g = (const float*)d_in[17];
  p.out = (float*)d_out; p.ws = (char*)d_ws;
#if MK_MULTI
  for (int ph = 0; ph < 42; ++ph) {
    p.phase_lo = ph; p.phase_hi = ph + 1; p.probe = PROBE_MASK;
    if (ph > 0 && ph < 41 && ((ph - 1) & 1) == 0 && !((PROBE_MASK >> (((ph - 1) % 20) >> 1)) & 1)) continue;
    hipLaunchKernelGGL(mega, dim3(grid_blocks), dim3(256), 0, stream, p);
  }
#else
  p.phase_lo = 0; p.phase_hi = 42; p.probe = PROBE_MASK;
  void* args[] = {&p};
  hipError_t e = hipLaunchCooperativeKernel((void*)mega, dim3(grid_blocks), dim3(256), args, 0, stream);
  if (e != hipSuccess) fprintf(stderr, "cooperative launch failed: %s (grid %d)\n", hipGetErrorString(e), grid_blocks);
#endif
}
```

```cpp
#include <hip/hip_runtime.h>
#include <hip/hip_cooperative_groups.h>
#include <stdint.h>
#include <cstdio>
namespace cg = cooperative_groups;

#ifndef PROBE_MASK
#define PROBE_MASK 0
#endif
#ifndef MK_MULTI
#define MK_MULTI 0
#endif

typedef unsigned short u16;
typedef short bf16x8 __attribute__((ext_vector_type(8)));
typedef float f32x16 __attribute__((ext_vector_type(16)));
typedef unsigned u32x4 __attribute__((ext_vector_type(4)));
typedef unsigned u32x2 __attribute__((ext_vector_type(2)));
typedef float f32x2v __attribute__((ext_vector_type(2)));
typedef __bf16 bf16x2v __attribute__((ext_vector_type(2)));
#define DI __device__ __forceinline__
#define GAS __attribute__((address_space(1)))
#define WAVE_LDS_FENCE() asm volatile("s_waitcnt lgkmcnt(0)" ::: "memory")
#define MFMA(a, b, c) __builtin_amdgcn_mfma_f32_32x32x16_bf16((a), (b), (c), 0, 0, 0)

constexpr int MPAD = 66304;
constexpr int NTM = 518;
constexpr float EPS = 1e-6f;
constexpr float LOG2E = 1.4426950408889634f;
constexpr float QSCALE_M = 0.10206207261596575f * LOG2E;
constexpr float QSCALE_G = 0.125f * LOG2E;

constexpr size_t SZ_WIN = 1536ull * 1024, SZ_WQB = 768ull * 384, SZ_WKVB = 1024ull * 256, SZ_WOUT = 1024ull * 1024,
                 SZ_WUP = 4096ull * 1024, SZ_WDN = 1024ull * 4096;
constexpr size_t WO_IN = 0, WO_QB = WO_IN + SZ_WIN, WO_KVB = WO_QB + SZ_WQB, WO_OUT = WO_KVB + SZ_WKVB, WO_UP = WO_OUT + SZ_WOUT,
                 WO_DN = WO_UP + SZ_WUP, W_LAYER = WO_DN + SZ_WDN;
constexpr size_t OFF_W = 0;
constexpr size_t OFF_TAB = OFF_W + 2 * W_LAYER * 2;
constexpr size_t OFF_XMETA = OFF_TAB + 16400ull * 16 * 8;
constexpr size_t OFF_SSQ = OFF_XMETA + 96ull * 1024 * 4;
constexpr size_t OFF_CNT = OFF_SSQ + 4ull * MPAD * 4;
constexpr size_t OFF_BAR = OFF_CNT + 1024;
constexpr size_t OFF_HN = OFF_BAR + 16384;
constexpr size_t OFF_CQ = OFF_HN + (size_t)MPAD * 1024 * 2;
constexpr size_t OFF_CKV = OFF_CQ + (size_t)MPAD * 384 * 2;
constexpr size_t OFF_KN = OFF_CKV + (size_t)MPAD * 256 * 2;
constexpr size_t OFF_KPE = OFF_KN + (size_t)MPAD * 512 * 2;
constexpr size_t OFF_VMT = OFF_KPE + (size_t)MPAD * 32 * 2;
constexpr size_t OFF_QG = OFF_VMT + (size_t)MPAD * 512 * 2;
constexpr size_t OFF_KG = OFF_QG + (size_t)MPAD * 512 * 2;
constexpr size_t OFF_VGT = OFF_KG + (size_t)MPAD * 128 * 2;
constexpr size_t OFF_END = OFF_VGT + (size_t)MPAD * 128 * 2;
constexpr size_t OFF_U = OFF_CQ;
static_assert(OFF_U + (size_t)259 * 128 * 4096 * 2 <= OFF_END, "U fits");
static_assert(OFF_END <= 536870912ull, "workspace");

struct Params {
  const float* xp; const float* xs; const float* meta;
  const float* attn_g; const float* w_in; const float* qa_g; const float* w_qb; const float* kva_g; const float* w_kvb;
  const float* gq_g; const float* gk_g; const float* mo_g; const float* go_g; const float* w_out; const float* mlp_g;
  const float* w_up; const float* w_dn; const float* fin_g;
  float* out; char* ws;
  int phase_lo, phase_hi, probe, pad_;
};


DI u32x4 ldg16(const void* p) { return *(const GAS u32x4*)p; }
DI void stg16(void* p, u32x4 v) { *(GAS u32x4*)p = v; }
DI void stg8(void* p, u32x2 v) { *(GAS u32x2*)p = v; }
typedef float f32x4v __attribute__((ext_vector_type(4)));
DI float4 ldgf4(const void* p) { const f32x4v v = *(const GAS f32x4v*)p; return make_float4(v.x, v.y, v.z, v.w); }
DI float ldgf(const float* p) { return *(const GAS float*)p; }
DI float2 ldgf2(const float2* p) { typedef float f32x2g __attribute__((ext_vector_type(2))); const f32x2g v = *(const GAS f32x2g*)p; return make_float2(v.x, v.y); }
DI void stgh(u16* p, u16 v) { *(GAS u16*)p = v; }
DI void stgf4(void* p, float4 v) { f32x4v w = {v.x, v.y, v.z, v.w}; *(GAS f32x4v*)p = w; }
DI unsigned pack2(float a, float b) { f32x2v f = {a, b}; bf16x2v v = __builtin_convertvector(f, bf16x2v); return __builtin_bit_cast(unsigned, v); }
DI u16 f2bf(float a) { return (u16)(pack2(a, 0.f) & 0xffffu); }
DI void store4(u16* dst, float a, float b, float c, float d) { u32x2 v = {pack2(a, b), pack2(c, d)}; *(u32x2*)dst = v; }
DI void store4g(u16* dst, float a, float b, float c, float d) { u32x2 v = {pack2(a, b), pack2(c, d)}; stg8(dst, v); }
DI int crow(int i, int h) { return (i & 3) + 8 * (i >> 2) + 4 * h; }
DI int swap23(int r) { return (r & 0x13) | ((r & 4) << 1) | ((r & 8) >> 1); }
DI float xhalf(float v) { return __shfl_xor(v, 32); }

DI void decode_tile(int T, int& seq, int& i) {
  if (T < 258) { seq = (T >= 129) ? 1 : 0; i = T - seq * 129; }
  else { int u = T - 258; int q = u / 65; seq = 2 + q; i = u - q * 65; }
}
DI int seq_base(int seq) { return seq < 2 ? seq * 16512 : 33024 + (seq - 2) * 8320; }

DI const float* xrow_src(const Params& p, int g, bool from_input) {
  int T = g >> 7, r = g & 127, seq, i; decode_tile(T, seq, i);
  if (i == 0) {
    if (r < 112) return nullptr;
    return from_input ? p.meta + (size_t)(r - 112) * 1024 : (const float*)(p.ws + OFF_XMETA) + (size_t)(seq * 16 + r - 112) * 1024;
  }
  int j = (i - 1) * 128 + r;
  if (seq < 2) { size_t row = (size_t)seq * 16384 + j; return from_input ? p.xp + row * 1024 : p.out + row * 1024; }
  size_t row = (size_t)(seq - 2) * 8192 + j;
  return from_input ? p.xs + row * 1024 : p.out + (32768 + row) * 1024;
}
DI float* xrow_dst(const Params& p, int g) {
  int T = g >> 7, r = g & 127, seq, i; decode_tile(T, seq, i);
  if (i == 0) {
    if (r < 112) return nullptr;
    return (float*)(p.ws + OFF_XMETA) + (size_t)(seq * 16 + r - 112) * 1024;
  }
  int j = (i - 1) * 128 + r;
  if (seq < 2) { size_t row = (size_t)seq * 16384 + j; return p.out + row * 1024; }
  size_t row = (size_t)(seq - 2) * 8192 + j;
  return p.out + (32768 + row) * 1024;
}

DI int mapcol(int kind, int n) {
  if (kind == 1) { if (n < 640) return n; if (n < 1408) return n + 32; if (n < 1440) return 640 + (n - 1408); return -1; }
  if (kind == 2) { if (n < 512) return (n >> 6) * 96 + (n & 63); int m = n - 512; return (m >> 5) * 96 + 64 + (m & 31); }
  if (kind == 3) { if (n < 512) return (n >> 6) * 128 + (n & 63); int m = n - 512; return (m >> 6) * 128 + 64 + (m & 63); }
  return n;
}
DI void prep_weight(const float* __restrict__ src, int Nsrc, u16* __restrict__ dst, int Nout, int K, const float* gA, const float* gB,
                    int ksplit, int kind, int gtid, int gthreads) {
  const int total = Nout * (K >> 3);
  for (int u = gtid; u < total; u += gthreads) {
    const int n = u % Nout, kc = u / Nout;
    const int col = mapcol(kind, n);
    const int k = kc * 8;
    float v[8];
#pragma unroll
    for (int j = 0; j < 8; ++j) {
      float x = 0.f;
      if (col >= 0) {
        x = src[(size_t)(k + j) * Nsrc + col];
        if (gA) x *= (k + j < ksplit) ? gA[k + j] : gB[k + j - ksplit];
      }
      v[j] = x;
    }
    u32x4 o = {pack2(v[0], v[1]), pack2(v[2], v[3]), pack2(v[4], v[5]), pack2(v[6], v[7])};
    *(u32x4*)(dst + (size_t)n * K + k) = o;
  }
}

DI void phase_prep(const Params& p, int tid) {
  const int gtid = blockIdx.x * 256 + tid, gthreads = gridDim.x * 256;
  u16* W = (u16*)(p.ws + OFF_W);
  for (int l = 0; l < 2; ++l) {
    u16* Wl = W + (size_t)l * W_LAYER;
    prep_weight(p.w_in + (size_t)l * 1024 * 1440, 1440, Wl + WO_IN, 1536, 1024, nullptr, nullptr, 0, 1, gtid, gthreads);
    prep_weight(p.w_qb + (size_t)l * 384 * 768, 768, Wl + WO_QB, 768, 384, p.qa_g + l * 384, p.qa_g + l * 384, 384, 2, gtid, gthreads);
    prep_weight(p.w_kvb + (size_t)l * 256 * 1024, 1024, Wl + WO_KVB, 1024, 256, p.kva_g + l * 256, p.kva_g + l * 256, 256, 3, gtid, gthreads);
    prep_weight(p.w_out + (size_t)l * 1024 * 1024, 1024, Wl + WO_OUT, 1024, 1024, p.mo_g + l * 512, p.go_g + l * 512, 512, 0, gtid, gthreads);
    prep_weight(p.w_up + (size_t)l * 1024 * 4096, 4096, Wl + WO_UP, 4096, 1024, nullptr, nullptr, 0, 0, gtid, gthreads);
    prep_weight(p.w_dn + (size_t)l * 4096 * 1024, 1024, Wl + WO_DN, 1024, 4096, nullptr, nullptr, 0, 0, gtid, gthreads);
  }
  float2* tab = (float2*)(p.ws + OFF_TAB);
  for (int u = gtid; u < 16400 * 16; u += gthreads) {
    const int pos = u >> 4, f = u & 15;
    const float invf = 1.0f / powf(10000.0f, (float)(2 * f) / 32.0f);
    const float ang = (float)pos * invf;
    const double rev = (double)ang * 0.15915494309189535;
    const double fr = rev - rint(rev);
    const float x = (float)(2.0 * fr);
    tab[u] = make_float2(cospif(x), sinpif(x));
  }
  float* xm = (float*)(p.ws + OFF_XMETA);
  for (int u = gtid; u < 96 * 1024; u += gthreads) xm[u] = p.meta[u & 16383];
  int* cnt = (int*)(p.ws + OFF_CNT);
  if (gtid < 128) cnt[gtid] = 0;
  unsigned* bar = (unsigned*)(p.ws + OFF_BAR);
  if (gtid < 4096) bar[gtid] = 0u;
}

DI void phase_norm(const Params& p, const float* __restrict__ gain, bool from_input, bool zero_ssq, int tid) {
  const int lane = tid & 63;
  const int gw = blockIdx.x * 4 + (tid >> 6), nw = gridDim.x * 4;
  u16* HN = (u16*)(p.ws + OFF_HN);
  float* ssq = (float*)(p.ws + OFF_SSQ);
  for (int g = gw; g < MPAD; g += nw) {
    const float* xr = xrow_src(p, g, from_input);
    u16* hr = HN + (size_t)g * 1024;
    if (!xr) {
      u32x4 z = {0u, 0u, 0u, 0u};
      *(u32x4*)(hr + lane * 16) = z;
      *(u32x4*)(hr + lane * 16 + 8) = z;
    } else {
      float4 v[4];
#pragma unroll
      for (int q = 0; q < 4; ++q) v[q] = ldgf4((const float4*)xr + lane + 64 * q);
      float ss = 0.f;
#pragma unroll
      for (int q = 0; q < 4; ++q) ss += v[q].x * v[q].x + v[q].y * v[q].y + v[q].z * v[q].z + v[q].w * v[q].w;
#pragma unroll
      for (int o = 32; o >= 1; o >>= 1) ss += __shfl_xor(ss, o);
      const float rstd = rsqrtf(ss * (1.0f / 1024.0f) + EPS);
#pragma unroll
      for (int q = 0; q < 4; ++q) {
        const float4 gg = ldgf4((const float4*)gain + lane + 64 * q);
        store4g(hr + 4 * (lane + 64 * q), v[q].x * rstd * gg.x, v[q].y * rstd * gg.y, v[q].z * rstd * gg.z, v[q].w * rstd * gg.w);
      }
    }
    if (zero_ssq && lane < 4) ssq[(size_t)lane * MPAD + g] = 0.f;
  }
}

DI void phase_final(const Params& p, int tid) {
  const int lane = tid & 63;
  const int gw = blockIdx.x * 4 + (tid >> 6), nw = gridDim.x * 4;
  for (int g = gw; g < MPAD; g += nw) {
    if (((g >> 7) == 0) || ((g >> 7) == 129) || ((g >> 7) >= 258 && ((g >> 7) - 258) % 65 == 0)) continue;
    float* xr = xrow_dst(p, g);
    float4 v[4];
#pragma unroll
    for (int q = 0; q < 4; ++q) v[q] = ldgf4((const float4*)xr + lane + 64 * q);
    float ss = 0.f;
#pragma unroll
    for (int q = 0; q < 4; ++q) ss += v[q].x * v[q].x + v[q].y * v[q].y + v[q].z * v[q].z + v[q].w * v[q].w;
#pragma unroll
    for (int o = 32; o >= 1; o >>= 1) ss += __shfl_xor(ss, o);
    const float rstd = rsqrtf(ss * (1.0f / 1024.0f) + EPS);
#pragma unroll
    for (int q = 0; q < 4; ++q) {
      const float4 gg = ldgf4((const float4*)p.fin_g + lane + 64 * q);
      float4 o = make_float4(v[q].x * rstd * gg.x, v[q].y * rstd * gg.y, v[q].z * rstd * gg.z, v[q].w * rstd * gg.w);
      stgf4((float4*)xr + lane + 64 * q, o);
    }
  }
}

constexpr int GP = 72;
struct APLin { const u16* A; int lda; DI const u16* ptr(int row, int k0) const { return A + (size_t)row * lda + k0; } };
struct APMix { const u16* QM; const u16* QG;
  DI const u16* ptr(int row, int k0) const { return k0 < 512 ? QM + (size_t)row * 768 + (k0 >> 6) * 96 : QG + (size_t)row * 512 + (k0 - 512); } };

template <bool MIDK, class AP, class EPI>
DI void gemm_tile(const AP& ap, const u16* __restrict__ W, int ldw, int K, int m0, int n0, const EPI& epi, char* smem, float r0, float r1, int tid, bool dry) {
  constexpr int SBUF = 2 * 128 * GP;
  u16* sA = (u16*)smem;
  u16* sB = sA + 128 * GP;
  const int lane = tid & 63, wave = tid >> 6, r = lane & 31, h = lane >> 5, wm = wave >> 1, wn = wave & 1;
  const int lrow = tid >> 3, lkc = (tid & 7) * 8;
  u32x4 ra0[4], rb0[4], ra1[4], rb1[4];
  f32x16 acc[2][2];
#pragma unroll
  for (int a = 0; a < 2; ++a)
#pragma unroll
    for (int b = 0; b < 2; ++b)
#pragma unroll
      for (int i = 0; i < 16; ++i) acc[a][b][i] = 0.f;
  const int nk = K >> 6;
#define GLOADQ(RA, RB, KT, q) do { const int k0_ = (KT) << 6; \
    RA[q] = ldg16(ap.ptr(m0 + lrow + 32 * (q), k0_) + lkc); RB[q] = ldg16(W + (size_t)(n0 + lrow + 32 * (q)) * ldw + k0_ + lkc); } while (0)
#define GLOAD(RA, RB, KT) do { GLOADQ(RA, RB, KT, 0); GLOADQ(RA, RB, KT, 1); GLOADQ(RA, RB, KT, 2); GLOADQ(RA, RB, KT, 3); } while (0)
#define SSTOREQ(RA, RB, ST, q) do { \
    *(u32x4*)(sA + (ST) * SBUF + (lrow + 32 * (q)) * GP + lkc) = RA[q]; *(u32x4*)(sB + (ST) * SBUF + (lrow + 32 * (q)) * GP + lkc) = RB[q]; } while (0)
#define SSTORE(RA, RB, ST) do { SSTOREQ(RA, RB, ST, 0); SSTOREQ(RA, RB, ST, 1); SSTOREQ(RA, RB, ST, 2); SSTOREQ(RA, RB, ST, 3); } while (0)
#define FLOAD(F, ST, ks) do { _Pragma("unroll") for (int a = 0; a < 2; ++a) { \
    F[a] = *(const bf16x8*)(sB + (ST) * SBUF + (wn * 64 + a * 32 + r) * GP + (ks) * 16 + h * 8); \
    F[2 + a] = *(const bf16x8*)(sA + (ST) * SBUF + (wm * 64 + a * 32 + r) * GP + (ks) * 16 + h * 8); } } while (0)
#define FMMA(F) do { _Pragma("unroll") for (int a = 0; a < 2; ++a) _Pragma("unroll") for (int b = 0; b < 2; ++b) acc[a][b] = MFMA(F[a], F[2 + b], acc[a][b]); } while (0)
  bf16x8 f0[4], f1[4];
  GLOAD(ra0, rb0, 0);
  GLOAD(ra1, rb1, 1);
  __syncthreads();
  SSTORE(ra0, rb0, 0);
  if (nk > 2) GLOAD(ra0, rb0, 2);
  __syncthreads();
  for (int kt = 0; kt < nk; kt += 2) {
    const bool l3 = kt + 3 < nk, s2 = kt + 2 < nk, l4 = kt + 4 < nk;
    FLOAD(f0, 0, 0); FLOAD(f1, 0, 1);
    FMMA(f0); SSTOREQ(ra1, rb1, 1, 0); if (l3) GLOADQ(ra1, rb1, kt + 3, 0);
    FLOAD(f0, 0, 2);
    FMMA(f1); SSTOREQ(ra1, rb1, 1, 1); if (l3) GLOADQ(ra1, rb1, kt + 3, 1);
    FLOAD(f1, 0, 3);
    FMMA(f0); SSTOREQ(ra1, rb1, 1, 2); if (l3) GLOADQ(ra1, rb1, kt + 3, 2);
    FMMA(f1); SSTOREQ(ra1, rb1, 1, 3); if (l3) GLOADQ(ra1, rb1, kt + 3, 3);
    __syncthreads();
    FLOAD(f0, 1, 0); FLOAD(f1, 1, 1);
    FMMA(f0); if (s2) SSTOREQ(ra0, rb0, 0, 0); if (l4) GLOADQ(ra0, rb0, kt + 4, 0);
    FLOAD(f0, 1, 2);
    FMMA(f1); if (s2) SSTOREQ(ra0, rb0, 0, 1); if (l4) GLOADQ(ra0, rb0, kt + 4, 1);
    FLOAD(f1, 1, 3);
    FMMA(f0); if (s2) SSTOREQ(ra0, rb0, 0, 2); if (l4) GLOADQ(ra0, rb0, kt + 4, 2);
    FMMA(f1); if (s2) SSTOREQ(ra0, rb0, 0, 3); if (l4) GLOADQ(ra0, rb0, kt + 4, 3);
    if (MIDK && kt == 6) {
#pragma unroll
      for (int a = 0; a < 2; ++a)
#pragma unroll
        for (int i = 0; i < 16; ++i) { acc[a][0][i] *= r0; acc[a][1][i] *= r1; }
    }
    __syncthreads();
  }
#undef GLOADQ
#undef SSTOREQ
#undef FLOAD
#undef FMMA
#undef GLOAD
#undef SSTORE
  if (!dry) epi(acc, n0 + wn * 64, m0 + wm * 64, lane, (u16*)smem + wave * 64 * GP);
}

struct ColId { DI int operator()(int ch) const { return ch * 8; } };
struct ColRope { DI int operator()(int ch) const { return (ch >> 2) * 96 + (ch & 3) * 8; } };

template <class COLF>
DI void stage_store(f32x16 (&acc)[2][2], u16* wl, int lane, u16* dst0, size_t pitch, const COLF& colf) {
  const int r = lane & 31, h = lane >> 5;
#pragma unroll
  for (int rb = 0; rb < 2; ++rb)
#pragma unroll
    for (int lb = 0; lb < 2; ++lb)
#pragma unroll
      for (int g4 = 0; g4 < 4; ++g4)
        store4(wl + (lb * 32 + r) * GP + rb * 32 + 8 * g4 + 4 * h, acc[rb][lb][4 * g4], acc[rb][lb][4 * g4 + 1], acc[rb][lb][4 * g4 + 2], acc[rb][lb][4 * g4 + 3]);
  WAVE_LDS_FENCE();
#pragma unroll
  for (int it = 0; it < 8; ++it) {
    const int row = it * 8 + (lane >> 3), ch = lane & 7;
    const u32x4 v = *(const u32x4*)(wl + row * GP + ch * 8);
    stg16(dst0 + (size_t)row * pitch + colf(ch), v);
  }
  WAVE_LDS_FENCE();
}

DI void rope16(float (&v)[16], const float2* __restrict__ tabrow, int h) {
#pragma unroll
  for (int i = 0; i < 8; ++i) {
    const int f = (i & 3) + 8 * (i >> 2) + 4 * h;
    const float2 cs = ldgf2(tabrow + f);
    const float x1 = v[i], x2 = v[i + 8];
    v[i] = x1 * cs.x - x2 * cs.y;
    v[i + 8] = x2 * cs.x + x1 * cs.y;
  }
}

struct EpiIn {
  u16 *CQ, *CKV, *QG, *KG, *VGT, *KPE; float *ssq_q, *ssq_kv; const float *gq_g, *gk_g; const float2* tab;
  DI void operator()(f32x16 (&acc)[2][2], int nb, int mb, int lane, u16* wl) const {
    const int r = lane & 31, h = lane >> 5;
    int seq, it; decode_tile(mb >> 7, seq, it);
#pragma unroll
    for (int ti = 0; ti < 2; ++ti) {
      const int g = mb + ti * 32 + r, rr = g & 127;
      if (nb < 640) {
        float ss = 0.f;
#pragma unroll
        for (int fi = 0; fi < 2; ++fi)
#pragma unroll
          for (int i = 0; i < 16; ++i) ss += acc[fi][ti][i] * acc[fi][ti][i];
        ss += xhalf(ss);
        if (h == 0) unsafeAtomicAdd((nb < 384 ? ssq_q : ssq_kv) + g, ss);
      } else if (nb < 1280) {
        const bool isq = nb < 1152;
        const float* gg = isq ? gq_g : gk_g;
        float ss = 0.f;
#pragma unroll
        for (int fi = 0; fi < 2; ++fi)
#pragma unroll
          for (int i = 0; i < 16; ++i) ss += acc[fi][ti][i] * acc[fi][ti][i];
        ss += xhalf(ss);
        const float rstd = rsqrtf(ss * (1.0f / 64.0f) + EPS);
        const float osc = isq ? QSCALE_G : 1.0f;
        int prow = 0, pcol = 0;
        if (it > 0) { const int j = (it - 1) * 128 + rr; prow = j >> 6; pcol = j & 63; }
        u16* dst = isq ? QG + (size_t)g * 512 + (nb - 640) : KG + (size_t)g * 128 + (nb - 1152);
#pragma unroll
        for (int fi = 0; fi < 2; ++fi) {
          const int pos = fi == 0 ? prow : pcol;
          float v[16];
#pragma unroll
          for (int i = 0; i < 16; ++i) v[i] = acc[fi][ti][i] * rstd * ldgf(gg + fi * 32 + crow(i, h));
          rope16(v, tab + pos * 16, h);
#pragma unroll
          for (int g4 = 0; g4 < 4; ++g4)
            store4g(dst + fi * 32 + 8 * g4 + 4 * h, v[4 * g4] * osc, v[4 * g4 + 1] * osc, v[4 * g4 + 2] * osc, v[4 * g4 + 3] * osc);
        }
      } else if (nb < 1408) {
#pragma unroll
        for (int fi = 0; fi < 2; ++fi)
#pragma unroll
          for (int i = 0; i < 16; ++i) stgh(VGT + (size_t)(nb - 1280 + fi * 32 + crow(i, h)) * MPAD + g, f2bf(acc[fi][ti][i]));
      } else if (nb == 1408) {
        int pos = 128 * it + rr - 112; pos = pos < 0 ? 0 : pos;
        float v[16];
#pragma unroll
        for (int i = 0; i < 16; ++i) v[i] = acc[0][ti][i];
        rope16(v, tab + pos * 16, h);
#pragma unroll
        for (int g4 = 0; g4 < 4; ++g4) store4g(KPE + (size_t)g * 32 + 8 * g4 + 4 * h, v[4 * g4], v[4 * g4 + 1], v[4 * g4 + 2], v[4 * g4 + 3]);
      }
    }
    if (nb < 384) stage_store(acc, wl, lane, CQ + (size_t)mb * 384 + nb, 384, ColId());
    else if (nb < 640) stage_store(acc, wl, lane, CKV + (size_t)mb * 256 + (nb - 384), 256, ColId());
  }
};

struct EpiQB {
  u16* QM; const float* ssq_q; const float2* tab;
  DI void operator()(f32x16 (&acc)[2][2], int nb, int mb, int lane, u16* wl) const {
    const int r = lane & 31, h = lane >> 5;
    int seq, it; decode_tile(mb >> 7, seq, it);
#pragma unroll
    for (int ti = 0; ti < 2; ++ti) {
      const int g = mb + ti * 32 + r, rr = g & 127;
      const float sc = rsqrtf(ldgf(ssq_q + g) * (1.0f / 384.0f) + EPS) * QSCALE_M;
      if (nb < 512) {
#pragma unroll
        for (int fi = 0; fi < 2; ++fi)
#pragma unroll
          for (int i = 0; i < 16; ++i) acc[fi][ti][i] *= sc;
      } else {
        int pos = 128 * it + rr - 112; pos = pos < 0 ? 0 : pos;
#pragma unroll
        for (int fi = 0; fi < 2; ++fi) {
          float v[16];
#pragma unroll
          for (int i = 0; i < 16; ++i) v[i] = acc[fi][ti][i] * sc;
          rope16(v, tab + pos * 16, h);
#pragma unroll
          for (int i = 0; i < 16; ++i) acc[fi][ti][i] = v[i];
        }
      }
    }
    if (nb < 512) stage_store(acc, wl, lane, QM + (size_t)mb * 768 + (nb >> 6) * 96, 768, ColId());
    else stage_store(acc, wl, lane, QM + (size_t)mb * 768 + ((nb - 512) >> 5) * 96 + 64, 768, ColRope());
  }
};

struct EpiKVB {
  u16 *KN, *VMT; const float* ssq_kv;
  DI void operator()(f32x16 (&acc)[2][2], int nb, int mb, int lane, u16* wl) const {
    const int r = lane & 31, h = lane >> 5;
#pragma unroll
    for (int ti = 0; ti < 2; ++ti) {
      const int g = mb + ti * 32 + r;
      const float sc = rsqrtf(ldgf(ssq_kv + g) * (1.0f / 256.0f) + EPS);
      if (nb < 512) {
#pragma unroll
        for (int fi = 0; fi < 2; ++fi)
#pragma unroll
          for (int i = 0; i < 16; ++i) acc[fi][ti][i] *= sc;
      } else {
#pragma unroll
        for (int fi = 0; fi < 2; ++fi)
#pragma unroll
          for (int i = 0; i < 16; ++i) stgh(VMT + (size_t)(nb - 512 + fi * 32 + crow(i, h)) * MPAD + g, f2bf(acc[fi][ti][i] * sc));
      }
    }
    if (nb < 512) stage_store(acc, wl, lane, KN + (size_t)mb * 512 + nb, 512, ColId());
  }
};

DI void res_bases(const Params& p, int mt, bool from_input, const float*& sb, float*& db, int& minrow) {
  int seq, it; decode_tile(mt, seq, it);
  float* xm = (float*)(p.ws + OFF_XMETA);
  if (it == 0) {
    minrow = 112;
    db = xm + ((ptrdiff_t)seq * 16 - 112) * 1024;
    sb = from_input ? p.meta - 112 * 1024 : db;
  } else {
    minrow = 0;
    const size_t row = seq < 2 ? (size_t)seq * 16384 + (size_t)(it - 1) * 128 : 32768 + (size_t)(seq - 2) * 8192 + (size_t)(it - 1) * 128;
    db = p.out + row * 1024;
    sb = from_input ? (seq < 2 ? p.xp + row * 1024 : p.xs + (row - 32768) * 1024) : db;
  }
}

struct EpiRes {
  const float* sb; float* db; int minrow; float fin0, fin1;
  DI void operator()(f32x16 (&acc)[2][2], int nb, int mb, int lane, u16* wl) const {
    const int r = lane & 31, h = lane >> 5, mbl = mb & 127;
    float* wf = (float*)wl;
#pragma unroll
    for (int fi = 0; fi < 2; ++fi) {
#pragma unroll
      for (int ti = 0; ti < 2; ++ti) {
        const float sc = ti == 0 ? fin0 : fin1;
#pragma unroll
        for (int g4 = 0; g4 < 4; ++g4) {
          float4 o = make_float4(acc[fi][ti][4 * g4] * sc, acc[fi][ti][4 * g4 + 1] * sc, acc[fi][ti][4 * g4 + 2] * sc, acc[fi][ti][4 * g4 + 3] * sc);
          *(float4*)(wf + (ti * 32 + r) * 36 + 8 * g4 + 4 * h) = o;
        }
      }
      WAVE_LDS_FENCE();
#pragma unroll
      for (int it = 0; it < 8; ++it) {
        const int row = it * 8 + (lane >> 3), ch = lane & 7;
        const float4 a = *(const float4*)(wf + row * 36 + ch * 4);
        const int trow = mbl + row;
        if (trow >= minrow) {
          const size_t off = (size_t)trow * 1024 + nb + fi * 32 + ch * 4;
          float4 x = ldgf4(sb + off);
          x.x += a.x; x.y += a.y; x.z += a.z; x.w += a.w;
          stgf4(db + off, x);
        }
      }
      WAVE_LDS_FENCE();
    }
  }
};

struct EpiUp {
  u16* U0;
  DI void operator()(f32x16 (&acc)[2][2], int nb, int mb, int lane, u16* wl) const {
#pragma unroll
    for (int ti = 0; ti < 2; ++ti)
#pragma unroll
      for (int fi = 0; fi < 2; ++fi)
#pragma unroll
        for (int i = 0; i < 16; ++i) { const float a = fmaxf(acc[fi][ti][i], 0.f); acc[fi][ti][i] = a * a; }
    stage_store(acc, wl, lane, U0 + (size_t)mb * 4096 + nb, 4096, ColId());
  }
};

constexpr float ATT_THR = 8.0f;

template <int DQK>
struct AttnCtx {
  static constexpr int KP = DQK + 8, NKS = DQK / 16, KCH = DQK / 8, NKL = 64 * KCH / 256, KBUF = 64 * KP, VBUF = 64 * GP;
  const u16 *Kb, *KPEb, *Vt; int kpitch, rowk0, nt, tid, r, h, sr;
  u16 *sK, *sV;
  bf16x8 qf[NKS], kone, qm;
  f32x16 o[2];
  float mref, l;
  u32x4 rk[NKL], rv[2];

  int koff[NKL], voff[2];
  DI void init_offs() {
#pragma unroll
    for (int q = 0; q < NKL; ++q) {
      const int c = tid + 256 * q, row = c / KCH, cc = c % KCH;
      koff[q] = (DQK == 96 && cc >= 8) ? row * 32 + (cc - 8) * 8 : row * kpitch + cc * 8;
    }
#pragma unroll
    for (int q = 0; q < 2; ++q) { const int c = tid + 256 * q, dv = c >> 3, kc = c & 7; voff[q] = dv * MPAD + kc * 8; }
  }
  DI void gload_k(int t) {
    const int row0 = rowk0 + t * 64;
    const u16* kt = Kb + (size_t)row0 * kpitch;
    const u16* pt = KPEb + (size_t)row0 * 32;
#pragma unroll
    for (int q = 0; q < NKL; ++q) {
      const int c = tid + 256 * q, cc = c % KCH;
      rk[q] = ldg16(((DQK == 96 && cc >= 8) ? pt : kt) + koff[q]);
    }
  }
  DI void gload_v(int t) {
    const u16* vt = Vt + (rowk0 + t * 64);
#pragma unroll
    for (int q = 0; q < 2; ++q) rv[q] = ldg16(vt + voff[q]);
  }
  DI void sstore_k(int buf) {
#pragma unroll
    for (int q = 0; q < NKL; ++q) {
      const int c = tid + 256 * q, row = c / KCH, cc = c % KCH;
      *(u32x4*)(sK + buf * KBUF + row * KP + cc * 8) = rk[q];
    }
  }
  DI void sstore_v(int buf) {
#pragma unroll
    for (int q = 0; q < 2; ++q) {
      const int c = tid + 256 * q, dv = c >> 3, kc = c & 7;
      *(u32x4*)(sV + buf * VBUF + dv * GP + kc * 8) = rv[q];
    }
  }
  DI void qk(int buf, f32x16 (&s)[2]) {
    const u16* kb = sK + buf * KBUF + sr * KP + h * 8;
#pragma unroll
    for (int kb2 = 0; kb2 < 2; ++kb2)
#pragma unroll
      for (int i = 0; i < 16; ++i) s[kb2][i] = 0.f;
#pragma unroll
    for (int ks = 0; ks < NKS; ++ks)
#pragma unroll
      for (int kb2 = 0; kb2 < 2; ++kb2) {
        const bf16x8 a = *(const bf16x8*)(kb + kb2 * 32 * KP + ks * 16);
        s[kb2] = MFMA(a, qf[ks], s[kb2]);
      }
    s[0] = MFMA(kone, qm, s[0]);
    s[1] = MFMA(kone, qm, s[1]);
  }
  template <int PAR>
  DI void step(int t, f32x16 (&cur)[2], f32x16 (&nxt)[2]) {
    if (t + 1 < nt) sstore_k(PAR ^ 1);
    if (t > 0) sstore_v(PAR);
    __syncthreads();
    if (t + 1 < nt) qk(PAR ^ 1, nxt);
    float mx = fmaxf(cur[0][0], cur[1][0]);
#pragma unroll
    for (int i = 1; i < 16; ++i) mx = fmaxf(fmaxf(cur[0][i], cur[1][i]), mx);
    if (__builtin_amdgcn_ballot_w64(mx > ATT_THR) != 0ull) {
      asm volatile("" ::: "memory");
      mx = fmaxf(mx, xhalf(mx));
      const float want = mref + fmaxf(mx, 0.f);
      const float mn = __uint_as_float(pack2(want, 0.f) << 16);
      const float d = mn - mref;
      const float alpha = __builtin_amdgcn_exp2f(-d);
      mref = mn;
      l *= alpha;
#pragma unroll
      for (int a = 0; a < 2; ++a)
#pragma unroll
        for (int i = 0; i < 16; ++i) { o[a][i] *= alpha; cur[a][i] -= d; nxt[a][i] -= d; }
      u32x4 q4 = {h == 0 ? (pack2(-mn, 0.f) & 0xffffu) : 0u, 0u, 0u, 0u};
      qm = __builtin_bit_cast(bf16x8, q4);
    }
    float psum = 0.f;
#pragma unroll
    for (int kb2 = 0; kb2 < 2; ++kb2)
#pragma unroll
      for (int i = 0; i < 16; ++i) { const float pv = __builtin_amdgcn_exp2f(cur[kb2][i]); cur[kb2][i] = pv; psum += pv; }
    l += psum;
    if (t + 2 < nt) gload_k(t + 2);
    if (t + 1 < nt) gload_v(t + 1);
    const u16* vb = sV + PAR * VBUF + r * GP + h * 8;
#pragma unroll
    for (int kb2 = 0; kb2 < 2; ++kb2)
#pragma unroll
      for (int s2 = 0; s2 < 2; ++s2) {
        u32x4 pk = {pack2(cur[kb2][8 * s2], cur[kb2][8 * s2 + 1]), pack2(cur[kb2][8 * s2 + 2], cur[kb2][8 * s2 + 3]),
                    pack2(cur[kb2][8 * s2 + 4], cur[kb2][8 * s2 + 5]), pack2(cur[kb2][8 * s2 + 6], cur[kb2][8 * s2 + 7])};
        const bf16x8 pf = __builtin_bit_cast(bf16x8, pk);
#pragma unroll
        for (int db = 0; db < 2; ++db) {
          const bf16x8 a = *(const bf16x8*)(vb + db * 32 * GP + kb2 * 32 + s2 * 16);
          o[db] = MFMA(a, pf, o[db]);
        }
      }
  }
};

template <int DQK>
DI void attn_item(const u16* __restrict__ Qb, int qpitch, const u16* __restrict__ Kb, int kpitch, const u16* __restrict__ KPEb,
                  const u16* __restrict__ Vt, float* __restrict__ ssq, int rowq0, int rowk0, int nt, char* smem, int tid, bool dry) {
  typedef AttnCtx<DQK> C;
  C c;
  const int lane = tid & 63, wave = tid >> 6, r = lane & 31, h = lane >> 5;
  c.Kb = Kb; c.KPEb = KPEb; c.Vt = Vt; c.kpitch = kpitch; c.rowk0 = rowk0; c.nt = nt; c.tid = tid; c.r = r; c.h = h; c.sr = swap23(r);
  c.sK = (u16*)smem; c.sV = c.sK + 2 * C::KBUF;
  c.init_offs();
  const int myrow = rowq0 + wave * 32 + r;
  {
    const u16* qrow = Qb + (size_t)myrow * qpitch + h * 8;
#pragma unroll
    for (int ks = 0; ks < C::NKS; ++ks) c.qf[ks] = __builtin_bit_cast(bf16x8, ldg16(qrow + ks * 16));
  }
#pragma unroll
  for (int a = 0; a < 2; ++a)
#pragma unroll
    for (int i = 0; i < 16; ++i) c.o[a][i] = 0.f;
  c.mref = 0.f; c.l = 0.f;
  {
    u32x4 k1 = {h == 0 ? 0x3F80u : 0u, 0u, 0u, 0u}, z4 = {0u, 0u, 0u, 0u};
    c.kone = __builtin_bit_cast(bf16x8, k1); c.qm = __builtin_bit_cast(bf16x8, z4);
  }
  f32x16 sa[2], sb[2];
  c.gload_k(0); c.gload_v(0);
  __syncthreads();
  c.sstore_k(0); c.sstore_v(0);
  if (nt > 1) c.gload_k(1);
  __syncthreads();
  c.qk(0, sa);
#pragma unroll
  for (int i = 0; i < 16; ++i) {
    sa[0][i] = -1e30f;
    if (swap23(crow(i, h)) < 16) sa[1][i] = -1e30f;
  }
  int t = 0;
  for (; t + 1 < nt; t += 2) {
    c.template step<0>(t, sa, sb);
    c.template step<1>(t + 1, sb, sa);
  }
  if (t < nt) c.template step<0>(t, sa, sb);
  if (dry) return;
  float l = c.l;
  l += xhalf(l);
  const float inv = 1.0f / l;
  float ss = 0.f;
  u16* orow = (u16*)Qb + (size_t)myrow * qpitch;
#pragma unroll
  for (int db = 0; db < 2; ++db)
#pragma unroll
    for (int g4 = 0; g4 < 4; ++g4) {
      const float a0 = c.o[db][4 * g4] * inv, a1 = c.o[db][4 * g4 + 1] * inv, a2 = c.o[db][4 * g4 + 2] * inv, a3 = c.o[db][4 * g4 + 3] * inv;
      ss += a0 * a0 + a1 * a1 + a2 * a2 + a3 * a3;
      store4g(orow + db * 32 + 8 * g4 + 4 * h, a0, a1, a2, a3);
    }
  ss += xhalf(ss);
  if (h == 0) unsafeAtomicAdd(ssq + myrow, ss);
}

constexpr int N_ITEMS = 8288;
DI void phase_attn(const Params& p, int layer, char* smem, int* s_item, int tid, bool dry) {
  u16* QM = (u16*)(p.ws + OFF_HN);
  const u16* KN = (const u16*)(p.ws + OFF_KN);
  const u16* KPE = (const u16*)(p.ws + OFF_KPE);
  const u16* VMT = (const u16*)(p.ws + OFF_VMT);
  u16* QG = (u16*)(p.ws + OFF_QG);
  const u16* KG = (const u16*)(p.ws + OFF_KG);
  const u16* VGT = (const u16*)(p.ws + OFF_VGT);
  float* ssq = (float*)(p.ws + OFF_SSQ);
  const int myx = (int)((unsigned)__builtin_amdgcn_s_getreg((3 << 11) | 20) & 7u);
  const int startL = blockIdx.x >= (gridDim.x >> 1) ? 1 : 0;
  int* cq = (int*)(p.ws + OFF_CNT) + 8 + layer * 32 + (dry ? 16 : 0);
  for (int xo = 0; xo < 8; ++xo) {
    const int x = (myx + xo) & 7;
    for (int pass = 0; pass < 2; ++pass) {
      const int L = startL ^ pass;
      for (;;) {
        if (tid == 0) *s_item = atomicAdd(cq + L * 8 + x, 1);
        __syncthreads();
        const int j = *s_item;
        __syncthreads();
        if (j >= 258 + 260) break;
        int seq, head, qi, nt;
        if (j < 258) {
          const int s2 = j / 129; qi = j - s2 * 129; nt = 257;
          if (L == 0) { const int sg = x + 8 * s2; seq = sg >> 3; head = sg & 7; }
          else { seq = x >> 2; head = ((x >> 1) & 1) * 4 + (x & 1) * 2 + s2; }
        } else {
          const int jj = j - 258, s4 = jj / 65; qi = jj - s4 * 65; nt = 129;
          if (L == 0) { const int sg = x + 8 * s4; seq = 2 + (sg >> 3); head = sg & 7; }
          else { seq = 2 + (x >> 1); head = (x & 1) * 4 + s4; }
        }
        const int P = seq_base(seq);
        if (L == 0)
          attn_item<96>(QM + head * 96, 768, KN + head * 64, 512, KPE, VMT + (size_t)head * 64 * MPAD, ssq + 2 * (size_t)MPAD, P + qi * 128, P + 64, nt, smem, tid, dry);
        else
          attn_item<64>(QG + head * 64, 512, KG + (head >> 2) * 64, 128, nullptr, VGT + (size_t)(head >> 2) * 64 * MPAD, ssq + 3 * (size_t)MPAD, P + qi * 128, P + 64, nt, smem, tid, dry);
      }
    }
  }
}

#define XB_TMO      128
#define XB_XCNT(j)  (256  + 64 * (j))
#define XB_XSUB(j)  (1280 + 64 * (j))
#define XB_XGEN(j)  (2304 + 64 * (j))
#define XB_TOP      3328
#define XB_TOPGEN   3392
#define XCD_BAR_WORDS 3456
#define XB_SPIN_CAP (1u << 18)
#define LAS __attribute__((address_space(3)))

__device__ __forceinline__ unsigned xb_ld(unsigned* p)              { return __hip_atomic_load(p, __ATOMIC_RELAXED, __HIP_MEMORY_SCOPE_AGENT); }
__device__ __forceinline__ unsigned xb_add(unsigned* p, unsigned v) { return __hip_atomic_fetch_add(p, v, __ATOMIC_RELAXED, __HIP_MEMORY_SCOPE_AGENT); }
__device__ __forceinline__ unsigned xb_xcc_id() { return (unsigned)__builtin_amdgcn_s_getreg((3 << 11) | 20) & 0xFu; }
#define XB_SPIN(cond, bar) do { unsigned _sp = 0; while (cond) { __builtin_amdgcn_s_sleep(1); \
    if ((++_sp & 255u) == 0u) { if (xb_ld(&(bar)[XB_TMO])) break; if (_sp > XB_SPIN_CAP) { atomicAdd(&(bar)[XB_TMO], 1u); break; } } } } while (0)

struct XcdBarrier {
    unsigned* bar; unsigned x;
    volatile LAS unsigned* st;
};

__device__ __forceinline__ XcdBarrier xcd_barrier_post(unsigned* bar, volatile LAS unsigned* st) {
    XcdBarrier b; b.bar = bar; b.x = xb_xcc_id(); b.st = st;
    if (threadIdx.x == 0) (void)xb_add(&bar[XB_XCNT(b.x)], 1u);
    return b;
}
__device__ __forceinline__ void xcd_barrier_complete(unsigned* bar, unsigned x, unsigned& nloc, unsigned& nx) {
    const unsigned G = gridDim.x * gridDim.y * gridDim.z;
    unsigned sum, cnt, mine, sp = 0u;
    for (;;) {
        sum = 0u; cnt = 0u; mine = 0u;
#pragma unroll
        for (unsigned j = 0; j < 16; ++j) { const unsigned c = xb_ld(&bar[XB_XCNT(j)]); sum += c; cnt += (c > 0u) ? 1u : 0u; mine = (j == x) ? c : mine; }
        if (sum == G) break;
        __builtin_amdgcn_s_sleep(1);
        if ((++sp & 255u) == 0u) { if (xb_ld(&bar[XB_TMO])) break; if (sp > XB_SPIN_CAP) { atomicAdd(&bar[XB_TMO], 1u); break; } }
    }
    nloc = mine > 0u ? mine : 1u; nx = cnt > 0u ? cnt : 1u;
}

__device__ __forceinline__ void xcd_barrier(const XcdBarrier& b) {
    asm volatile("s_waitcnt vmcnt(0)" ::: "memory");
    __syncthreads();
    if (threadIdx.x == 0) {
        unsigned* bar = b.bar;
        __builtin_amdgcn_s_waitcnt(0);
        unsigned nloc = b.st[0], nx = b.st[1];
        if (nloc == 0u) { xcd_barrier_complete(bar, b.x, nloc, nx); b.st[0] = nloc; b.st[1] = nx; }
        const unsigned old = xb_add(&bar[XB_XSUB(b.x)], 1u);
        const unsigned gen = old / nloc;
        if (old + 1u == (gen + 1u) * nloc) {
            __builtin_amdgcn_fence(__ATOMIC_RELEASE, "agent");
            asm volatile("s_waitcnt vmcnt(0)" ::: "memory");
            const unsigned og = xb_add(&bar[XB_TOP], 1u);
            const unsigned tg = og / nx;
            if (og + 1u == (tg + 1u) * nx) xb_add(&bar[XB_TOPGEN], 1u);
            else XB_SPIN(xb_ld(&bar[XB_TOPGEN]) == tg, bar);
            __builtin_amdgcn_fence(__ATOMIC_ACQUIRE, "agent");
            xb_add(&bar[XB_XGEN(b.x)], 1u);
            asm volatile("s_waitcnt vmcnt(0)" ::: "memory");
        } else {
            XB_SPIN(xb_ld(&bar[XB_XGEN(b.x)]) == gen, bar);
            __builtin_amdgcn_fence(__ATOMIC_ACQUIRE, "agent");
            asm volatile("s_waitcnt vmcnt(0)" ::: "memory");
        }
    }
    __syncthreads();
}


__global__ void __launch_bounds__(256, 2) mega(Params pin) {
  __shared__ __attribute__((aligned(16))) char smem[2 * 2 * 128 * GP * 2];
  __shared__ int s_item;
  __shared__ uint4 xb_words;
  if (threadIdx.x == 0) xb_words = make_uint4(0u, 0u, 0u, 0u);
  __syncthreads();
  XcdBarrier xb; xb.bar = nullptr; xb.x = 0u; xb.st = (volatile LAS unsigned*)&xb_words;
  bool xb_posted = false;
  const int G = gridDim.x, b = blockIdx.x;
  const int vb = ((G & 7) == 0) ? ((b & 7) * (G >> 3) + (b >> 3)) : b;
  for (int st = pin.phase_lo; st < pin.phase_hi; ++st) {
    int ph; bool dry = false;
    if (st == 0) ph = 0;
    else if (st == 41) ph = 21;
    else {
      const int u = st - 1, lay = u / 20, v = u - lay * 20, sb = v >> 1;
      dry = (v & 1) == 0;
      if (dry && !((pin.probe >> sb) & 1)) continue;
      if (lay == 0 && sb == 0) continue;
      ph = 1 + lay * 10 + sb;
    }
    if (st > pin.phase_lo) {
      if (!xb_posted) {
        cg::this_grid().sync();
        xb = xcd_barrier_post((unsigned*)(pin.ws + OFF_BAR), (volatile LAS unsigned*)&xb_words);
        xb_posted = true;
      } else xcd_barrier(xb);
    }
    Params p = pin;
    asm volatile("" : "+s"(p.xp), "+s"(p.xs), "+s"(p.meta), "+s"(p.attn_g), "+s"(p.w_in), "+s"(p.qa_g), "+s"(p.w_qb), "+s"(p.kva_g), "+s"(p.w_kvb), "+s"(p.gq_g));
    asm volatile("" : "+s"(p.gk_g), "+s"(p.mo_g), "+s"(p.go_g), "+s"(p.w_out), "+s"(p.mlp_g), "+s"(p.w_up), "+s"(p.w_dn), "+s"(p.fin_g), "+s"(p.out), "+s"(p.ws));
    int tid = threadIdx.x;
    asm volatile("" : "+v"(tid));
    const int lane = tid & 63, wave = tid >> 6, r = lane & 31;
    float* ssq = (float*)(p.ws + OFF_SSQ);
    const float2* tab = (const float2*)(p.ws + OFF_TAB);
    if (ph == 0) { phase_prep(p, tid); phase_norm(p, p.attn_g, true, true, tid); continue; }
    if (ph == 21) { phase_final(p, tid); continue; }
    const int layer = (ph - 1) / 10, sub = (ph - 1) % 10;
    const u16* Wl = (const u16*)(p.ws + OFF_W) + (size_t)layer * W_LAYER;
    if (sub == 0) {
      phase_norm(p, p.attn_g + layer * 1024, layer == 0, true, tid);
    } else if (sub == 1) {
      EpiIn e; e.CQ = (u16*)(p.ws + OFF_CQ); e.CKV = (u16*)(p.ws + OFF_CKV); e.QG = (u16*)(p.ws + OFF_QG); e.KG = (u16*)(p.ws + OFF_KG);
      e.VGT = (u16*)(p.ws + OFF_VGT); e.KPE = (u16*)(p.ws + OFF_KPE); e.ssq_q = ssq; e.ssq_kv = ssq + MPAD;
      e.gq_g = p.gq_g + layer * 64; e.gk_g = p.gk_g + layer * 64; e.tab = tab;
      APLin ap{(const u16*)(p.ws + OFF_HN), 1024};
      for (int t = vb; t < NTM * 12; t += G) { const int mt = t / 12, nt = t - mt * 12; gemm_tile<false>(ap, Wl + WO_IN, 1024, 1024, mt * 128, nt * 128, e, smem, 1.f, 1.f, tid, dry); }
    } else if (sub == 2) {
      EpiQB e2; e2.QM = (u16*)(p.ws + OFF_HN); e2.ssq_q = ssq; e2.tab = tab;
      EpiKVB e3; e3.KN = (u16*)(p.ws + OFF_KN); e3.VMT = (u16*)(p.ws + OFF_VMT); e3.ssq_kv = ssq + MPAD;
      APLin a2{(const u16*)(p.ws + OFF_CQ), 384};
      APLin a3{(const u16*)(p.ws + OFF_CKV), 256};
      for (int t = vb; t < NTM * 14; t += G) {
        if (t < NTM * 6) { const int mt = t / 6, nt = t - mt * 6; gemm_tile<false>(a2, Wl + WO_QB, 384, 384, mt * 128, nt * 128, e2, smem, 1.f, 1.f, tid, dry); }
        else { const int u = t - NTM * 6; const int mt = u >> 3, nt = u & 7; gemm_tile<false>(a3, Wl + WO_KVB, 256, 256, mt * 128, nt * 128, e3, smem, 1.f, 1.f, tid, dry); }
      }
    } else if (sub == 3) {
      phase_attn(p, layer, smem, &s_item, tid, dry);
    } else if (sub == 4) {
      APMix ap{(const u16*)(p.ws + OFF_HN), (const u16*)(p.ws + OFF_QG)};
      for (int t = vb; t < NTM * 8; t += G) {
        const int mt = t >> 3, nt = t & 7;
        const int g0 = mt * 128 + (wave >> 1) * 64 + r;
        const float ra0 = rsqrtf(ldgf(ssq + 2 * (size_t)MPAD + g0) * (1.0f / 512.0f) + EPS), rg0 = rsqrtf(ldgf(ssq + 3 * (size_t)MPAD + g0) * (1.0f / 512.0f) + EPS);
        const float ra1 = rsqrtf(ldgf(ssq + 2 * (size_t)MPAD + g0 + 32) * (1.0f / 512.0f) + EPS), rg1 = rsqrtf(ldgf(ssq + 3 * (size_t)MPAD + g0 + 32) * (1.0f / 512.0f) + EPS);
        EpiRes e; res_bases(p, mt, layer == 0, e.sb, e.db, e.minrow); e.fin0 = rg0; e.fin1 = rg1;
        gemm_tile<true>(ap, Wl + WO_OUT, 1024, 1024, mt * 128, nt * 128, e, smem, ra0 / rg0, ra1 / rg1, tid, dry);
      }
    } else if (sub == 5) {
      phase_norm(p, p.mlp_g + layer * 1024, false, false, tid);
    } else if (sub == 6 || sub == 8) {
      const int mh = (sub - 6) >> 1;
      EpiUp e; e.U0 = (u16*)(p.ws + OFF_U) - (size_t)mh * 259 * 128 * 4096;
      APLin ap{(const u16*)(p.ws + OFF_HN), 1024};
      for (int t = vb; t < 259 * 32; t += G) {
        int ml, nt;
        if (t < 256 * 32) { const int blk = t >> 6, w = t & 63; ml = (blk >> 2) * 8 + (w >> 3); nt = (blk & 3) * 8 + (w & 7); }
        else { ml = t >> 5; nt = t & 31; }
        gemm_tile<false>(ap, Wl + WO_UP, 1024, 1024, (mh * 259 + ml) * 128, nt * 128, e, smem, 1.f, 1.f, tid, dry);
      }
    } else {
      const int mh = (sub - 7) >> 1;
      APLin ap{(const u16*)(p.ws + OFF_U) - (size_t)mh * 259 * 128 * 4096, 4096};
      for (int t = vb; t < 259 * 8; t += G) {
        const int mt = mh * 259 + (t >> 3), nt = t & 7;
        EpiRes e; res_bases(p, mt, false, e.sb, e.db, e.minrow); e.fin0 = 1.f; e.fin1 = 1.f;
        gemm_tile<false>(ap, Wl + WO_DN, 4096, 4096, mt * 128, nt * 128, e, smem, 1.f, 1.f, tid, dry);
      }
    }
  }
}

extern "C" void kernel_launch(void* const* d_in, const int* in_sizes, int n_in, void* d_out, int out_size, void* d_ws, size_t ws_size,
                              hipStream_t stream) {
  static int grid_blocks = 0;
  if (!grid_blocks) {
    int dev = 0, cus = 0, per_cu = 0;
    hipGetDevice(&dev);
    hipDeviceGetAttribute(&cus, hipDeviceAttributeMultiprocessorCount, dev);
    hipOccupancyMaxActiveBlocksPerMultiprocessor(&per_cu, mega, 256, 0);
    if (per_cu > 2) per_cu = 2;
    if (per_cu < 1) per_cu = 1;
    grid_blocks = cus * per_cu;
  }
  Params p{};
  p.xp = (const float*)d_in[0]; p.xs = (const float*)d_in[1]; p.meta = (const float*)d_in[2];
  p.attn_g = (const float*)d_in[3]; p.w_in = (const float*)d_in[4]; p.qa_g = (const float*)d_in[5]; p.w_qb = (const float*)d_in[6];
  p.kva_g = (const float*)d_in[7]; p.w_kvb = (const float*)d_in[8]; p.gq_g = (const float*)d_in[9]; p.gk_g = (const float*)d_in[10];
  p.mo_g = (const float*)d_in[11]; p.go_g = (const float*)d_in[12]; p.w_out = (const float*)d_in[13]; p.mlp_g = (const float*)d_in[14];
  p.w_up = (const float*)d_in[15]; p.w_dn = (const float*)d_in[16]; p.fin_g = (const float*)d_in[17];
  p.out = (float*)d_out; p.ws = (char*)d_ws;
#if MK_MULTI
  for (int ph = 0; ph < 42; ++ph) {
    p.phase_lo = ph; p.phase_hi = ph + 1; p.probe = PROBE_MASK;
    if (ph > 0 && ph < 41 && ((ph - 1) & 1) == 0 && !((PROBE_MASK >> (((ph - 1) % 20) >> 1)) & 1)) continue;
    hipLaunchKernelGGL(mega, dim3(grid_blocks), dim3(256), 0, stream, p);
  }
#else
  p.phase_lo = 0; p.phase_hi = 42; p.probe = PROBE_MASK;
  void* args[] = {&p};
  hipError_t e = hipLaunchCooperativeKernel((void*)mega, dim3(grid_blocks), dim3(256), args, 0, stream);
  if (e != hipSuccess) fprintf(stderr, "cooperative launch failed: %s (grid %d)\n", hipGetErrorString(e), grid_blocks);
#endif
}
```

```cpp
#include <hip/hip_runtime.h>
#include <hip/hip_cooperative_groups.h>
#include <stdint.h>
#include <cstdio>
namespace cg = cooperative_groups;

#ifndef PROBE_MASK
#define PROBE_MASK 0
#endif
#ifndef MK_MULTI
#define MK_MULTI 0
#endif

typedef unsigned short u16;
typedef short bf16x8 __attribute__((ext_vector_type(8)));
typedef float f32x16 __attribute__((ext_vector_type(16)));
typedef unsigned u32x4 __attribute__((ext_vector_type(4)));
typedef unsigned u32x2 __attribute__((ext_vector_type(2)));
typedef float f32x2v __attribute__((ext_vector_type(2)));
typedef __bf16 bf16x2v __attribute__((ext_vector_type(2)));
#define DI __device__ __forceinline__
#define GAS __attribute__((address_space(1)))
#define WAVE_LDS_FENCE() asm volatile("s_waitcnt lgkmcnt(0)" ::: "memory")
#define MFMA(a, b, c) __builtin_amdgcn_mfma_f32_32x32x16_bf16((a), (b), (c), 0, 0, 0)

constexpr int MPAD = 66304;
constexpr int NTM = 518;
constexpr float EPS = 1e-6f;
constexpr float LOG2E = 1.4426950408889634f;
constexpr float QSCALE_M = 0.10206207261596575f * LOG2E;
constexpr float QSCALE_G = 0.125f * LOG2E;

constexpr size_t SZ_WIN = 1536ull * 1024, SZ_WQB = 768ull * 384, SZ_WKVB = 1024ull * 256, SZ_WOUT = 1024ull * 1024,
                 SZ_WUP = 4096ull * 1024, SZ_WDN = 1024ull * 4096;
constexpr size_t WO_IN = 0, WO_QB = WO_IN + SZ_WIN, WO_KVB = WO_QB + SZ_WQB, WO_OUT = WO_KVB + SZ_WKVB, WO_UP = WO_OUT + SZ_WOUT,
                 WO_DN = WO_UP + SZ_WUP, W_LAYER = WO_DN + SZ_WDN;
constexpr size_t OFF_W = 0;
constexpr size_t OFF_TAB = OFF_W + 2 * W_LAYER * 2;
constexpr size_t OFF_XMETA = OFF_TAB + 16400ull * 16 * 8;
constexpr size_t OFF_SSQ = OFF_XMETA + 96ull * 1024 * 4;
constexpr size_t OFF_CNT = OFF_SSQ + 4ull * MPAD * 4;
constexpr size_t OFF_BAR = OFF_CNT + 1024;
constexpr size_t OFF_HN = OFF_BAR + 16384;
constexpr size_t OFF_CQ = OFF_HN + (size_t)MPAD * 1024 * 2;
constexpr size_t OFF_CKV = OFF_CQ + (size_t)MPAD * 384 * 2;
constexpr size_t OFF_KN = OFF_CKV + (size_t)MPAD * 256 * 2;
constexpr size_t OFF_KPE = OFF_KN + (size_t)MPAD * 512 * 2;
constexpr size_t OFF_VMT = OFF_KPE + (size_t)MPAD * 32 * 2;
constexpr size_t OFF_QG = OFF_VMT + (size_t)MPAD * 512 * 2;
constexpr size_t OFF_KG = OFF_QG + (size_t)MPAD * 512 * 2;
constexpr size_t OFF_VGT = OFF_KG + (size_t)MPAD * 128 * 2;
constexpr size_t OFF_END = OFF_VGT + (size_t)MPAD * 128 * 2;
constexpr size_t OFF_U = OFF_CQ;
static_assert(OFF_U + (size_t)259 * 128 * 4096 * 2 <= OFF_END, "U fits");
static_assert(OFF_END <= 536870912ull, "workspace");

struct Params {
  const float* xp; const float* xs; const float* meta;
  const float* attn_g; const float* w_in; const float* qa_g; const float* w_qb; const float* kva_g; const float* w_kvb;
  const float* gq_g; const float* gk_g; const float* mo_g; const float* go_g; const float* w_out; const float* mlp_g;
  const float* w_up; const float* w_dn; const float* fin_g;
  float* out; char* ws;
  int phase_lo, phase_hi, probe, pad_;
};


DI u32x4 ldg16(const void* p) { return *(const GAS u32x4*)p; }
DI void stg16(void* p, u32x4 v) { *(GAS u32x4*)p = v; }
DI void stg8(void* p, u32x2 v) { *(GAS u32x2*)p = v; }
typedef float f32x4v __attribute__((ext_vector_type(4)));
DI float4 ldgf4(const void* p) { const f32x4v v = *(const GAS f32x4v*)p; return make_float4(v.x, v.y, v.z, v.w); }
DI float ldgf(const float* p) { return *(const GAS float*)p; }
DI float2 ldgf2(const float2* p) { typedef float f32x2g __attribute__((ext_vector_type(2))); const f32x2g v = *(const GAS f32x2g*)p; return make_float2(v.x, v.y); }
DI void stgh(u16* p, u16 v) { *(GAS u16*)p = v; }
DI void stgf4(void* p, float4 v) { f32x4v w = {v.x, v.y, v.z, v.w}; *(GAS f32x4v*)p = w; }
DI unsigned pack2(float a, float b) { f32x2v f = {a, b}; bf16x2v v = __builtin_convertvector(f, bf16x2v); return __builtin_bit_cast(unsigned, v); }
DI u16 f2bf(float a) { return (u16)(pack2(a, 0.f) & 0xffffu); }
DI void store4(u16* dst, float a, float b, float c, float d) { u32x2 v = {pack2(a, b), pack2(c, d)}; *(u32x2*)dst = v; }
DI void store4g(u16* dst, float a, float b, float c, float d) { u32x2 v = {pack2(a, b), pack2(c, d)}; stg8(dst, v); }
DI int crow(int i, int h) { return (i & 3) + 8 * (i >> 2) + 4 * h; }
DI int swap23(int r) { return (r & 0x13) | ((r & 4) << 1) | ((r & 8) >> 1); }
DI float xhalf(float v) { return __shfl_xor(v, 32); }

DI void decode_tile(int T, int& seq, int& i) {
  if (T < 258) { seq = (T >= 129) ? 1 : 0; i = T - seq * 129; }
  else { int u = T - 258; int q = u / 65; seq = 2 + q; i = u - q * 65; }
}
DI int seq_base(int seq) { return seq < 2 ? seq * 16512 : 33024 + (seq - 2) * 8320; }

DI const float* xrow_src(const Params& p, int g, bool from_input) {
  int T = g >> 7, r = g & 127, seq, i; decode_tile(T, seq, i);
  if (i == 0) {
    if (r < 112) return nullptr;
    return from_input ? p.meta + (size_t)(r - 112) * 1024 : (const float*)(p.ws + OFF_XMETA) + (size_t)(seq * 16 + r - 112) * 1024;
  }
  int j = (i - 1) * 128 + r;
  if (seq < 2) { size_t row = (size_t)seq * 16384 + j; return from_input ? p.xp + row * 1024 : p.out + row * 1024; }
  size_t row = (size_t)(seq - 2) * 8192 + j;
  return from_input ? p.xs + row * 1024 : p.out + (32768 + row) * 1024;
}
DI float* xrow_dst(const Params& p, int g) {
  int T = g >> 7, r = g & 127, seq, i; decode_tile(T, seq, i);
  if (i == 0) {
    if (r < 112) return nullptr;
    return (float*)(p.ws + OFF_XMETA) + (size_t)(seq * 16 + r - 112) * 1024;
  }
  int j = (i - 1) * 128 + r;
  if (seq < 2) { size_t row = (size_t)seq * 16384 + j; return p.out + row * 1024; }
  size_t row = (size_t)(seq - 2) * 8192 + j;
  return p.out + (32768 + row) * 1024;
}

DI int mapcol(int kind, int n) {
  if (kind == 1) { if (n < 640) return n; if (n < 1408) return n + 32; if (n < 1440) return 640 + (n - 1408); return -1; }
  if (kind == 2) { if (n < 512) return (n >> 6) * 96 + (n & 63); int m = n - 512; return (m >> 5) * 96 + 64 + (m & 31); }
  if (kind == 3) { if (n < 512) return (n >> 6) * 128 + (n & 63); int m = n - 512; return (m >> 6) * 128 + 64 + (m & 63); }
  return n;
}
DI void prep_weight(const float* __restrict__ src, int Nsrc, u16* __restrict__ dst, int Nout, int K, const float* gA, const float* gB,
                    int ksplit, int kind, int gtid, int gthreads) {
  const int total = Nout * (K >> 3);
  for (int u = gtid; u < total; u += gthreads) {
    const int n = u % Nout, kc = u / Nout;
    const int col = mapcol(kind, n);
    const int k = kc * 8;
    float v[8];
#pragma unroll
    for (int j = 0; j < 8; ++j) {
      float x = 0.f;
      if (col >= 0) {
        x = src[(size_t)(k + j) * Nsrc + col];
        if (gA) x *= (k + j < ksplit) ? gA[k + j] : gB[k + j - ksplit];
      }
      v[j] = x;
    }
    u32x4 o = {pack2(v[0], v[1]), pack2(v[2], v[3]), pack2(v[4], v[5]), pack2(v[6], v[7])};
    *(u32x4*)(dst + (size_t)n * K + k) = o;
  }
}

DI void phase_prep(const Params& p, int tid) {
  const int gtid = blockIdx.x * 256 + tid, gthreads = gridDim.x * 256;
  u16* W = (u16*)(p.ws + OFF_W);
  for (int l = 0; l < 2; ++l) {
    u16* Wl = W + (size_t)l * W_LAYER;
    prep_weight(p.w_in + (size_t)l * 1024 * 1440, 1440, Wl + WO_IN, 1536, 1024, nullptr, nullptr, 0, 1, gtid, gthreads);
    prep_weight(p.w_qb + (size_t)l * 384 * 768, 768, Wl + WO_QB, 768, 384, p.qa_g + l * 384, p.qa_g + l * 384, 384, 2, gtid, gthreads);
    prep_weight(p.w_kvb + (size_t)l * 256 * 1024, 1024, Wl + WO_KVB, 1024, 256, p.kva_g + l * 256, p.kva_g + l * 256, 256, 3, gtid, gthreads);
    prep_weight(p.w_out + (size_t)l * 1024 * 1024, 1024, Wl + WO_OUT, 1024, 1024, p.mo_g + l * 512, p.go_g + l * 512, 512, 0, gtid, gthreads);
    prep_weight(p.w_up + (size_t)l * 1024 * 4096, 4096, Wl + WO_UP, 4096, 1024, nullptr, nullptr, 0, 0, gtid, gthreads);
    prep_weight(p.w_dn + (size_t)l * 4096 * 1024, 1024, Wl + WO_DN, 1024, 4096, nullptr, nullptr, 0, 0, gtid, gthreads);
  }
  float2* tab = (float2*)(p.ws + OFF_TAB);
  for (int u = gtid; u < 16400 * 16; u += gthreads) {
    const int pos = u >> 4, f = u & 15;
    const float invf = 1.0f / powf(10000.0f, (float)(2 * f) / 32.0f);
    const float ang = (float)pos * invf;
    const double rev = (double)ang * 0.15915494309189535;
    const double fr = rev - rint(rev);
    const float x = (float)(2.0 * fr);
    tab[u] = make_float2(cospif(x), sinpif(x));
  }
  float* xm = (float*)(p.ws + OFF_XMETA);
  for (int u = gtid; u < 96 * 1024; u += gthreads) xm[u] = p.meta[u & 16383];
  int* cnt = (int*)(p.ws + OFF_CNT);
  if (gtid < 128) cnt[gtid] = 0;
  unsigned* bar = (unsigned*)(p.ws + OFF_BAR);
  if (gtid < 4096) bar[gtid] = 0u;
}

DI void phase_norm(const Params& p, const float* __restrict__ gain, bool from_input, bool zero_ssq, int tid) {
  const int lane = tid & 63;
  const int gw = blockIdx.x * 4 + (tid >> 6), nw = gridDim.x * 4;
  u16* HN = (u16*)(p.ws + OFF_HN);
  float* ssq = (float*)(p.ws + OFF_SSQ);
  for (int g = gw; g < MPAD; g += nw) {
    const float* xr = xrow_src(p, g, from_input);
    u16* hr = HN + (size_t)g * 1024;
    if (!xr) {
      u32x4 z = {0u, 0u, 0u, 0u};
      *(u32x4*)(hr + lane * 16) = z;
      *(u32x4*)(hr + lane * 16 + 8) = z;
    } else {
      float4 v[4];
#pragma unroll
      for (int q = 0; q < 4; ++q) v[q] = ldgf4((const float4*)xr + lane + 64 * q);
      float ss = 0.f;
#pragma unroll
      for (int q = 0; q < 4; ++q) ss += v[q].x * v[q].x + v[q].y * v[q].y + v[q].z * v[q].z + v[q].w * v[q].w;
#pragma unroll
      for (int o = 32; o >= 1; o >>= 1) ss += __shfl_xor(ss, o);
      const float rstd = rsqrtf(ss * (1.0f / 1024.0f) + EPS);
#pragma unroll
      for (int q = 0; q < 4; ++q) {
        const float4 gg = ldgf4((const float4*)gain + lane + 64 * q);
        store4g(hr + 4 * (lane + 64 * q), v[q].x * rstd * gg.x, v[q].y * rstd * gg.y, v[q].z * rstd * gg.z, v[q].w * rstd * gg.w);
      }
    }
    if (zero_ssq && lane < 4) ssq[(size_t)lane * MPAD + g] = 0.f;
  }
}

DI void phase_final(const Params& p, int tid) {
  const int lane = tid & 63;
  const int gw = blockIdx.x * 4 + (tid >> 6), nw = gridDim.x * 4;
  for (int g = gw; g < MPAD; g += nw) {
    if (((g >> 7) == 0) || ((g >> 7) == 129) || ((g >> 7) >= 258 && ((g >> 7) - 258) % 65 == 0)) continue;
    float* xr = xrow_dst(p, g);
    float4 v[4];
#pragma unroll
    for (int q = 0; q < 4; ++q) v[q] = ldgf4((const float4*)xr + lane + 64 * q);
    float ss = 0.f;
#pragma unroll
    for (int q = 0; q < 4; ++q) ss += v[q].x * v[q].x + v[q].y * v[q].y + v[q].z * v[q].z + v[q].w * v[q].w;
#pragma unroll
    for (int o = 32; o >= 1; o >>= 1) ss += __shfl_xor(ss, o);
    const float rstd = rsqrtf(ss * (1.0f / 1024.0f) + EPS);
#pragma unroll
    for (int q = 0; q < 4; ++q) {
      const float4 gg = ldgf4((const float4*)p.fin_g + lane + 64 * q);
      float4 o = make_float4(v[q].x * rstd * gg.x, v[q].y * rstd * gg.y, v[q].z * rstd * gg.z, v[q].w * rstd * gg.w);
      stgf4((float4*)xr + lane + 64 * q, o);
    }
  }
}

constexpr int GP = 72;
struct APLin { const u16* A; int lda; DI const u16* ptr(int row, int k0) const { return A + (size_t)row * lda + k0; } };
struct APMix { const u16* QM; const u16* QG;
  DI const u16* ptr(int row, int k0) const { return k0 < 512 ? QM + (size_t)row * 768 + (k0 >> 6) * 96 : QG + (size_t)row * 512 + (k0 - 512); } };

template <bool MIDK, class AP, class EPI>
DI void gemm_tile(const AP& ap, const u16* __restrict__ W, int ldw, int K, int m0, int n0, const EPI& epi, char* smem, float r0, float r1, int tid, bool dry) {
  constexpr int SBUF = 2 * 128 * GP;
  u16* sA = (u16*)smem;
  u16* sB = sA + 128 * GP;
  const int lane = tid & 63, wave = tid >> 6, r = lane & 31, h = lane >> 5, wm = wave >> 1, wn = wave & 1;
  const int lrow = tid >> 3, lkc = (tid & 7) * 8;
  u32x4 ra0[4], rb0[4], ra1[4], rb1[4];
  f32x16 acc[2][2];
#pragma unroll
  for (int a = 0; a < 2; ++a)
#pragma unroll
    for (int b = 0; b < 2; ++b)
#pragma unroll
      for (int i = 0; i < 16; ++i) acc[a][b][i] = 0.f;
  const int nk = K >> 6;
#define GLOADQ(RA, RB, KT, q) do { const int k0_ = (KT) << 6; \
    RA[q] = ldg16(ap.ptr(m0 + lrow + 32 * (q), k0_) + lkc); RB[q] = ldg16(W + (size_t)(n0 + lrow + 32 * (q)) * ldw + k0_ + lkc); } while (0)
#define GLOAD(RA, RB, KT) do { GLOADQ(RA, RB, KT, 0); GLOADQ(RA, RB, KT, 1); GLOADQ(RA, RB, KT, 2); GLOADQ(RA, RB, KT, 3); } while (0)
#define SSTOREQ(RA, RB, ST, q) do { \
    *(u32x4*)(sA + (ST) * SBUF + (lrow + 32 * (q)) * GP + lkc) = RA[q]; *(u32x4*)(sB + (ST) * SBUF + (lrow + 32 * (q)) * GP + lkc) = RB[q]; } while (0)
#define SSTORE(RA, RB, ST) do { SSTOREQ(RA, RB, ST, 0); SSTOREQ(RA, RB, ST, 1); SSTOREQ(RA, RB, ST, 2); SSTOREQ(RA, RB, ST, 3); } while (0)
#define FLOAD(F, ST, ks) do { _Pragma("unroll") for (int a = 0; a < 2; ++a) { \
    F[a] = *(const bf16x8*)(sB + (ST) * SBUF + (wn * 64 + a * 32 + r) * GP + (ks) * 16 + h * 8); \
    F[2 + a] = *(const bf16x8*)(sA + (ST) * SBUF + (wm * 64 + a * 32 + r) * GP + (ks) * 16 + h * 8); } } while (0)
#define FMMA(F) do { _Pragma("unroll") for (int a = 0; a < 2; ++a) _Pragma("unroll") for (int b = 0; b < 2; ++b) acc[a][b] = MFMA(F[a], F[2 + b], acc[a][b]); } while (0)
  bf16x8 f0[4], f1[4];
  GLOAD(ra0, rb0, 0);
  GLOAD(ra1, rb1, 1);
  __syncthreads();
  SSTORE(ra0, rb0, 0);
  if (nk > 2) GLOAD(ra0, rb0, 2);
  __syncthreads();
  for (int kt = 0; kt < nk; kt += 2) {
    const bool l3 = kt + 3 < nk, s2 = kt + 2 < nk, l4 = kt + 4 < nk;
    FLOAD(f0, 0, 0); FLOAD(f1, 0, 1);
    FMMA(f0); SSTOREQ(ra1, rb1, 1, 0); if (l3) GLOADQ(ra1, rb1, kt + 3, 0);
    FLOAD(f0, 0, 2);
    FMMA(f1); SSTOREQ(ra1, rb1, 1, 1); if (l3) GLOADQ(ra1, rb1, kt + 3, 1);
    FLOAD(f1, 0, 3);
    FMMA(f0); SSTOREQ(ra1, rb1, 1, 2); if (l3) GLOADQ(ra1, rb1, kt + 3, 2);
    FMMA(f1); SSTOREQ(ra1, rb1, 1, 3); if (l3) GLOADQ(ra1, rb1, kt + 3, 3);
    __syncthreads();
    FLOAD(f0, 1, 0); FLOAD(f1, 1, 1);
    FMMA(f0); if (s2) SSTOREQ(ra0, rb0, 0, 0); if (l4) GLOADQ(ra0, rb0, kt + 4, 0);
    FLOAD(f0, 1, 2);
    FMMA(f1); if (s2) SSTOREQ(ra0, rb0, 0, 1); if (l4) GLOADQ(ra0, rb0, kt + 4, 1);
    FLOAD(f1, 1, 3);
    FMMA(f0); if (s2) SSTOREQ(ra0, rb0, 0, 2); if (l4) GLOADQ(ra0, rb0, kt + 4, 2);
    FMMA(f1); if (s2) SSTOREQ(ra0, rb0, 0, 3); if (l4) GLOADQ(ra0, rb0, kt + 4, 3);
    if (MIDK && kt == 6) {
#pragma unroll
      for (int a = 0; a < 2; ++a)
#pragma unroll
        for (int i = 0; i < 16; ++i) { acc[a][0][i] *= r0; acc[a][1][i] *= r1; }
    }
    __syncthreads();
  }
#undef GLOADQ
#undef SSTOREQ
#undef FLOAD
#undef FMMA
#undef GLOAD
#undef SSTORE
  if (!dry) epi(acc, n0 + wn * 64, m0 + wm * 64, lane, (u16*)smem + wave * 64 * GP);
}

struct ColId { DI int operator()(int ch) const { return ch * 8; } };
struct ColRope { DI int operator()(int ch) const { return (ch >> 2) * 96 + (ch & 3) * 8; } };

template <class COLF>
DI void stage_store(f32x16 (&acc)[2][2], u16* wl, int lane, u16* dst0, size_t pitch, const COLF& colf) {
  const int r = lane & 31, h = lane >> 5;
#pragma unroll
  for (int rb = 0; rb < 2; ++rb)
#pragma unroll
    for (int lb = 0; lb < 2; ++lb)
#pragma unroll
      for (int g4 = 0; g4 < 4; ++g4)
        store4(wl + (lb * 32 + r) * GP + rb * 32 + 8 * g4 + 4 * h, acc[rb][lb][4 * g4], acc[rb][lb][4 * g4 + 1], acc[rb][lb][4 * g4 + 2], acc[rb][lb][4 * g4 + 3]);
  WAVE_LDS_FENCE();
#pragma unroll
  for (int it = 0; it < 8; ++it) {
    const int row = it * 8 + (lane >> 3), ch = lane & 7;
    const u32x4 v = *(const u32x4*)(wl + row * GP + ch * 8);
    stg16(dst0 + (size_t)row * pitch + colf(ch), v);
  }
  WAVE_LDS_FENCE();
}

DI void rope16(float (&v)[16], const float2* __restrict__ tabrow, int h) {
#pragma unroll
  for (int i = 0; i < 8; ++i) {
    const int f = (i & 3) + 8 * (i >> 2) + 4 * h;
    const float2 cs = ldgf2(tabrow + f);
    const float x1 = v[i], x2 = v[i + 8];
    v[i] = x1 * cs.x - x2 * cs.y;
    v[i + 8] = x2 * cs.x + x1 * cs.y;
  }
}

struct EpiIn {
  u16 *CQ, *CKV, *QG, *KG, *VGT, *KPE; float *ssq_q, *ssq_kv; const float *gq_g, *gk_g; const float2* tab;
  DI void operator()(f32x16 (&acc)[2][2], int nb, int mb, int lane, u16* wl) const {
    const int r = lane & 31, h = lane >> 5;
    int seq, it; decode_tile(mb >> 7, seq, it);
#pragma unroll
    for (int ti = 0; ti < 2; ++ti) {
      const int g = mb + ti * 32 + r, rr = g & 127;
      if (nb < 640) {
        float ss = 0.f;
#pragma unroll
        for (int fi = 0; fi < 2; ++fi)
#pragma unroll
          for (int i = 0; i < 16; ++i) ss += acc[fi][ti][i] * acc[fi][ti][i];
        ss += xhalf(ss);
        if (h == 0) unsafeAtomicAdd((nb < 384 ? ssq_q : ssq_kv) + g, ss);
      } else if (nb < 1280) {
        const bool isq = nb < 1152;
        const float* gg = isq ? gq_g : gk_g;
        float ss = 0.f;
#pragma unroll
        for (int fi = 0; fi < 2; ++fi)
#pragma unroll
          for (int i = 0; i < 16; ++i) ss += acc[fi][ti][i] * acc[fi][ti][i];
        ss += xhalf(ss);
        const float rstd = rsqrtf(ss * (1.0f / 64.0f) + EPS);
        const float osc = isq ? QSCALE_G : 1.0f;
        int prow = 0, pcol = 0;
        if (it > 0) { const int j = (it - 1) * 128 + rr; prow = j >> 6; pcol = j & 63; }
        u16* dst = isq ? QG + (size_t)g * 512 + (nb - 640) : KG + (size_t)g * 128 + (nb - 1152);
#pragma unroll
        for (int fi = 0; fi < 2; ++fi) {
          const int pos = fi == 0 ? prow : pcol;
          float v[16];
#pragma unroll
          for (int i = 0; i < 16; ++i) v[i] = acc[fi][ti][i] * rstd * ldgf(gg + fi * 32 + crow(i, h));
          rope16(v, tab + pos * 16, h);
#pragma unroll
          for (int g4 = 0; g4 < 4; ++g4)
            store4g(dst + fi * 32 + 8 * g4 + 4 * h, v[4 * g4] * osc, v[4 * g4 + 1] * osc, v[4 * g4 + 2] * osc, v[4 * g4 + 3] * osc);
        }
      } else if (nb < 1408) {
#pragma unroll
        for (int fi = 0; fi < 2; ++fi)
#pragma unroll
          for (int i = 0; i < 16; ++i) stgh(VGT + (size_t)(nb - 1280 + fi * 32 + crow(i, h)) * MPAD + g, f2bf(acc[fi][ti][i]));
      } else if (nb == 1408) {
        int pos = 128 * it + rr - 112; pos = pos < 0 ? 0 : pos;
        float v[16];
#pragma unroll
        for (int i = 0; i < 16; ++i) v[i] = acc[0][ti][i];
        rope16(v, tab + pos * 16, h);
#pragma unroll
        for (int g4 = 0; g4 < 4; ++g4) store4g(KPE + (size_t)g * 32 + 8 * g4 + 4 * h, v[4 * g4], v[4 * g4 + 1], v[4 * g4 + 2], v[4 * g4 + 3]);
      }
    }
    if (nb < 384) stage_store(acc, wl, lane, CQ + (size_t)mb * 384 + nb, 384, ColId());
    else if (nb < 640) stage_store(acc, wl, lane, CKV + (size_t)mb * 256 + (nb - 384), 256, ColId());
  }
};

struct EpiQB {
  u16* QM; const float* ssq_q; const float2* tab;
  DI void operator()(f32x16 (&acc)[2][2], int nb, int mb, int lane, u16* wl) const {
    const int r = lane & 31, h = lane >> 5;
    int seq, it; decode_tile(mb >> 7, seq, it);
#pragma unroll
    for (int ti = 0; ti < 2; ++ti) {
      const int g = mb + ti * 32 + r, rr = g & 127;
      const float sc = rsqrtf(ldgf(ssq_q + g) * (1.0f / 384.0f) + EPS) * QSCALE_M;
      if (nb < 512) {
#pragma unroll
        for (int fi = 0; fi < 2; ++fi)
#pragma unroll
          for (int i = 0; i < 16; ++i) acc[fi][ti][i] *= sc;
      } else {
        int pos = 128 * it + rr - 112; pos = pos < 0 ? 0 : pos;
#pragma unroll
        for (int fi = 0; fi < 2; ++fi) {
          float v[16];
#pragma unroll
          for (int i = 0; i < 16; ++i) v[i] = acc[fi][ti][i] * sc;
          rope16(v, tab + pos * 16, h);
#pragma unroll
          for (int i = 0; i < 16; ++i) acc[fi][ti][i] = v[i];
        }
      }
    }
    if (nb < 512) stage_store(acc, wl, lane, QM + (size_t)mb * 768 + (nb >> 6) * 96, 768, ColId());
    else stage_store(acc, wl, lane, QM + (size_t)mb * 768 + ((nb - 512) >> 5) * 96 + 64, 768, ColRope());
  }
};

struct EpiKVB {
  u16 *KN, *VMT; const float* ssq_kv;
  DI void operator()(f32x16 (&acc)[2][2], int nb, int mb, int lane, u16* wl) const {
    const int r = lane & 31, h = lane >> 5;
#pragma unroll
    for (int ti = 0; ti < 2; ++ti) {
      const int g = mb + ti * 32 + r;
      const float sc = rsqrtf(ldgf(ssq_kv + g) * (1.0f / 256.0f) + EPS);
      if (nb < 512) {
#pragma unroll
        for (int fi = 0; fi < 2; ++fi)
#pragma unroll
          for (int i = 0; i < 16; ++i) acc[fi][ti][i] *= sc;
      } else {
#pragma unroll
        for (int fi = 0; fi < 2; ++fi)
#pragma unroll
          for (int i = 0; i < 16; ++i) stgh(VMT + (size_t)(nb - 512 + fi * 32 + crow(i, h)) * MPAD + g, f2bf(acc[fi][ti][i] * sc));
      }
    }
    if (nb < 512) stage_store(acc, wl, lane, KN + (size_t)mb * 512 + nb, 512, ColId());
  }
};

DI void res_bases(const Params& p, int mt, bool from_input, const float*& sb, float*& db, int& minrow) {
  int seq, it; decode_tile(mt, seq, it);
  float* xm = (float*)(p.ws + OFF_XMETA);
  if (it == 0) {
    minrow = 112;
    db = xm + ((ptrdiff_t)seq * 16 - 112) * 1024;
    sb = from_input ? p.meta - 112 * 1024 : db;
  } else {
    minrow = 0;
    const size_t row = seq < 2 ? (size_t)seq * 16384 + (size_t)(it - 1) * 128 : 32768 + (size_t)(seq - 2) * 8192 + (size_t)(it - 1) * 128;
    db = p.out + row * 1024;
    sb = from_input ? (seq < 2 ? p.xp + row * 1024 : p.xs + (row - 32768) * 1024) : db;
  }
}

struct EpiRes {
  const float* sb; float* db; int minrow; float fin0, fin1;
  DI void operator()(f32x16 (&acc)[2][2], int nb, int mb, int lane, u16* wl) const {
    const int r = lane & 31, h = lane >> 5, mbl = mb & 127;
    float* wf = (float*)wl;
#pragma unroll
    for (int fi = 0; fi < 2; ++fi) {
#pragma unroll
      for (int ti = 0; ti < 2; ++ti) {
        const float sc = ti == 0 ? fin0 : fin1;
#pragma unroll
        for (int g4 = 0; g4 < 4; ++g4) {
          float4 o = make_float4(acc[fi][ti][4 * g4] * sc, acc[fi][ti][4 * g4 + 1] * sc, acc[fi][ti][4 * g4 + 2] * sc, acc[fi][ti][4 * g4 + 3] * sc);
          *(float4*)(wf + (ti * 32 + r) * 36 + 8 * g4 + 4 * h) = o;
        }
      }
      WAVE_LDS_FENCE();
#pragma unroll
      for (int it = 0; it < 8; ++it) {
        const int row = it * 8 + (lane >> 3), ch = lane & 7;
        const float4 a = *(const float4*)(wf + row * 36 + ch * 4);
        const int trow = mbl + row;
        if (trow >= minrow) {
          const size_t off = (size_t)trow * 1024 + nb + fi * 32 + ch * 4;
          float4 x = ldgf4(sb + off);
          x.x += a.x; x.y += a.y; x.z += a.z; x.w += a.w;
          stgf4(db + off, x);
        }
      }
      WAVE_LDS_FENCE();
    }
  }
};

struct EpiUp {
  u16* U0;
  DI void operator()(f32x16 (&acc)[2][2], int nb, int mb, int lane, u16* wl) const {
#pragma unroll
    for (int ti = 0; ti < 2; ++ti)
#pragma unroll
      for (int fi = 0; fi < 2; ++fi)
#pragma unroll
        for (int i = 0; i < 16; ++i) { const float a = fmaxf(acc[fi][ti][i], 0.f); acc[fi][ti][i] = a * a; }
    stage_store(acc, wl, lane, U0 + (size_t)mb * 4096 + nb, 4096, ColId());
  }
};

constexpr float ATT_THR = 12.0f;

template <int DQK>
struct AttnCtx {
  static constexpr int KP = DQK + 8, NKS = DQK / 16, KCH = DQK / 8, NKL = 64 * KCH / 256, KBUF = 64 * KP, VBUF = 64 * GP;
  const u16 *Kb, *KPEb, *Vt; int kpitch, rowk0, nt, tid, r, h, sr;
  u16 *sK, *sV;
  bf16x8 qf[NKS], kone, qm;
  f32x16 o[2];
  float mref, l;
  u32x4 rk[NKL], rv[2];

  int koff[NKL], voff[2];
  DI void init_offs() {
#pragma unroll
    for (int q = 0; q < NKL; ++q) {
      const int c = tid + 256 * q, row = c / KCH, cc = c % KCH;
      koff[q] = (DQK == 96 && cc >= 8) ? row * 32 + (cc - 8) * 8 : row * kpitch + cc * 8;
    }
#pragma unroll
    for (int q = 0; q < 2; ++q) { const int c = tid + 256 * q, dv = c >> 3, kc = c & 7; voff[q] = dv * MPAD + kc * 8; }
  }
  DI void gload_k(int t) {
    const int row0 = rowk0 + t * 64;
    const u16* kt = Kb + (size_t)row0 * kpitch;
    const u16* pt = KPEb + (size_t)row0 * 32;
#pragma unroll
    for (int q = 0; q < NKL; ++q) {
      const int c = tid + 256 * q, cc = c % KCH;
      rk[q] = ldg16(((DQK == 96 && cc >= 8) ? pt : kt) + koff[q]);
    }
  }
  DI void gload_v(int t) {
    const u16* vt = Vt + (rowk0 + t * 64);
#pragma unroll
    for (int q = 0; q < 2; ++q) rv[q] = ldg16(vt + voff[q]);
  }
  DI void sstore_k(int buf) {
#pragma unroll
    for (int q = 0; q < NKL; ++q) {
      const int c = tid + 256 * q, row = c / KCH, cc = c % KCH;
      *(u32x4*)(sK + buf * KBUF + row * KP + cc * 8) = rk[q];
    }
  }
  DI void sstore_v(int buf) {
#pragma unroll
    for (int q = 0; q < 2; ++q) {
      const int c = tid + 256 * q, dv = c >> 3, kc = c & 7;
      *(u32x4*)(sV + buf * VBUF + dv * GP + kc * 8) = rv[q];
    }
  }
  DI void qk(int buf, f32x16 (&s)[2]) {
    const u16* kb = sK + buf * KBUF + sr * KP + h * 8;
#pragma unroll
    for (int kb2 = 0; kb2 < 2; ++kb2)
#pragma unroll
      for (int i = 0; i < 16; ++i) s[kb2][i] = 0.f;
#pragma unroll
    for (int ks = 0; ks < NKS; ++ks)
#pragma unroll
      for (int kb2 = 0; kb2 < 2; ++kb2) {
        const bf16x8 a = *(const bf16x8*)(kb + kb2 * 32 * KP + ks * 16);
        s[kb2] = MFMA(a, qf[ks], s[kb2]);
      }
    s[0] = MFMA(kone, qm, s[0]);
    s[1] = MFMA(kone, qm, s[1]);
  }
  template <int PAR>
  DI void step(int t, f32x16 (&cur)[2], f32x16 (&nxt)[2]) {
    if (t + 1 < nt) sstore_k(PAR ^ 1);
    if (t > 0) sstore_v(PAR);
    __syncthreads();
    if (t + 1 < nt) qk(PAR ^ 1, nxt);
    float mx = fmaxf(cur[0][0], cur[1][0]);
#pragma unroll
    for (int i = 1; i < 16; ++i) mx = fmaxf(fmaxf(cur[0][i], cur[1][i]), mx);
    if (__builtin_amdgcn_ballot_w64(mx > ATT_THR) != 0ull) {
      asm volatile("" ::: "memory");
      mx = fmaxf(mx, xhalf(mx));
      const float want = mref + fmaxf(mx, 0.f);
      const float mn = __uint_as_float(pack2(want, 0.f) << 16);
      const float d = mn - mref;
      const float alpha = __builtin_amdgcn_exp2f(-d);
      mref = mn;
      l *= alpha;
#pragma unroll
      for (int a = 0; a < 2; ++a)
#pragma unroll
        for (int i = 0; i < 16; ++i) { o[a][i] *= alpha; cur[a][i] -= d; nxt[a][i] -= d; }
      u32x4 q4 = {h == 0 ? (pack2(-mn, 0.f) & 0xffffu) : 0u, 0u, 0u, 0u};
      qm = __builtin_bit_cast(bf16x8, q4);
    }
    float psum = 0.f;
#pragma unroll
    for (int kb2 = 0; kb2 < 2; ++kb2)
#pragma unroll
      for (int i = 0; i < 16; ++i) { const float pv = __builtin_amdgcn_exp2f(cur[kb2][i]); cur[kb2][i] = pv; psum += pv; }
    l += psum;
    if (t + 2 < nt) gload_k(t + 2);
    if (t + 1 < nt) gload_v(t + 1);
    const u16* vb = sV + PAR * VBUF + r * GP + h * 8;
#pragma unroll
    for (int kb2 = 0; kb2 < 2; ++kb2)
#pragma unroll
      for (int s2 = 0; s2 < 2; ++s2) {
        u32x4 pk = {pack2(cur[kb2][8 * s2], cur[kb2][8 * s2 + 1]), pack2(cur[kb2][8 * s2 + 2], cur[kb2][8 * s2 + 3]),
                    pack2(cur[kb2][8 * s2 + 4], cur[kb2][8 * s2 + 5]), pack2(cur[kb2][8 * s2 + 6], cur[kb2][8 * s2 + 7])};
        const bf16x8 pf = __builtin_bit_cast(bf16x8, pk);
#pragma unroll
        for (int db = 0; db < 2; ++db) {
          const bf16x8 a = *(const bf16x8*)(vb + db * 32 * GP + kb2 * 32 + s2 * 16);
          o[db] = MFMA(a, pf, o[db]);
        }
      }
  }
};

template <int DQK>
DI void attn_item(const u16* __restrict__ Qb, int qpitch, const u16* __restrict__ Kb, int kpitch, const u16* __restrict__ KPEb,
                  const u16* __restrict__ Vt, float* __restrict__ ssq, int rowq0, int rowk0, int nt, char* smem, int tid, bool dry) {
  typedef AttnCtx<DQK> C;
  C c;
  const int lane = tid & 63, wave = tid >> 6, r = lane & 31, h = lane >> 5;
  c.Kb = Kb; c.KPEb = KPEb; c.Vt = Vt; c.kpitch = kpitch; c.rowk0 = rowk0; c.nt = nt; c.tid = tid; c.r = r; c.h = h; c.sr = swap23(r);
  c.sK = (u16*)smem; c.sV = c.sK + 2 * C::KBUF;
  c.init_offs();
  const int myrow = rowq0 + wave * 32 + r;
  {
    const u16* qrow = Qb + (size_t)myrow * qpitch + h * 8;
#pragma unroll
    for (int ks = 0; ks < C::NKS; ++ks) c.qf[ks] = __builtin_bit_cast(bf16x8, ldg16(qrow + ks * 16));
  }
#pragma unroll
  for (int a = 0; a < 2; ++a)
#pragma unroll
    for (int i = 0; i < 16; ++i) c.o[a][i] = 0.f;
  c.mref = 0.f; c.l = 0.f;
  {
    u32x4 k1 = {h == 0 ? 0x3F80u : 0u, 0u, 0u, 0u}, z4 = {0u, 0u, 0u, 0u};
    c.kone = __builtin_bit_cast(bf16x8, k1); c.qm = __builtin_bit_cast(bf16x8, z4);
  }
  f32x16 sa[2], sb[2];
  c.gload_k(0); c.gload_v(0);
  __syncthreads();
  c.sstore_k(0); c.sstore_v(0);
  if (nt > 1) c.gload_k(1);
  __syncthreads();
  c.qk(0, sa);
#pragma unroll
  for (int i = 0; i < 16; ++i) {
    sa[0][i] = -1e30f;
    if (swap23(crow(i, h)) < 16) sa[1][i] = -1e30f;
  }
  int t = 0;
  for (; t + 1 < nt; t += 2) {
    c.template step<0>(t, sa, sb);
    c.template step<1>(t + 1, sb, sa);
  }
  if (t < nt) c.template step<0>(t, sa, sb);
  if (dry) return;
  float l = c.l;
  l += xhalf(l);
  const float inv = 1.0f / l;
  float ss = 0.f;
  u16* orow = (u16*)Qb + (size_t)myrow * qpitch;
#pragma unroll
  for (int db = 0; db < 2; ++db)
#pragma unroll
    for (int g4 = 0; g4 < 4; ++g4) {
      const float a0 = c.o[db][4 * g4] * inv, a1 = c.o[db][4 * g4 + 1] * inv, a2 = c.o[db][4 * g4 + 2] * inv, a3 = c.o[db][4 * g4 + 3] * inv;
      ss += a0 * a0 + a1 * a1 + a2 * a2 + a3 * a3;
      store4g(orow + db * 32 + 8 * g4 + 4 * h, a0, a1, a2, a3);
    }
  ss += xhalf(ss);
  if (h == 0) unsafeAtomicAdd(ssq + myrow, ss);
}

constexpr int N_ITEMS = 8288;
DI void phase_attn(const Params& p, int layer, char* smem, int* s_item, int tid, bool dry) {
  u16* QM = (u16*)(p.ws + OFF_HN);
  const u16* KN = (const u16*)(p.ws + OFF_KN);
  const u16* KPE = (const u16*)(p.ws + OFF_KPE);
  const u16* VMT = (const u16*)(p.ws + OFF_VMT);
  u16* QG = (u16*)(p.ws + OFF_QG);
  const u16* KG = (const u16*)(p.ws + OFF_KG);
  const u16* VGT = (const u16*)(p.ws + OFF_VGT);
  float* ssq = (float*)(p.ws + OFF_SSQ);
  const int myx = (int)((unsigned)__builtin_amdgcn_s_getreg((3 << 11) | 20) & 7u);
  const int startL = blockIdx.x >= (gridDim.x >> 1) ? 1 : 0;
  int* cq = (int*)(p.ws + OFF_CNT) + 8 + layer * 32 + (dry ? 16 : 0);
  for (int xo = 0; xo < 8; ++xo) {
    const int x = (myx + xo) & 7;
    for (int pass = 0; pass < 2; ++pass) {
      const int L = startL ^ pass;
      for (;;) {
        if (tid == 0) *s_item = atomicAdd(cq + L * 8 + x, 1);
        __syncthreads();
        const int j = *s_item;
        __syncthreads();
        if (j >= 258 + 260) break;
        int seq, head, qi, nt;
        if (j < 258) {
          const int s2 = j / 129; qi = j - s2 * 129; nt = 257;
          if (L == 0) { const int sg = x + 8 * s2; seq = sg >> 3; head = sg & 7; }
          else { seq = x >> 2; head = ((x >> 1) & 1) * 4 + (x & 1) * 2 + s2; }
        } else {
          const int jj = j - 258, s4 = jj / 65; qi = jj - s4 * 65; nt = 129;
          if (L == 0) { const int sg = x + 8 * s4; seq = 2 + (sg >> 3); head = sg & 7; }
          else { seq = 2 + (x >> 1); head = (x & 1) * 4 + s4; }
        }
        const int P = seq_base(seq);
        if (L == 0)
          attn_item<96>(QM + head * 96, 768, KN + head * 64, 512, KPE, VMT + (size_t)head * 64 * MPAD, ssq + 2 * (size_t)MPAD, P + qi * 128, P + 64, nt, smem, tid, dry);
        else
          attn_item<64>(QG + head * 64, 512, KG + (head >> 2) * 64, 128, nullptr, VGT + (size_t)(head >> 2) * 64 * MPAD, ssq + 3 * (size_t)MPAD, P + qi * 128, P + 64, nt, smem, tid, dry);
      }
    }
  }
}

#define XB_TMO      128
#define XB_XCNT(j)  (256  + 64 * (j))
#define XB_XSUB(j)  (1280 + 64 * (j))
#define XB_XGEN(j)  (2304 + 64 * (j))
#define XB_TOP      3328
#define XB_TOPGEN   3392
#define XCD_BAR_WORDS 3456
#define XB_SPIN_CAP (1u << 18)
#define LAS __attribute__((address_space(3)))

__device__ __forceinline__ unsigned xb_ld(unsigned* p)              { return __hip_atomic_load(p, __ATOMIC_RELAXED, __HIP_MEMORY_SCOPE_AGENT); }
__device__ __forceinline__ unsigned xb_add(unsigned* p, unsigned v) { return __hip_atomic_fetch_add(p, v, __ATOMIC_RELAXED, __HIP_MEMORY_SCOPE_AGENT); }
__device__ __forceinline__ unsigned xb_xcc_id() { return (unsigned)__builtin_amdgcn_s_getreg((3 << 11) | 20) & 0xFu; }
#define XB_SPIN(cond, bar) do { unsigned _sp = 0; while (cond) { __builtin_amdgcn_s_sleep(1); \
    if ((++_sp & 255u) == 0u) { if (xb_ld(&(bar)[XB_TMO])) break; if (_sp > XB_SPIN_CAP) { atomicAdd(&(bar)[XB_TMO], 1u); break; } } } } while (0)

struct XcdBarrier {
    unsigned* bar; unsigned x;
    volatile LAS unsigned* st;
};

__device__ __forceinline__ XcdBarrier xcd_barrier_post(unsigned* bar, volatile LAS unsigned* st) {
    XcdBarrier b; b.bar = bar; b.x = xb_xcc_id(); b.st = st;
    if (threadIdx.x == 0) (void)xb_add(&bar[XB_XCNT(b.x)], 1u);
    return b;
}
__device__ __forceinline__ void xcd_barrier_complete(unsigned* bar, unsigned x, unsigned& nloc, unsigned& nx) {
    const unsigned G = gridDim.x * gridDim.y * gridDim.z;
    unsigned sum, cnt, mine, sp = 0u;
    for (;;) {
        sum = 0u; cnt = 0u; mine = 0u;
#pragma unroll
        for (unsigned j = 0; j < 16; ++j) { const unsigned c = xb_ld(&bar[XB_XCNT(j)]); sum += c; cnt += (c > 0u) ? 1u : 0u; mine = (j == x) ? c : mine; }
        if (sum == G) break;
        __builtin_amdgcn_s_sleep(1);
        if ((++sp & 255u) == 0u) { if (xb_ld(&bar[XB_TMO])) break; if (sp > XB_SPIN_CAP) { atomicAdd(&bar[XB_TMO], 1u); break; } }
    }
    nloc = mine > 0u ? mine : 1u; nx = cnt > 0u ? cnt : 1u;
}

__device__ __forceinline__ void xcd_barrier(const XcdBarrier& b) {
    asm volatile("s_waitcnt vmcnt(0)" ::: "memory");
    __syncthreads();
    if (threadIdx.x == 0) {
        unsigned* bar = b.bar;
        __builtin_amdgcn_s_waitcnt(0);
        unsigned nloc = b.st[0], nx = b.st[1];
        if (nloc == 0u) { xcd_barrier_complete(bar, b.x, nloc, nx); b.st[0] = nloc; b.st[1] = nx; }
        const unsigned old = xb_add(&bar[XB_XSUB(b.x)], 1u);
        const unsigned gen = old / nloc;
        if (old + 1u == (gen + 1u) * nloc) {
            __builtin_amdgcn_fence(__ATOMIC_RELEASE, "agent");
            asm volatile("s_waitcnt vmcnt(0)" ::: "memory");
            const unsigned og = xb_add(&bar[XB_TOP], 1u);
            const unsigned tg = og / nx;
            if (og + 1u == (tg + 1u) * nx) xb_add(&bar[XB_TOPGEN], 1u);
            else XB_SPIN(xb_ld(&bar[XB_TOPGEN]) == tg, bar);
            __builtin_amdgcn_fence(__ATOMIC_ACQUIRE, "agent");
            xb_add(&bar[XB_XGEN(b.x)], 1u);
            asm volatile("s_waitcnt vmcnt(0)" ::: "memory");
        } else {
            XB_SPIN(xb_ld(&bar[XB_XGEN(b.x)]) == gen, bar);
            __builtin_amdgcn_fence(__ATOMIC_ACQUIRE, "agent");
            asm volatile("s_waitcnt vmcnt(0)" ::: "memory");
        }
    }
    __syncthreads();
}


__global__ void __launch_bounds__(256, 2) mega(Params pin) {
  __shared__ __attribute__((aligned(16))) char smem[2 * 2 * 128 * GP * 2];
  __shared__ int s_item;
  __shared__ uint4 xb_words;
  if (threadIdx.x == 0) xb_words = make_uint4(0u, 0u, 0u, 0u);
  __syncthreads();
  XcdBarrier xb; xb.bar = nullptr; xb.x = 0u; xb.st = (volatile LAS unsigned*)&xb_words;
  bool xb_posted = false;
  const int G = gridDim.x, b = blockIdx.x;
  const int vb = ((G & 7) == 0) ? ((b & 7) * (G >> 3) + (b >> 3)) : b;
  for (int st = pin.phase_lo; st < pin.phase_hi; ++st) {
    int ph; bool dry = false;
    if (st == 0) ph = 0;
    else if (st == 41) ph = 21;
    else {
      const int u = st - 1, lay = u / 20, v = u - lay * 20, sb = v >> 1;
      dry = (v & 1) == 0;
      if (dry && !((pin.probe >> sb) & 1)) continue;
      if (lay == 0 && sb == 0) continue;
      ph = 1 + lay * 10 + sb;
    }
    if (st > pin.phase_lo) {
      if (!xb_posted) {
        cg::this_grid().sync();
        xb = xcd_barrier_post((unsigned*)(pin.ws + OFF_BAR), (volatile LAS unsigned*)&xb_words);
        xb_posted = true;
      } else xcd_barrier(xb);
    }
    Params p = pin;
    asm volatile("" : "+s"(p.xp), "+s"(p.xs), "+s"(p.meta), "+s"(p.attn_g), "+s"(p.w_in), "+s"(p.qa_g), "+s"(p.w_qb), "+s"(p.kva_g), "+s"(p.w_kvb), "+s"(p.gq_g));
    asm volatile("" : "+s"(p.gk_g), "+s"(p.mo_g), "+s"(p.go_g), "+s"(p.w_out), "+s"(p.mlp_g), "+s"(p.w_up), "+s"(p.w_dn), "+s"(p.fin_g), "+s"(p.out), "+s"(p.ws));
    int tid = threadIdx.x;
    asm volatile("" : "+v"(tid));
    const int lane = tid & 63, wave = tid >> 6, r = lane & 31;
    float* ssq = (float*)(p.ws + OFF_SSQ);
    const float2* tab = (const float2*)(p.ws + OFF_TAB);
    if (ph == 0) { phase_prep(p, tid); phase_norm(p, p.attn_g, true, true, tid); continue; }
    if (ph == 21) { phase_final(p, tid); continue; }
    const int layer = (ph - 1) / 10, sub = (ph - 1) % 10;
    const u16* Wl = (const u16*)(p.ws + OFF_W) + (size_t)layer * W_LAYER;
    if (sub == 0) {
      phase_norm(p, p.attn_g + layer * 1024, layer == 0, true, tid);
    } else if (sub == 1) {
      EpiIn e; e.CQ = (u16*)(p.ws + OFF_CQ); e.CKV = (u16*)(p.ws + OFF_CKV); e.QG = (u16*)(p.ws + OFF_QG); e.KG = (u16*)(p.ws + OFF_KG);
      e.VGT = (u16*)(p.ws + OFF_VGT); e.KPE = (u16*)(p.ws + OFF_KPE); e.ssq_q = ssq; e.ssq_kv = ssq + MPAD;
      e.gq_g = p.gq_g + layer * 64; e.gk_g = p.gk_g + layer * 64; e.tab = tab;
      APLin ap{(const u16*)(p.ws + OFF_HN), 1024};
      for (int t = vb; t < NTM * 12; t += G) { const int mt = t / 12, nt = t - mt * 12; gemm_tile<false>(ap, Wl + WO_IN, 1024, 1024, mt * 128, nt * 128, e, smem, 1.f, 1.f, tid, dry); }
    } else if (sub == 2) {
      EpiQB e2; e2.QM = (u16*)(p.ws + OFF_HN); e2.ssq_q = ssq; e2.tab = tab;
      EpiKVB e3; e3.KN = (u16*)(p.ws + OFF_KN); e3.VMT = (u16*)(p.ws + OFF_VMT); e3.ssq_kv = ssq + MPAD;
      APLin a2{(const u16*)(p.ws + OFF_CQ), 384};
      APLin a3{(const u16*)(p.ws + OFF_CKV), 256};
      for (int t = vb; t < NTM * 14; t += G) {
        if (t < NTM * 6) { const int mt = t / 6, nt = t - mt * 6; gemm_tile<false>(a2, Wl + WO_QB, 384, 384, mt * 128, nt * 128, e2, smem, 1.f, 1.f, tid, dry); }
        else { const int u = t - NTM * 6; const int mt = u >> 3, nt = u & 7; gemm_tile<false>(a3, Wl + WO_KVB, 256, 256, mt * 128, nt * 128, e3, smem, 1.f, 1.f, tid, dry); }
      }
    } else if (sub == 3) {
      phase_attn(p, layer, smem, &s_item, tid, dry);
    } else if (sub == 4) {
      APMix ap{(const u16*)(p.ws + OFF_HN), (const u16*)(p.ws + OFF_QG)};
      for (int t = vb; t < NTM * 8; t += G) {
        const int mt = t >> 3, nt = t & 7;
        const int g0 = mt * 128 + (wave >> 1) * 64 + r;
        const float ra0 = rsqrtf(ldgf(ssq + 2 * (size_t)MPAD + g0) * (1.0f / 512.0f) + EPS), rg0 = rsqrtf(ldgf(ssq + 3 * (size_t)MPAD + g0) * (1.0f / 512.0f) + EPS);
        const float ra1 = rsqrtf(ldgf(ssq + 2 * (size_t)MPAD + g0 + 32) * (1.0f / 512.0f) + EPS), rg1 = rsqrtf(ldgf(ssq + 3 * (size_t)MPAD + g0 + 32) * (1.0f / 512.0f) + EPS);
        EpiRes e; res_bases(p, mt, layer == 0, e.sb, e.db, e.minrow); e.fin0 = rg0; e.fin1 = rg1;
        gemm_tile<true>(ap, Wl + WO_OUT, 1024, 1024, mt * 128, nt * 128, e, smem, ra0 / rg0, ra1 / rg1, tid, dry);
      }
    } else if (sub == 5) {
      phase_norm(p, p.mlp_g + layer * 1024, false, false, tid);
    } else if (sub == 6 || sub == 8) {
      const int mh = (sub - 6) >> 1;
      EpiUp e; e.U0 = (u16*)(p.ws + OFF_U) - (size_t)mh * 259 * 128 * 4096;
      APLin ap{(const u16*)(p.ws + OFF_HN), 1024};
      for (int t = vb; t < 259 * 32; t += G) {
        int ml, nt;
        if (t < 256 * 32) { const int blk = t >> 6, w = t & 63; ml = (blk >> 2) * 8 + (w >> 3); nt = (blk & 3) * 8 + (w & 7); }
        else { ml = t >> 5; nt = t & 31; }
        gemm_tile<false>(ap, Wl + WO_UP, 1024, 1024, (mh * 259 + ml) * 128, nt * 128, e, smem, 1.f, 1.f, tid, dry);
      }
    } else {
      const int mh = (sub - 7) >> 1;
      APLin ap{(const u16*)(p.ws + OFF_U) - (size_t)mh * 259 * 128 * 4096, 4096};
      for (int t = vb; t < 259 * 8; t += G) {
        const int mt = mh * 259 + (t >> 3), nt = t & 7;
        EpiRes e; res_bases(p, mt, false, e.sb, e.db, e.minrow); e.fin0 = 1.f; e.fin1 = 1.f;
        gemm_tile<false>(ap, Wl + WO_DN, 4096, 4096, mt * 128, nt * 128, e, smem, 1.f, 1.f, tid, dry);
      }
    }
  }
}

extern "C" void kernel_launch(void* const* d_in, const int* in_sizes, int n_in, void* d_out, int out_size, void* d_ws, size_t ws_size,
                              hipStream_t stream) {
  static int grid_blocks = 0;
  if (!grid_blocks) {
    int dev = 0, cus = 0, per_cu = 0;
    hipGetDevice(&dev);
    hipDeviceGetAttribute(&cus, hipDeviceAttributeMultiprocessorCount, dev);
    hipOccupancyMaxActiveBlocksPerMultiprocessor(&per_cu, mega, 256, 0);
    if (per_cu > 2) per_cu = 2;
    if (per_cu < 1) per_cu = 1;
    grid_blocks = cus * per_cu;
  }
  Params p{};
  p.xp = (const float*)d_in[0]; p.xs = (const float*)d_in[1]; p.meta = (const float*)d_in[2];
  p.attn_g = (const float*)d_in[3]; p.w_in = (const float*)d_in[4]; p.qa_g = (const float*)d_in[5]; p.w_qb = (const float*)d_in[6];
  p.kva_g = (const float*)d_in[7]; p.w_kvb = (const float*)d_in[8]; p.gq_g = (const float*)d_in[9]; p.gk_g = (const float*)d_in[10];
  p.mo_g = (const float*)d_in[11]; p.go_g = (const float*)d_in[12]; p.w_out = (const float*)d_in[13]; p.mlp_g = (const float*)d_in[14];
  p.w_up = (const float*)d_in[15]; p.w_dn = (const float*)d_in[16]; p.fin_g = (const float*)d_in[17];
  p.out = (float*)d_out; p.ws = (char*)d_ws;
#if MK_MULTI
  for (int ph = 0; ph < 42; ++ph) {
    p.phase_lo = ph; p.phase_hi = ph + 1; p.probe = PROBE_MASK;
    if (ph > 0 && ph < 41 && ((ph - 1) & 1) == 0 && !((PROBE_MASK >> (((ph - 1) % 20) >> 1)) & 1)) continue;
    hipLaunchKernelGGL(mega, dim3(grid_blocks), dim3(256), 0, stream, p);
  }
#else
  p.phase_lo = 0; p.phase_hi = 42; p.probe = PROBE_MASK;
  void* args[] = {&p};
  hipError_t e = hipLaunchCooperativeKernel((void*)mega, dim3(grid_blocks), dim3(256), args, 0, stream);
  if (e != hipSuccess) fprintf(stderr, "cooperative launch failed: %s (grid %d)\n", hipGetErrorString(e), grid_blocks);
#endif
}
```
